# Optimizing an MI355X kernel written in HIP

```python
import math
import jax, jax.numpy as jnp
from jax import lax
import numpy as np

D_MODEL = 1024
BATCH = 32
SEQ = 2048
DEPTH = 1

CHUNK = 64
EPS = 1e-6

D_MIX = D_MODEL
D_LRU = D_MIX // 2
D_SSM = D_MIX - D_LRU

LRU_HEADS = 8
LRU_HEAD_DIM = D_LRU // LRU_HEADS
CONV_WIDTH = 4
LRU_C = 8.0

SSM_GROUP = 16
SSM_GROUPS = D_SSM // SSM_GROUP
SSM_STATE = 64
DT_MIN = 0.001
DT_MAX = 0.1

PEER_HEADS = 8
PEER_NKEYS = 128
PEER_EXPERTS = PEER_NKEYS * PEER_NKEYS
PEER_TOPK = 16
PEER_QDIM = 256
PEER_HALF = PEER_QDIM // 2
TOK_BLOCK = 128

kernel_name = 'hymba_rglru_s5_peer_block'


def rms_norm(x, g):
    xf = x.astype(jnp.float32)
    y = xf * lax.rsqrt(jnp.mean(xf * xf, axis=-1, keepdims=True) + EPS) * g.astype(jnp.float32)
    return y.astype(x.dtype)


def rg_lru_group(xa, gate, conv_w, conv_b, wa, ba, wx, bx, lam):
    b, s, _ = xa.shape
    xc = lax.conv_general_dilated(
        xa, conv_w[:, None, :].astype(xa.dtype), window_strides=(1,),
        padding=[(CONV_WIDTH - 1, 0)], dimension_numbers=('NWC', 'WIO', 'NWC'),
        feature_group_count=D_LRU) + conv_b
    xf = xc.astype(jnp.float32)
    xh = xf.reshape(b, s, LRU_HEADS, LRU_HEAD_DIM)
    r = jax.nn.sigmoid(jnp.einsum('bshi,hij->bshj', xh, wa.astype(jnp.float32)).reshape(b, s, D_LRU)
                       + ba.astype(jnp.float32))
    i_g = jax.nn.sigmoid(jnp.einsum('bshi,hij->bshj', xh, wx.astype(jnp.float32)).reshape(b, s, D_LRU)
                         + bx.astype(jnp.float32))
    log_a = -LRU_C * r * jax.nn.softplus(-lam.astype(jnp.float32))
    a = jnp.exp(log_a)
    u = jnp.sqrt(-jnp.expm1(2.0 * log_a)) * (i_g * xf)

    def step(h, au):
        a_t, u_t = au
        h = a_t * h + u_t
        return h, h

    _, hs = lax.scan(step, jnp.zeros((b, D_LRU), jnp.float32),
                     (jnp.swapaxes(a, 0, 1), jnp.swapaxes(u, 0, 1)))
    h = jnp.swapaxes(hs, 0, 1)
    return (h * jax.nn.gelu(gate.astype(jnp.float32))).astype(xa.dtype)


def _complex_combine(e1, e2):
    a1r, a1i, b1r, b1i = e1
    a2r, a2i, b2r, b2i = e2
    return (a2r * a1r - a2i * a1i,
            a2r * a1i + a2i * a1r,
            a2r * b1r - a2i * b1i + b2r,
            a2r * b1i + a2i * b1r + b2i)


def s5_group(u, lam_re, lam_im, log_dt, b_re, b_im, c_re, c_im, d_skip, glu_w, glu_b):
    b, s, _ = u.shape
    uf = u.astype(jnp.float32)
    dt = jnp.exp(log_dt.astype(jnp.float32))[:, None]
    lr = lam_re.astype(jnp.float32)
    li = lam_im.astype(jnp.float32)
    mag = jnp.exp(lr * dt)
    ab_re = mag * jnp.cos(li * dt)
    ab_im = mag * jnp.sin(li * dt)
    den = lr * lr + li * li
    n_re = ab_re - 1.0
    n_im = ab_im
    zc_re = (n_re * lr + n_im * li) / den
    zc_im = (n_im * lr - n_re * li) / den
    br = b_re.astype(jnp.float32)
    bi = b_im.astype(jnp.float32)
    bb_re = zc_re[..., None] * br - zc_im[..., None] * bi
    bb_im = zc_re[..., None] * bi + zc_im[..., None] * br
    cr = c_re.astype(jnp.float32)
    ci = c_im.astype(jnp.float32)

    n_chunks = s // CHUNK
    uc = uf.reshape(b, n_chunks, CHUNK, SSM_GROUPS, SSM_GROUP).transpose(1, 0, 2, 3, 4)
    a_re = jnp.broadcast_to(ab_re, (b, CHUNK, SSM_GROUPS, SSM_STATE))
    a_im = jnp.broadcast_to(ab_im, (b, CHUNK, SSM_GROUPS, SSM_STATE))

    def chunk_step(carry, u_c):
        h_re, h_im = carry
        bu_re = jnp.einsum('bcgi,gpi->bcgp', u_c, bb_re)
        bu_im = jnp.einsum('bcgi,gpi->bcgp', u_c, bb_im)
        acum_re, acum_im, s_re, s_im = lax.associative_scan(
            _complex_combine, (a_re, a_im, bu_re, bu_im), axis=1)
        st_re = s_re + acum_re * h_re[:, None] - acum_im * h_im[:, None]
        st_im = s_im + acum_re * h_im[:, None] + acum_im * h_re[:, None]
        y = jnp.einsum('bcgp,gip->bcgi', st_re, cr) - jnp.einsum('bcgp,gip->bcgi', st_im, ci)
        return (st_re[:, -1], st_im[:, -1]), y

    h0 = jnp.zeros((b, SSM_GROUPS, SSM_STATE), jnp.float32)
    _, ys = lax.scan(chunk_step, (h0, h0), uc)
    y = ys.transpose(1, 0, 2, 3, 4).reshape(b, s, D_SSM) + d_skip.astype(jnp.float32) * uf
    g = jax.nn.gelu(y)
    out = g * jax.nn.sigmoid(g @ glu_w.astype(jnp.float32) + glu_b.astype(jnp.float32))
    return out.astype(u.dtype)


def peer_ffn(x, wq, k1, k2, u_tab, v_tab):
    b, s, d = x.shape
    xt = x.reshape(-1, TOK_BLOCK, d)

    def block(xb):
        q = (xb @ wq).astype(jnp.float32).reshape(TOK_BLOCK, PEER_HEADS, PEER_QDIM)
        s1 = jnp.einsum('thd,kd->thk', q[..., :PEER_HALF], k1.astype(jnp.float32))
        s2 = jnp.einsum('thd,kd->thk', q[..., PEER_HALF:], k2.astype(jnp.float32))
        v1, i1 = lax.top_k(s1, PEER_TOPK)
        v2, i2 = lax.top_k(s2, PEER_TOPK)
        cand = (v1[..., :, None] + v2[..., None, :]).reshape(TOK_BLOCK, PEER_HEADS, PEER_TOPK * PEER_TOPK)
        sc, cidx = lax.top_k(cand, PEER_TOPK)
        e = (jnp.take_along_axis(i1, cidx // PEER_TOPK, axis=-1) * PEER_NKEYS
             + jnp.take_along_axis(i2, cidx % PEER_TOPK, axis=-1))
        g = jax.nn.softmax(sc, axis=-1)
        u_sel = u_tab[e]
        act = jax.nn.gelu(jnp.einsum('thkd,td->thk', u_sel, xb).astype(jnp.float32))
        v_sel = v_tab[e]
        return jnp.einsum('thk,thkd->td', (g * act).astype(xb.dtype), v_sel)

    out = lax.map(block, xt)
    return out.reshape(b, s, d)


def setup_inputs(seed: int = 0) -> dict:
    key = jax.random.key(seed)
    ks = jax.random.split(key, 32)
    L = DEPTH

    def nrm(k, shape, scale):
        return jax.random.normal(k, shape, jnp.float32) * scale

    x = jax.random.normal(ks[0], (BATCH, SEQ, D_MODEL), jnp.float32)
    norm1_g = 1.0 + nrm(ks[1], (L, D_MODEL), 0.02)
    w_in = nrm(ks[2], (L, D_MODEL, D_LRU + D_LRU + D_SSM), D_MODEL ** -0.5)
    conv_w = nrm(ks[3], (L, CONV_WIDTH, D_LRU), CONV_WIDTH ** -0.5)
    conv_b = nrm(ks[4], (L, D_LRU), 0.01)
    lru_wa = nrm(ks[5], (L, LRU_HEADS, LRU_HEAD_DIM, LRU_HEAD_DIM), LRU_HEAD_DIM ** -0.5)
    lru_ba = nrm(ks[6], (L, D_LRU), 0.01)
    lru_wx = nrm(ks[7], (L, LRU_HEADS, LRU_HEAD_DIM, LRU_HEAD_DIM), LRU_HEAD_DIM ** -0.5)
    lru_bx = nrm(ks[8], (L, D_LRU), 0.01)
    a_c = jax.random.uniform(ks[9], (L, D_LRU), jnp.float32, 0.9, 0.999)
    sig_l = a_c ** (1.0 / LRU_C)
    lru_lambda = jnp.log(sig_l) - jnp.log1p(-sig_l)
    n_idx = jnp.arange(SSM_STATE, dtype=jnp.float32)
    s5_lambda_re = -0.5 + nrm(ks[10], (L, SSM_GROUPS, SSM_STATE), 0.01)
    s5_lambda_im = math.pi * n_idx + nrm(ks[11], (L, SSM_GROUPS, SSM_STATE), 0.01)
    s5_log_dt = jax.random.uniform(ks[12], (L, SSM_GROUPS), jnp.float32,
                                   math.log(DT_MIN), math.log(DT_MAX))
    s5_b_re = nrm(ks[13], (L, SSM_GROUPS, SSM_STATE, SSM_GROUP), (2.0 * SSM_GROUP) ** -0.5)
    s5_b_im = nrm(ks[14], (L, SSM_GROUPS, SSM_STATE, SSM_GROUP), (2.0 * SSM_GROUP) ** -0.5)
    s5_c_re = nrm(ks[15], (L, SSM_GROUPS, SSM_GROUP, SSM_STATE), (2.0 * SSM_STATE) ** -0.5)
    s5_c_im = nrm(ks[16], (L, SSM_GROUPS, SSM_GROUP, SSM_STATE), (2.0 * SSM_STATE) ** -0.5)
    s5_d = nrm(ks[17], (L, D_SSM), 1.0)
    s5_glu_w = nrm(ks[18], (L, D_SSM, D_SSM), D_SSM ** -0.5)
    s5_glu_b = nrm(ks[19], (L, D_SSM), 0.01)
    gnorm_lru = 1.0 + nrm(ks[20], (L, D_LRU), 0.02)
    gnorm_s5 = 1.0 + nrm(ks[21], (L, D_SSM), 0.02)
    w_out = nrm(ks[22], (L, D_MIX, D_MODEL), D_MIX ** -0.5)
    norm2_g = 1.0 + nrm(ks[23], (L, D_MODEL), 0.02)
    peer_wq = nrm(ks[24], (L, D_MODEL, PEER_HEADS * PEER_QDIM), D_MODEL ** -0.5)
    peer_k1 = nrm(ks[25], (L, PEER_NKEYS, PEER_HALF), PEER_HALF ** -0.5)
    peer_k2 = nrm(ks[26], (L, PEER_NKEYS, PEER_HALF), PEER_HALF ** -0.5)
    peer_u = nrm(ks[27], (L, PEER_EXPERTS, D_MODEL), D_MODEL ** -0.5)
    peer_v = nrm(ks[28], (L, PEER_EXPERTS, D_MODEL), (PEER_HEADS * PEER_TOPK) ** -0.5)
    normf_g = 1.0 + nrm(ks[29], (D_MODEL,), 0.02)
    return {'x': x, 'norm1_g': norm1_g, 'w_in': w_in, 'conv_w': conv_w, 'conv_b': conv_b,
            'lru_wa': lru_wa, 'lru_ba': lru_ba, 'lru_wx': lru_wx, 'lru_bx': lru_bx,
            'lru_lambda': lru_lambda, 's5_lambda_re': s5_lambda_re, 's5_lambda_im': s5_lambda_im,
            's5_log_dt': s5_log_dt, 's5_b_re': s5_b_re, 's5_b_im': s5_b_im,
            's5_c_re': s5_c_re, 's5_c_im': s5_c_im, 's5_d': s5_d, 's5_glu_w': s5_glu_w,
            's5_glu_b': s5_glu_b, 'gnorm_lru': gnorm_lru, 'gnorm_s5': gnorm_s5, 'w_out': w_out,
            'norm2_g': norm2_g, 'peer_wq': peer_wq, 'peer_k1': peer_k1, 'peer_k2': peer_k2,
            'peer_u': peer_u, 'peer_v': peer_v, 'normf_g': normf_g}


def reference(x, norm1_g, w_in, conv_w, conv_b, lru_wa, lru_ba, lru_wx, lru_bx, lru_lambda,
              s5_lambda_re, s5_lambda_im, s5_log_dt, s5_b_re, s5_b_im, s5_c_re, s5_c_im,
              s5_d, s5_glu_w, s5_glu_b, gnorm_lru, gnorm_s5, w_out, norm2_g,
              peer_wq, peer_k1, peer_k2, peer_u, peer_v, normf_g):
    h = x
    for l in range(DEPTH):
        xn = rms_norm(h, norm1_g[l])
        p = xn @ w_in[l]
        xa = p[..., :D_LRU]
        gate = p[..., D_LRU:2 * D_LRU]
        us = p[..., 2 * D_LRU:]
        ya = rg_lru_group(xa, gate, conv_w[l], conv_b[l], lru_wa[l], lru_ba[l],
                          lru_wx[l], lru_bx[l], lru_lambda[l])
        yb = s5_group(us, s5_lambda_re[l], s5_lambda_im[l], s5_log_dt[l], s5_b_re[l], s5_b_im[l],
                      s5_c_re[l], s5_c_im[l], s5_d[l], s5_glu_w[l], s5_glu_b[l])
        y = jnp.concatenate([rms_norm(ya, gnorm_lru[l]), rms_norm(yb, gnorm_s5[l])], axis=-1)
        h = h + y @ w_out[l]
        h = h + peer_ffn(rms_norm(h, norm2_g[l]), peer_wq[l], peer_k1[l], peer_k2[l],
                         peer_u[l], peer_v[l])
    return rms_norm(h, normf_g)
```

```cpp
#include <hip/hip_runtime.h>
#include <hip/hip_cooperative_groups.h>
#include <cstdio>
namespace cg = cooperative_groups;

typedef unsigned short u16;
using bf16x8 = __attribute__((ext_vector_type(8))) short;
using f32x4 = __attribute__((ext_vector_type(4))) float;
using f32x16 = __attribute__((ext_vector_type(16))) float;

#ifndef ONE_LAUNCH
#define ONE_LAUNCH 0
#endif

#define T_TOK 65536
#define EPSF 1e-6f
#define NPHASE 10

struct Params {
  const float *x, *norm1_g, *w_in, *conv_w, *conv_b, *lru_wa, *lru_ba, *lru_wx, *lru_bx, *lru_lambda;
  const float *s5_lre, *s5_lim, *s5_logdt, *s5_bre, *s5_bim, *s5_cre, *s5_cim, *s5_d, *glu_w, *glu_b;
  const float *gnorm_lru, *gnorm_s5, *w_out, *norm2_g, *wq, *k1, *k2, *pu, *pv, *normf_g;
  float* out;
  u16 *xb, *WinT, *GluT, *WoutT, *WqT, *K1b, *K2b, *Ub, *Vb, *WaT, *WxT, *MF, *G, *p, *Hs, *ycat, *gs5, *hb, *q;
  float *rstd1, *A16, *Acar, *Hcar, *Hin, *E, *gw;
  int* eidx;
};

__device__ __forceinline__ u16 f2bf(float f) {
  unsigned u = __float_as_uint(f);
  u += 0x7fffu + ((u >> 16) & 1u);
  return (u16)(u >> 16);
}
__device__ __forceinline__ float bf2f(u16 h) { return __uint_as_float(((unsigned)h) << 16); }
__device__ __forceinline__ unsigned pack2(float a, float b) { return (unsigned)f2bf(a) | (((unsigned)f2bf(b)) << 16); }
__device__ __forceinline__ float bflo(unsigned u) { return __uint_as_float(u << 16); }
__device__ __forceinline__ float bfhi(unsigned u) { return __uint_as_float(u & 0xffff0000u); }
__device__ __forceinline__ float sigmoid_(float x) { return 1.f / (1.f + __expf(-x)); }
__device__ __forceinline__ float gelu_(float x) {
  float z = 0.7978845608028654f * (x + 0.044715f * x * x * x);
  return x / (1.f + __expf(-2.f * z));
}
__device__ __forceinline__ float wsum(float v) {
#pragma unroll
  for (int o = 32; o; o >>= 1) v += __shfl_xor(v, o);
  return v;
}
__device__ __forceinline__ float sq8(uint4 v) {
  float s = 0.f, t;
  t = bflo(v.x); s += t * t; t = bfhi(v.x); s += t * t;
  t = bflo(v.y); s += t * t; t = bfhi(v.y); s += t * t;
  t = bflo(v.z); s += t * t; t = bfhi(v.z); s += t * t;
  t = bflo(v.w); s += t * t; t = bfhi(v.w); s += t * t;
  return s;
}
#define MFMA16(a, b, c) __builtin_amdgcn_mfma_f32_16x16x32_bf16(a, b, c, 0, 0, 0)
#define MFMA32(a, b, c) __builtin_amdgcn_mfma_f32_32x32x16_bf16(a, b, c, 0, 0, 0)

__device__ void transpose_fold(const float* src, const float* g, u16* dst, int ldd, int K, int N, char* smem) {
  float* tl = (float*)smem;
  const int tid = threadIdx.x;
  const int tk = K / 64, tn = N / 64;
  for (int t = blockIdx.x; t < tk * tn; t += gridDim.x) {
    int k0 = (t / tn) * 64, n0 = (t % tn) * 64;
    __syncthreads();
    for (int i = 0; i < 16; ++i) {
      int k = (tid >> 6) + i * 4, n = tid & 63;
      float v = src[(size_t)(k0 + k) * N + n0 + n];
      if (g) v *= g[k0 + k];
      tl[k * 65 + n] = v;
    }
    __syncthreads();
    for (int i = 0; i < 16; ++i) {
      int n = (tid >> 6) + i * 4, k = tid & 63;
      dst[(size_t)(n0 + n) * ldd + k0 + k] = f2bf(tl[k * 65 + n]);
    }
  }
}

__device__ void s5_prep(const Params& P, char* smem, int g) {
  float* apw = (float*)smem;
  float* bb = apw + 17 * 64 * 2;
  float* kk = bb + 64 * 16 * 2;
  const int tid = threadIdx.x;
  __syncthreads();
  if (tid < 64) {
    int pp = tid;
    float lr = P.s5_lre[g * 64 + pp], li = P.s5_lim[g * 64 + pp];
    float dt = expf(P.s5_logdt[g]);
    float mag = expf(lr * dt);
    double ang = (double)li * (double)dt;
    double kq = rint(ang * 0.15915494309189535);
    float r = (float)(ang - kq * 6.283185307179586);
    float sn = __sinf(r), cs = __cosf(r);
    {
      sn = sinf(r); cs = cosf(r);
    }
    float are = mag * cs, aim = mag * sn;
    float den = lr * lr + li * li;
    float nre = are - 1.f, nim = aim;
    float zre = (nre * lr + nim * li) / den, zim = (nim * lr - nre * li) / den;
    float pr = 1.f, pi = 0.f;
    for (int d = 0; d <= 16; ++d) {
      apw[(d * 64 + pp) * 2] = pr; apw[(d * 64 + pp) * 2 + 1] = pi;
      float nr = pr * are - pi * aim, ni = pr * aim + pi * are;
      pr = nr; pi = ni;
    }
    P.A16[(g * 64 + pp) * 2] = apw[(16 * 64 + pp) * 2];
    P.A16[(g * 64 + pp) * 2 + 1] = apw[(16 * 64 + pp) * 2 + 1];
    for (int j = 0; j < 16; ++j) {
      float br = P.s5_bre[(g * 64 + pp) * 16 + j], bi = P.s5_bim[(g * 64 + pp) * 16 + j];
      bb[(pp * 16 + j) * 2] = zre * br - zim * bi;
      bb[(pp * 16 + j) * 2 + 1] = zre * bi + zim * br;
    }
  }
  __syncthreads();
  for (int rr = 0; rr < 16; ++rr) {
    int e = tid + rr * 256;
    int d = e >> 8, i = (e >> 4) & 15, j = e & 15;
    float s = 0.f;
    for (int pp = 0; pp < 64; ++pp) {
      float cr = P.s5_cre[(g * 16 + i) * 64 + pp], ci = P.s5_cim[(g * 16 + i) * 64 + pp];
      float ar = apw[(d * 64 + pp) * 2], ai = apw[(d * 64 + pp) * 2 + 1];
      float xr = cr * ar - ci * ai, xi = cr * ai + ci * ar;
      s += xr * bb[(pp * 16 + j) * 2] - xi * bb[(pp * 16 + j) * 2 + 1];
    }
    kk[e] = s;
  }
  __syncthreads();
  u16* MFg = P.MF + (size_t)g * 256 * 384;
  for (int it = 0; it < 192; ++it) {
    int e = tid + it * 256;
    int m = e / 192, cp = (e % 192) * 2;
    int t = m >> 4, i = m & 15;
    float v[2];
    for (int q = 0; q < 2; ++q) {
      int col = cp + q;
      float val;
      if (col < 256) {
        int sg = col >> 4, j = col & 15;
        val = (sg <= t) ? kk[((t - sg) * 16 + i) * 16 + j] : 0.f;
        if (sg == t && i == j) val += P.s5_d[g * 16 + i];
      } else {
        int pc = col - 256, pp = pc & 63, im = pc >> 6;
        float cr = P.s5_cre[(g * 16 + i) * 64 + pp], ci = P.s5_cim[(g * 16 + i) * 64 + pp];
        float ar = apw[((t + 1) * 64 + pp) * 2], ai = apw[((t + 1) * 64 + pp) * 2 + 1];
        float xr = cr * ar - ci * ai, xi = cr * ai + ci * ar;
        val = im ? -xi : xr;
      }
      v[q] = val;
    }
    *(unsigned*)(MFg + (size_t)m * 384 + cp) = pack2(v[0], v[1]);
  }
  u16* Gg = P.G + (size_t)g * 128 * 256;
  for (int it = 0; it < 64; ++it) {
    int e = tid + it * 256;
    int row = e >> 7, cp = (e & 127) * 2;
    int im = row >> 6, pp = row & 63;
    float v[2];
    for (int q = 0; q < 2; ++q) {
      int col = cp + q, sg = col >> 4, j = col & 15;
      float ar = apw[((15 - sg) * 64 + pp) * 2], ai = apw[((15 - sg) * 64 + pp) * 2 + 1];
      float br = bb[(pp * 16 + j) * 2], bi = bb[(pp * 16 + j) * 2 + 1];
      v[q] = im ? (ar * bi + ai * br) : (ar * br - ai * bi);
    }
    *(unsigned*)(Gg + (size_t)row * 256 + cp) = pack2(v[0], v[1]);
  }
}

__device__ void phase_prep(const Params& P, char* smem) {
  const int tid = threadIdx.x, lane = tid & 63, w = tid >> 6;
  {
    int g = (int)gridDim.x - 1 - (int)blockIdx.x;
    if (g < 32) s5_prep(P, smem, g);
  }
  {
    const int gwv = blockIdx.x * 4 + w, nw = gridDim.x * 4;
    for (int r = gwv; r < T_TOK; r += nw) {
      const float4* src = (const float4*)(P.x + (size_t)r * 1024);
      float4 v[4];
      float ss = 0.f;
#pragma unroll
      for (int i = 0; i < 4; ++i) {
        v[i] = src[i * 64 + lane];
        ss += v[i].x * v[i].x + v[i].y * v[i].y + v[i].z * v[i].z + v[i].w * v[i].w;
      }
      ss = wsum(ss);
      if (lane == 0) P.rstd1[r] = rsqrtf(ss * (1.f / 1024.f) + EPSF);
      uint2* dst = (uint2*)(P.xb + (size_t)r * 1024);
#pragma unroll
      for (int i = 0; i < 4; ++i) dst[i * 64 + lane] = make_uint2(pack2(v[i].x, v[i].y), pack2(v[i].z, v[i].w));
    }
  }
  {
    size_t gt = (size_t)blockIdx.x * 256 + tid, nt = (size_t)gridDim.x * 256;
    for (size_t i = gt; i < 4194304; i += nt) {
      float4 a = ((const float4*)P.pu)[i];
      ((uint2*)P.Ub)[i] = make_uint2(pack2(a.x, a.y), pack2(a.z, a.w));
      float4 b = ((const float4*)P.pv)[i];
      ((uint2*)P.Vb)[i] = make_uint2(pack2(b.x, b.y), pack2(b.z, b.w));
    }
    for (size_t i = gt; i < 4096; i += nt) {
      float4 a = ((const float4*)P.k1)[i];
      ((uint2*)P.K1b)[i] = make_uint2(pack2(a.x, a.y), pack2(a.z, a.w));
      float4 b = ((const float4*)P.k2)[i];
      ((uint2*)P.K2b)[i] = make_uint2(pack2(b.x, b.y), pack2(b.z, b.w));
    }
  }
  transpose_fold(P.w_in, P.norm1_g, P.WinT, 1024, 1024, 1536, smem);
  transpose_fold(P.glu_w, nullptr, P.GluT, 512, 512, 512, smem);
  transpose_fold(P.w_out, P.gnorm_lru, P.WoutT, 1024, 512, 1024, smem);
  transpose_fold(P.w_out + 512 * 1024, P.gnorm_s5, P.WoutT + 512, 1024, 512, 1024, smem);
  transpose_fold(P.wq, P.norm2_g, P.WqT, 1024, 1024, 2048, smem);
  for (int h = 0; h < 8; ++h) {
    transpose_fold(P.lru_wa + h * 4096, nullptr, P.WaT + h * 4096, 64, 64, 64, smem);
    transpose_fold(P.lru_wx + h * 4096, nullptr, P.WxT + h * 4096, 64, 64, 64, smem);
  }
}

enum { EPI_INPROJ = 0, EPI_GLU = 1, EPI_OUT = 2, EPI_Q = 3 };
#define LDT 72

template <int EPI>
__device__ void gemm_phase(const Params& P, char* smem, const u16* __restrict__ A, const u16* __restrict__ Bt,
                           int M, int N, int K) {
  u16* As = (u16*)smem;
  u16* Bs = As + 128 * LDT;
  float* rs = (float*)(Bs + 128 * LDT);
  const int tid = threadIdx.x, lane = tid & 63, w = tid >> 6, wm = w >> 1, wn = w & 1;
  const int l15 = lane & 15, lq = lane >> 4;
  const int NT = N / 128, MT = M / 128, ntiles = MT * NT, nk = K / 64;
  for (int tile = blockIdx.x; tile < ntiles; tile += gridDim.x) {
    const int row0 = (tile / NT) * 128, col0 = (tile % NT) * 128;
    __syncthreads();
    if (EPI == EPI_OUT || EPI == EPI_Q) {
      int r = tid >> 1, hf = tid & 1;
      const uint4* src = (const uint4*)(A + (size_t)(row0 + r) * K + hf * 512);
      float ss = 0.f;
      for (int i = 0; i < 64; ++i) ss += sq8(src[i]);
      if (EPI == EPI_Q) {
        ss += __shfl_xor(ss, 1);
        rs[r * 2 + hf] = rsqrtf(ss * (1.f / 1024.f) + EPSF);
      } else {
        rs[r * 2 + hf] = rsqrtf(ss * (1.f / 512.f) + EPSF);
      }
    }
    f32x4 acc[4][4];
#pragma unroll
    for (int i = 0; i < 4; ++i)
#pragma unroll
      for (int j = 0; j < 4; ++j) acc[i][j] = (f32x4){0.f, 0.f, 0.f, 0.f};
    uint4 ra0, ra1, ra2, ra3, rb0, rb1, rb2, rb3;
    const u16* Ag = A + (size_t)row0 * K;
    const u16* Bg = Bt + (size_t)col0 * K;
#define GLD(i, kk) { int c = tid + i * 256, r = c >> 3, kc = c & 7; \
      ra##i = *(const uint4*)(Ag + (size_t)r * K + (kk) * 64 + kc * 8); \
      rb##i = *(const uint4*)(Bg + (size_t)r * K + (kk) * 64 + kc * 8); }
#define LST(i) { int c = tid + i * 256, r = c >> 3, kc = c & 7; \
      *(uint4*)(As + r * LDT + kc * 8) = ra##i; *(uint4*)(Bs + r * LDT + kc * 8) = rb##i; }
    GLD(0, 0) GLD(1, 0) GLD(2, 0) GLD(3, 0)
    for (int kt = 0; kt < nk; ++kt) {
      __syncthreads();
      LST(0) LST(1) LST(2) LST(3)
      __syncthreads();
      if (kt + 1 < nk) { GLD(0, kt + 1) GLD(1, kt + 1) GLD(2, kt + 1) GLD(3, kt + 1) }
      if (EPI == EPI_OUT && kt == nk / 2) {
#pragma unroll
        for (int mt = 0; mt < 4; ++mt) {
          int lr = wm * 64 + mt * 16 + l15;
          float ratio = rs[lr * 2] / rs[lr * 2 + 1];
#pragma unroll
          for (int nt = 0; nt < 4; ++nt) acc[mt][nt] *= ratio;
        }
      }
#pragma unroll
      for (int ks = 0; ks < 2; ++ks) {
        bf16x8 af[4], bfr[4];
#pragma unroll
        for (int mt = 0; mt < 4; ++mt)
          af[mt] = *(const bf16x8*)(As + (wm * 64 + mt * 16 + l15) * LDT + ks * 32 + lq * 8);
#pragma unroll
        for (int nt = 0; nt < 4; ++nt)
          bfr[nt] = *(const bf16x8*)(Bs + (wn * 64 + nt * 16 + l15) * LDT + ks * 32 + lq * 8);
#pragma unroll
        for (int mt = 0; mt < 4; ++mt)
#pragma unroll
          for (int nt = 0; nt < 4; ++nt) acc[mt][nt] = MFMA16(bfr[nt], af[mt], acc[mt][nt]);
      }
    }
#pragma unroll
    for (int mt = 0; mt < 4; ++mt) {
      const int lr = wm * 64 + mt * 16 + l15;
      const size_t row = (size_t)(row0 + lr);
      float sc = 1.f;
      if (EPI == EPI_INPROJ) sc = P.rstd1[row];
      if (EPI == EPI_OUT) sc = rs[lr * 2 + 1];
      if (EPI == EPI_Q) sc = rs[lr * 2];
#pragma unroll
      for (int nt = 0; nt < 4; ++nt) {
        const int col = col0 + wn * 64 + nt * 16 + lq * 4;
        f32x4 v = acc[mt][nt];
        if (EPI == EPI_INPROJ) {
          *(uint2*)(P.p + row * 1536 + col) = make_uint2(pack2(v[0] * sc, v[1] * sc), pack2(v[2] * sc, v[3] * sc));
        } else if (EPI == EPI_Q) {
          *(uint2*)(P.q + row * 2048 + col) = make_uint2(pack2(v[0] * sc, v[1] * sc), pack2(v[2] * sc, v[3] * sc));
        } else if (EPI == EPI_GLU) {
          uint2 gg = *(const uint2*)(P.gs5 + row * 512 + col);
          float4 gb = *(const float4*)(P.glu_b + col);
          float g0 = bflo(gg.x), g1 = bfhi(gg.x), g2 = bflo(gg.y), g3 = bfhi(gg.y);
          float o0 = g0 * sigmoid_(v[0] + gb.x), o1 = g1 * sigmoid_(v[1] + gb.y);
          float o2 = g2 * sigmoid_(v[2] + gb.z), o3 = g3 * sigmoid_(v[3] + gb.w);
          *(uint2*)(P.ycat + row * 1024 + 512 + col) = make_uint2(pack2(o0, o1), pack2(o2, o3));
        } else {
          float4 xv = *(const float4*)(P.x + row * 1024 + col);
          float4 h = make_float4(xv.x + v[0] * sc, xv.y + v[1] * sc, xv.z + v[2] * sc, xv.w + v[3] * sc);
          *(float4*)(P.out + row * 1024 + col) = h;
          *(uint2*)(P.hb + row * 1024 + col) = make_uint2(pack2(h.x, h.y), pack2(h.z, h.w));
        }
      }
    }
  }
}

template <bool FINAL>
__device__ void lru_phase(const Params& P, char* smem) {
  float* xcs = (float*)smem;
  float* a_s = xcs + 64 * 65;
  float* u_s = a_s + 64 * 65;
  float* segA = u_s + 64 * 65;
  float* segH = segA + 256;
  const int tid = threadIdx.x, lane = tid & 63, w = tid >> 6;
  const int l15 = lane & 15, lq = lane >> 4;
  for (int item = blockIdx.x; item < 8192; item += gridDim.x) {
    const int head = item & 7, tile = (item >> 3) & 31, b = item >> 8;
    const int c0 = head * 64, t0 = tile * 64;
    __syncthreads();
    bf16x8 af[2];
    {
      const int tl = w * 16 + l15;
      const int t = t0 + tl;
      const u16* prow = P.p + ((size_t)(b * 2048 + t)) * 1536 + c0;
#pragma unroll
      for (int ks = 0; ks < 2; ++ks) {
        const int ch = ks * 32 + lq * 8;
        float xc[8];
        {
          float4 b0 = *(const float4*)(P.conv_b + c0 + ch), b1 = *(const float4*)(P.conv_b + c0 + ch + 4);
          xc[0] = b0.x; xc[1] = b0.y; xc[2] = b0.z; xc[3] = b0.w; xc[4] = b1.x; xc[5] = b1.y; xc[6] = b1.z; xc[7] = b1.w;
        }
#pragma unroll
        for (int k = 0; k < 4; ++k) {
          if (t - 3 + k >= 0) {
            uint4 v = *(const uint4*)(prow + (k - 3) * 1536 + ch);
            float4 w0 = *(const float4*)(P.conv_w + k * 512 + c0 + ch), w1 = *(const float4*)(P.conv_w + k * 512 + c0 + ch + 4);
            xc[0] += w0.x * bflo(v.x); xc[1] += w0.y * bfhi(v.x); xc[2] += w0.z * bflo(v.y); xc[3] += w0.w * bfhi(v.y);
            xc[4] += w1.x * bflo(v.z); xc[5] += w1.y * bfhi(v.z); xc[6] += w1.z * bflo(v.w); xc[7] += w1.w * bfhi(v.w);
          }
        }
#pragma unroll
        for (int i = 0; i < 8; ++i) xcs[tl * 65 + ch + i] = xc[i];
        unsigned p0 = pack2(xc[0], xc[1]), p1 = pack2(xc[2], xc[3]), p2 = pack2(xc[4], xc[5]), p3 = pack2(xc[6], xc[7]);
        uint4 pk = make_uint4(p0, p1, p2, p3);
        af[ks] = *(bf16x8*)&pk;
      }
    }
    f32x4 accr[4], acci[4];
#pragma unroll
    for (int nt = 0; nt < 4; ++nt) {
      accr[nt] = (f32x4){0.f, 0.f, 0.f, 0.f};
      acci[nt] = (f32x4){0.f, 0.f, 0.f, 0.f};
#pragma unroll
      for (int ks = 0; ks < 2; ++ks) {
        bf16x8 ba = *(const bf16x8*)(P.WaT + head * 4096 + (nt * 16 + l15) * 64 + ks * 32 + lq * 8);
        bf16x8 bx = *(const bf16x8*)(P.WxT + head * 4096 + (nt * 16 + l15) * 64 + ks * 32 + lq * 8);
        accr[nt] = MFMA16(af[ks], ba, accr[nt]);
        acci[nt] = MFMA16(af[ks], bx, acci[nt]);
      }
    }
    __syncthreads();
#pragma unroll
    for (int nt = 0; nt < 4; ++nt) {
      const int ch = nt * 16 + l15;
      const float ba = P.lru_ba[c0 + ch], bx = P.lru_bx[c0 + ch], lam = P.lru_lambda[c0 + ch];
      const float sp = fmaxf(-lam, 0.f) + log1pf(expf(-fabsf(lam)));
#pragma unroll
      for (int r = 0; r < 4; ++r) {
        const int tl = w * 16 + lq * 4 + r;
        float xf = xcs[tl * 65 + ch];
        float rr = sigmoid_(accr[nt][r] + ba), ig = sigmoid_(acci[nt][r] + bx);
        float la = -8.f * rr * sp;
        float a = expf(la);
        float u = sqrtf(-expm1f(2.f * la)) * ig * xf;
        a_s[tl * 65 + ch] = a;
        u_s[tl * 65 + ch] = u;
      }
    }
    __syncthreads();
    {
      const int ch = tid & 63, seg = tid >> 6;
      float Ap = 1.f, Hl = 0.f;
#pragma unroll
      for (int s = 0; s < 16; ++s) {
        float a = a_s[(seg * 16 + s) * 65 + ch], u = u_s[(seg * 16 + s) * 65 + ch];
        Hl = a * Hl + u;
        Ap *= a;
      }
      segA[seg * 64 + ch] = Ap;
      segH[seg * 64 + ch] = Hl;
      __syncthreads();
      if (!FINAL) {
        if (seg == 0) {
          float Aa = 1.f, Hh = 0.f;
#pragma unroll
          for (int s = 0; s < 4; ++s) {
            Hh = segA[s * 64 + ch] * Hh + segH[s * 64 + ch];
            Aa *= segA[s * 64 + ch];
          }
          P.Acar[(b * 32 + tile) * 512 + c0 + ch] = Aa;
          P.Hcar[(b * 32 + tile) * 512 + c0 + ch] = Hh;
        }
      } else {
        float h = P.Hin[(b * 32 + tile) * 512 + c0 + ch];
#pragma unroll
        for (int s = 0; s < 3; ++s)
          if (s < seg) h = segA[s * 64 + ch] * h + segH[s * 64 + ch];
#pragma unroll
        for (int s = 0; s < 16; ++s) {
          const int tl = seg * 16 + s;
          h = a_s[tl * 65 + ch] * h + u_s[tl * 65 + ch];
          const size_t tok = (size_t)(b * 2048 + t0 + tl);
          float gate = bf2f(P.p[tok * 1536 + 512 + c0 + ch]);
          P.ycat[tok * 1024 + c0 + ch] = f2bf(h * gelu_(gate));
        }
      }
    }
  }
}

__device__ void carry_phase(const Params& P) {
  const int gt = blockIdx.x * 256 + threadIdx.x, nth = gridDim.x * 256;
  for (int i = gt; i < 16384 + 65536; i += nth) {
    if (i < 16384) {
      const int b = i >> 9, ch = i & 511;
      float h = 0.f;
      for (int t0 = 0; t0 < 32; t0 += 8) {
        float a[8], hh[8];
#pragma unroll
        for (int j = 0; j < 8; ++j) {
          a[j] = P.Acar[(b * 32 + t0 + j) * 512 + ch];
          hh[j] = P.Hcar[(b * 32 + t0 + j) * 512 + ch];
        }
#pragma unroll
        for (int j = 0; j < 8; ++j) {
          P.Hin[(b * 32 + t0 + j) * 512 + ch] = h;
          h = a[j] * h + hh[j];
        }
      }
    } else {
      const int k = i - 16384;
      const int pp = k & 63, g = (k >> 6) & 31, b = k >> 11;
      const float ar = P.A16[(g * 64 + pp) * 2], ai = P.A16[(g * 64 + pp) * 2 + 1];
      float hr = 0.f, hi = 0.f;
      for (int c0 = 0; c0 < 128; c0 += 8) {
        float er[8], ei[8];
#pragma unroll
        for (int j = 0; j < 8; ++j) {
          size_t base = ((size_t)(b * 128 + c0 + j) * 32 + g) * 128;
          er[j] = P.E[base + pp];
          ei[j] = P.E[base + 64 + pp];
        }
#pragma unroll
        for (int j = 0; j < 8; ++j) {
          size_t base = ((size_t)(b * 128 + c0 + j) * 32 + g) * 128;
          P.Hs[base + pp] = f2bf(hr);
          P.Hs[base + 64 + pp] = f2bf(hi);
          float nr = ar * hr - ai * hi + er[j], ni = ar * hi + ai * hr + ei[j];
          hr = nr; hi = ni;
        }
      }
    }
  }
}

template <bool YPH>
__device__ void s5_phase(const Params& P) {
  constexpr int MTW = YPH ? 4 : 2;
  const int tid = threadIdx.x, lane = tid & 63, w = tid >> 6;
  const int l15 = lane & 15, lq = lane >> 4;
  for (int item = blockIdx.x; item < 2048; item += gridDim.x) {
    const int g = item & 31, cb = item >> 5;
    f32x4 acc[MTW][4];
#pragma unroll
    for (int i = 0; i < MTW; ++i)
#pragma unroll
      for (int j = 0; j < 4; ++j) acc[i][j] = (f32x4){0.f, 0.f, 0.f, 0.f};
    const u16* Am = YPH ? (P.MF + (size_t)g * 256 * 384) : (P.G + (size_t)g * 128 * 256);
    constexpr int LD = YPH ? 384 : 256;
    for (int ks = 0; ks < 8; ++ks) {
      bf16x8 bu[4];
#pragma unroll
      for (int nt = 0; nt < 4; ++nt) {
        const int Ncol = cb * 64 + nt * 16 + l15;
        const int b = Ncol >> 7, c = Ncol & 127;
        const int tau = ks * 2 + (lq >> 1), j0 = (lq & 1) * 8;
        bu[nt] = *(const bf16x8*)(P.p + ((size_t)(b * 2048 + c * 16 + tau)) * 1536 + 1024 + g * 16 + j0);
      }
#pragma unroll
      for (int mt = 0; mt < MTW; ++mt) {
        const int m = (w * MTW + mt) * 16 + l15;
        bf16x8 a = *(const bf16x8*)(Am + (size_t)m * LD + ks * 32 + lq * 8);
#pragma unroll
        for (int nt = 0; nt < 4; ++nt) acc[mt][nt] = MFMA16(a, bu[nt], acc[mt][nt]);
      }
    }
    if (YPH) {
      for (int ks = 0; ks < 4; ++ks) {
        bf16x8 bh[4];
#pragma unroll
        for (int nt = 0; nt < 4; ++nt) {
          const int Ncol = cb * 64 + nt * 16 + l15;
          bh[nt] = *(const bf16x8*)(P.Hs + ((size_t)Ncol * 32 + g) * 128 + ks * 32 + lq * 8);
        }
#pragma unroll
        for (int mt = 0; mt < MTW; ++mt) {
          const int m = (w * MTW + mt) * 16 + l15;
          bf16x8 a = *(const bf16x8*)(Am + (size_t)m * LD + 256 + ks * 32 + lq * 8);
#pragma unroll
          for (int nt = 0; nt < 4; ++nt) acc[mt][nt] = MFMA16(a, bh[nt], acc[mt][nt]);
        }
      }
    }
#pragma unroll
    for (int mt = 0; mt < MTW; ++mt)
#pragma unroll
      for (int nt = 0; nt < 4; ++nt) {
        const int Ncol = cb * 64 + nt * 16 + l15;
        f32x4 v = acc[mt][nt];
        if (!YPH) {
          const int m0 = (w * MTW + mt) * 16 + lq * 4;
          *(float4*)(P.E + ((size_t)Ncol * 32 + g) * 128 + m0) = make_float4(v[0], v[1], v[2], v[3]);
        } else {
          const int b = Ncol >> 7, c = Ncol & 127;
          const int tloc = w * MTW + mt;
          const size_t tok = (size_t)(b * 2048 + c * 16 + tloc);
          *(uint2*)(P.gs5 + tok * 512 + g * 16 + lq * 4) =
              make_uint2(pack2(gelu_(v[0]), gelu_(v[1])), pack2(gelu_(v[2]), gelu_(v[3])));
        }
      }
  }
}

__device__ __forceinline__ void ce(float& hi, float& lo) {
  float a = hi, b = lo;
  asm("v_max_f32 %0, %1, %2" : "=v"(hi) : "v"(a), "v"(b));
  asm("v_min_f32 %0, %1, %2" : "=v"(lo) : "v"(a), "v"(b));
}
__device__ __forceinline__ float vmaxf(float a, float b) {
  float r;
  asm("v_max_f32 %0, %1, %2" : "=v"(r) : "v"(a), "v"(b));
  return r;
}
__device__ __forceinline__ void sort16(float (&v)[16]) {
#pragma unroll
  for (int k = 2; k <= 16; k <<= 1)
#pragma unroll
    for (int j = k >> 1; j > 0; j >>= 1)
#pragma unroll
      for (int i = 0; i < 16; ++i) {
        int l = i ^ j;
        if (l > i) {
          if ((i & k) == 0) ce(v[i], v[l]); else ce(v[l], v[i]);
        }
      }
}
__device__ __forceinline__ void bmerge16(float (&v)[16]) {
#pragma unroll
  for (int j = 8; j > 0; j >>= 1)
#pragma unroll
    for (int i = 0; i < 16; ++i) {
      int l = i ^ j;
      if (l > i) ce(v[i], v[l]);
    }
}
__device__ __forceinline__ void merge_top16(float (&x)[16], const float (&y)[16]) {
#pragma unroll
  for (int i = 0; i < 16; ++i) x[i] = vmaxf(x[i], y[15 - i]);
  bmerge16(x);
}
__device__ __forceinline__ void top16_of_64(f32x16 (&acc)[4], int half, float (&res)[16]) {
  float g[4][16];
#pragma unroll
  for (int mt = 0; mt < 4; ++mt) {
#pragma unroll
    for (int i = 0; i < 16; ++i) {
      unsigned idx = mt * 32 + (i >> 2) * 8 + (i & 3);
      unsigned bits = (__float_as_uint(acc[mt][i]) & 0xffffff80u) | idx | (unsigned)(half * 4);
      g[mt][i] = __uint_as_float(bits);
    }
    sort16(g[mt]);
  }
  merge_top16(g[0], g[1]);
  merge_top16(g[2], g[3]);
  merge_top16(g[0], g[2]);
  float y[16];
#pragma unroll
  for (int i = 0; i < 16; ++i) y[i] = __shfl_xor(g[0][i], 32);
  merge_top16(g[0], y);
#pragma unroll
  for (int i = 0; i < 16; ++i) res[i] = g[0][i];
}
__host__ __device__ constexpr int cand_off(int i) {
  int s = 0;
  for (int q = 0; q < i; ++q) s += 16 / (q + 1);
  return s;
}

__device__ void score_phase(const Params& P, char* smem) {
  const int tid = threadIdx.x, lane = tid & 63, w = tid >> 6;
  const int l31 = lane & 31, half = lane >> 5;
  unsigned char* lut = (unsigned char*)smem + tid * 36;
  for (int item = blockIdx.x; item < 4096; item += gridDim.x) {
    const int head = item & 7, tb = item >> 3;
    const size_t tok = (size_t)tb * 128 + w * 32 + l31;
    float a[16], bl[16];
#pragma unroll
    for (int s = 0; s < 2; ++s) {
      f32x16 acc[4];
#pragma unroll
      for (int mt = 0; mt < 4; ++mt)
#pragma unroll
        for (int i = 0; i < 16; ++i) acc[mt][i] = 0.f;
      const u16* Kb = s ? P.K2b : P.K1b;
      const u16* qrow = P.q + tok * 2048 + head * 256 + s * 128;
#pragma unroll 2
      for (int ks = 0; ks < 8; ++ks) {
        bf16x8 bq = *(const bf16x8*)(qrow + ks * 16 + half * 8);
#pragma unroll
        for (int mt = 0; mt < 4; ++mt) {
          bf16x8 ak = *(const bf16x8*)(Kb + (mt * 32 + l31) * 128 + ks * 16 + half * 8);
          acc[mt] = MFMA32(ak, bq, acc[mt]);
        }
      }
      if (s == 0) top16_of_64(acc, half, a); else top16_of_64(acc, half, bl);
    }
    float va[16], vb[16];
#pragma unroll
    for (int i = 0; i < 16; ++i) {
      va[i] = __uint_as_float(__float_as_uint(a[i]) & 0xffffff80u);
      vb[i] = __uint_as_float(__float_as_uint(bl[i]) & 0xffffff80u);
    }
    float cg4[4][16];
#pragma unroll
    for (int i = 0; i < 4; ++i)
#pragma unroll
      for (int j = 0; j < 16; ++j) cg4[i][j] = __uint_as_float(0xff800000u);
#pragma unroll
    for (int i = 0; i < 16; ++i)
#pragma unroll
      for (int j = 0; j < 16; ++j)
        if ((i + 1) * (j + 1) <= 16) {
          const int pos = cand_off(i) + j;
          float sm = va[i] + vb[j];
          cg4[pos >> 4][pos & 15] = __uint_as_float((__float_as_uint(sm) & 0xffffff00u) | (unsigned)(i * 16 + j));
        }
#pragma unroll
    for (int i = 0; i < 4; ++i) sort16(cg4[i]);
    merge_top16(cg4[0], cg4[1]);
    merge_top16(cg4[2], cg4[3]);
    merge_top16(cg4[0], cg4[2]);
    {
      unsigned* lw = (unsigned*)lut;
#pragma unroll
      for (int i = 0; i < 4; ++i) {
        lw[i] = (__float_as_uint(a[i * 4]) & 127u) | ((__float_as_uint(a[i * 4 + 1]) & 127u) << 8) |
                ((__float_as_uint(a[i * 4 + 2]) & 127u) << 16) | ((__float_as_uint(a[i * 4 + 3]) & 127u) << 24);
        lw[4 + i] = (__float_as_uint(bl[i * 4]) & 127u) | ((__float_as_uint(bl[i * 4 + 1]) & 127u) << 8) |
                    ((__float_as_uint(bl[i * 4 + 2]) & 127u) << 16) | ((__float_as_uint(bl[i * 4 + 3]) & 127u) << 24);
      }
    }
    float sc[16];
    int ee[16];
    const float mx = __uint_as_float(__float_as_uint(cg4[0][0]) & 0xffffff00u);
    float ssum = 0.f;
#pragma unroll
    for (int k = 0; k < 16; ++k) {
      unsigned bits = __float_as_uint(cg4[0][k]);
      unsigned code = bits & 255u;
      float v = __uint_as_float(bits & 0xffffff00u);
      sc[k] = __expf(v - mx);
      ssum += sc[k];
      int i1 = lut[code >> 4], i2 = lut[16 + (code & 15u)];
      ee[k] = i1 * 128 + i2;
    }
    const float inv = 1.f / ssum;
    if (half == 0) {
      int4* dst = (int4*)(P.eidx + tok * 128 + head * 16);
#pragma unroll
      for (int i = 0; i < 4; ++i) dst[i] = make_int4(ee[i * 4], ee[i * 4 + 1], ee[i * 4 + 2], ee[i * 4 + 3]);
    } else {
      float4* dst = (float4*)(P.gw + tok * 128 + head * 16);
#pragma unroll
      for (int i = 0; i < 4; ++i)
        dst[i] = make_float4(sc[i * 4] * inv, sc[i * 4 + 1] * inv, sc[i * 4 + 2] * inv, sc[i * 4 + 3] * inv);
    }
  }
}

__device__ __forceinline__ float dot8(uint4 u, const unsigned* xp, float acc) {
  acc += bflo(u.x) * bflo(xp[0]); acc += bfhi(u.x) * bfhi(xp[0]);
  acc += bflo(u.y) * bflo(xp[1]); acc += bfhi(u.y) * bfhi(xp[1]);
  acc += bflo(u.z) * bflo(xp[2]); acc += bfhi(u.z) * bfhi(xp[2]);
  acc += bflo(u.w) * bflo(xp[3]); acc += bfhi(u.w) * bfhi(xp[3]);
  return acc;
}
__device__ __forceinline__ void axpy8(float* o, float wgt, uint4 v) {
  o[0] += wgt * bflo(v.x); o[1] += wgt * bfhi(v.x);
  o[2] += wgt * bflo(v.y); o[3] += wgt * bfhi(v.y);
  o[4] += wgt * bflo(v.z); o[5] += wgt * bfhi(v.z);
  o[6] += wgt * bflo(v.w); o[7] += wgt * bfhi(v.w);
}

__device__ void peer_phase(const Params& P) {
  const int tid = threadIdx.x, lane = tid & 63, w = tid >> 6;
  const int gwv = blockIdx.x * 4 + w, nw = gridDim.x * 4;
  for (int tok = gwv; tok < T_TOK; tok += nw) {
    float* hrow = P.out + (size_t)tok * 1024;
    float h[16];
    float ss = 0.f;
#pragma unroll
    for (int c = 0; c < 2; ++c) {
      float4 v0 = *(const float4*)(hrow + c * 512 + lane * 8), v1 = *(const float4*)(hrow + c * 512 + lane * 8 + 4);
      h[c * 8 + 0] = v0.x; h[c * 8 + 1] = v0.y; h[c * 8 + 2] = v0.z; h[c * 8 + 3] = v0.w;
      h[c * 8 + 4] = v1.x; h[c * 8 + 5] = v1.y; h[c * 8 + 6] = v1.z; h[c * 8 + 7] = v1.w;
    }
#pragma unroll
    for (int i = 0; i < 16; ++i) ss += h[i] * h[i];
    ss = wsum(ss);
    const float rstd2 = rsqrtf(ss * (1.f / 1024.f) + EPSF);
    unsigned xp[8];
#pragma unroll
    for (int c = 0; c < 2; ++c) {
      float4 g0 = *(const float4*)(P.norm2_g + c * 512 + lane * 8), g1 = *(const float4*)(P.norm2_g + c * 512 + lane * 8 + 4);
      xp[c * 4 + 0] = pack2(h[c * 8 + 0] * rstd2 * g0.x, h[c * 8 + 1] * rstd2 * g0.y);
      xp[c * 4 + 1] = pack2(h[c * 8 + 2] * rstd2 * g0.z, h[c * 8 + 3] * rstd2 * g0.w);
      xp[c * 4 + 2] = pack2(h[c * 8 + 4] * rstd2 * g1.x, h[c * 8 + 5] * rstd2 * g1.y);
      xp[c * 4 + 3] = pack2(h[c * 8 + 6] * rstd2 * g1.z, h[c * 8 + 7] * rstd2 * g1.w);
    }
    const int e_lo = P.eidx[(size_t)tok * 128 + lane], e_hi = P.eidx[(size_t)tok * 128 + 64 + lane];
    const float g_lo = P.gw[(size_t)tok * 128 + lane], g_hi = P.gw[(size_t)tok * 128 + 64 + lane];
    float o[16];
#pragma unroll
    for (int i = 0; i < 16; ++i) o[i] = 0.f;
    for (int k0 = 0; k0 < 128; k0 += 4) {
      int e[4]; float gk[4];
      uint4 u0[4], u1[4], v0[4], v1[4];
#pragma unroll
      for (int j = 0; j < 4; ++j) {
        const int k = k0 + j;
        e[j] = (k0 < 64) ? __shfl(e_lo, k) : __shfl(e_hi, k - 64);
        gk[j] = (k0 < 64) ? __shfl(g_lo, k) : __shfl(g_hi, k - 64);
        const u16* ur = P.Ub + (size_t)e[j] * 1024 + lane * 8;
        const u16* vr = P.Vb + (size_t)e[j] * 1024 + lane * 8;
        u0[j] = *(const uint4*)ur; u1[j] = *(const uint4*)(ur + 512);
        v0[j] = *(const uint4*)vr; v1[j] = *(const uint4*)(vr + 512);
      }
      float d[4];
#pragma unroll
      for (int j = 0; j < 4; ++j) {
        d[j] = dot8(u0[j], xp, 0.f);
        d[j] = dot8(u1[j], xp + 4, d[j]);
      }
#pragma unroll
      for (int o2 = 32; o2; o2 >>= 1)
#pragma unroll
        for (int j = 0; j < 4; ++j) d[j] += __shfl_xor(d[j], o2);
#pragma unroll
      for (int j = 0; j < 4; ++j) {
        float wgt = gelu_(d[j]) * gk[j];
        axpy8(o, wgt, v0[j]);
        axpy8(o + 8, wgt, v1[j]);
      }
    }
    float ss2 = 0.f;
#pragma unroll
    for (int i = 0; i < 16; ++i) { h[i] += o[i]; ss2 += h[i] * h[i]; }
    ss2 = wsum(ss2);
    const float rf = rsqrtf(ss2 * (1.f / 1024.f) + EPSF);
#pragma unroll
    for (int c = 0; c < 2; ++c) {
      float4 g0 = *(const float4*)(P.normf_g + c * 512 + lane * 8), g1 = *(const float4*)(P.normf_g + c * 512 + lane * 8 + 4);
      *(float4*)(hrow + c * 512 + lane * 8) =
          make_float4(h[c * 8 + 0] * rf * g0.x, h[c * 8 + 1] * rf * g0.y, h[c * 8 + 2] * rf * g0.z, h[c * 8 + 3] * rf * g0.w);
      *(float4*)(hrow + c * 512 + lane * 8 + 4) =
          make_float4(h[c * 8 + 4] * rf * g1.x, h[c * 8 + 5] * rf * g1.y, h[c * 8 + 6] * rf * g1.z, h[c * 8 + 7] * rf * g1.w);
    }
  }
}

#define SMEM_BYTES 53248

template <int PH>
__device__ __forceinline__ void run_phase(const Params& P, char* smem) {
  if (PH == 0) phase_prep(P, smem);
  if (PH == 1) gemm_phase<EPI_INPROJ>(P, smem, P.xb, P.WinT, T_TOK, 1536, 1024);
  if (PH == 2) { lru_phase<false>(P, smem); s5_phase<false>(P); }
  if (PH == 3) carry_phase(P);
  if (PH == 4) { lru_phase<true>(P, smem); s5_phase<true>(P); }
  if (PH == 5) gemm_phase<EPI_GLU>(P, smem, P.gs5, P.GluT, T_TOK, 512, 512);
  if (PH == 6) gemm_phase<EPI_OUT>(P, smem, P.ycat, P.WoutT, T_TOK, 1024, 1024);
  if (PH == 7) gemm_phase<EPI_Q>(P, smem, P.hb, P.WqT, T_TOK, 2048, 1024);
  if (PH == 8) score_phase(P, smem);
  if (PH == 9) peer_phase(P);
}

template <int LO, int HI>
__global__ void __launch_bounds__(256, 2) mk(Params P) {
  __shared__ __attribute__((aligned(16))) char smem[SMEM_BYTES];
  cg::grid_group grid = cg::this_grid();
#define PHASE(n) if (LO <= n && n <= HI) { run_phase<n>(P, smem); if (n < HI) grid.sync(); }
  PHASE(0) PHASE(1) PHASE(2) PHASE(3) PHASE(4) PHASE(5) PHASE(6) PHASE(7) PHASE(8) PHASE(9)
}

extern "C" void kernel_launch(void* const* d_in, const int* in_sizes, int n_in, void* d_out, int out_size,
                              void* d_ws, size_t ws_size, hipStream_t stream) {
  Params P{};
  const float** pin = (const float**)&P;
  for (int i = 0; i < 30; ++i) pin[i] = (const float*)d_in[i];
  P.out = (float*)d_out;
  char* ws = (char*)d_ws;
  size_t off = 0;
  auto take = [&](size_t bytes) { char* r = ws + off; off += (bytes + 255) & ~(size_t)255; return r; };
  const size_t MB = 1024 * 1024;
  char* RA = take(128 * MB);
  char* RB = take(256 * MB);
  char* RC = take(128 * MB);
  char* RD = take(64 * MB);
  P.xb = (u16*)RA; P.ycat = (u16*)RA;
  P.p = (u16*)RB; P.q = (u16*)RB;
  P.E = (float*)RC; P.Hs = (u16*)(RC + 64 * MB); P.hb = (u16*)RC;
  P.gs5 = (u16*)RD; P.eidx = (int*)RD; P.gw = (float*)(RD + 32 * MB);
  P.Ub = (u16*)take(32 * MB); P.Vb = (u16*)take(32 * MB);
  P.WinT = (u16*)take(1536 * 1024 * 2); P.GluT = (u16*)take(512 * 512 * 2);
  P.WoutT = (u16*)take(1024 * 1024 * 2); P.WqT = (u16*)take(2048 * 1024 * 2);
  P.K1b = (u16*)take(128 * 128 * 2); P.K2b = (u16*)take(128 * 128 * 2);
  P.WaT = (u16*)take(8 * 4096 * 2); P.WxT = (u16*)take(8 * 4096 * 2);
  P.MF = (u16*)take(32 * 256 * 384 * 2); P.G = (u16*)take(32 * 128 * 256 * 2);
  P.rstd1 = (float*)take(T_TOK * 4); P.A16 = (float*)take(32 * 64 * 2 * 4);
  P.Acar = (float*)take(32 * 32 * 512 * 4); P.Hcar = (float*)take(32 * 32 * 512 * 4); P.Hin = (float*)take(32 * 32 * 512 * 4);

  static int grid_blocks = 0;
#if ONE_LAUNCH
  if (!grid_blocks) {
    int dev = 0, cus = 0, per_cu = 0;
    (void)hipGetDevice(&dev);
    (void)hipDeviceGetAttribute(&cus, hipDeviceAttributeMultiprocessorCount, dev);
    (void)hipOccupancyMaxActiveBlocksPerMultiprocessor(&per_cu, mk<0, NPHASE - 1>, 256, 0);
    if (per_cu > 2) per_cu = 2;
    if (per_cu < 1) per_cu = 1;
    grid_blocks = cus * per_cu;
  }
  void* args[] = {&P};
  hipError_t e = hipLaunchCooperativeKernel((void*)mk<0, NPHASE - 1>, dim3(grid_blocks), dim3(256), args, 0, stream);
  if (e != hipSuccess) fprintf(stderr, "cooperative launch failed: %s (grid %d)\n", hipGetErrorString(e), grid_blocks);
#else
  if (!grid_blocks) {
    int dev = 0, cus = 0;
    (void)hipGetDevice(&dev);
    (void)hipDeviceGetAttribute(&cus, hipDeviceAttributeMultiprocessorCount, dev);
    grid_blocks = cus * 2;
  }
  mk<0, 0><<<grid_blocks, 256, 0, stream>>>(P);
  mk<1, 1><<<grid_blocks, 256, 0, stream>>>(P);
  mk<2, 2><<<grid_blocks, 256, 0, stream>>>(P);
  mk<3, 3><<<grid_blocks, 256, 0, stream>>>(P);
  mk<4, 4><<<grid_blocks, 256, 0, stream>>>(P);
  mk<5, 5><<<grid_blocks, 256, 0, stream>>>(P);
  mk<6, 6><<<grid_blocks, 256, 0, stream>>>(P);
  mk<7, 7><<<grid_blocks, 256, 0, stream>>>(P);
  mk<8, 8><<<grid_blocks, 256, 0, stream>>>(P);
  mk<9, 9><<<grid_blocks, 256, 0, stream>>>(P);
#endif
}
```

```cpp
#include <hip/hip_runtime.h>
#include <hip/hip_cooperative_groups.h>
#include <cstdio>
namespace cg = cooperative_groups;

typedef unsigned short u16;
using bf16x8 = __attribute__((ext_vector_type(8))) short;
using f32x4 = __attribute__((ext_vector_type(4))) float;
using f32x16 = __attribute__((ext_vector_type(16))) float;

#ifndef ONE_LAUNCH
#define ONE_LAUNCH 1
#endif

#define T_TOK 65536
#define EPSF 1e-6f
#define NPHASE 13

struct Params {
  const float *x, *norm1_g, *w_in, *conv_w, *conv_b, *lru_wa, *lru_ba, *lru_wx, *lru_bx, *lru_lambda;
  const float *s5_lre, *s5_lim, *s5_logdt, *s5_bre, *s5_bim, *s5_cre, *s5_cim, *s5_d, *glu_w, *glu_b;
  const float *gnorm_lru, *gnorm_s5, *w_out, *norm2_g, *wq, *k1, *k2, *pu, *pv, *normf_g;
  float* out;
  u16 *xb, *WinT, *GluT, *WoutT, *WqT, *K1b, *K2b, *Ub, *Vb, *WaT, *WxT, *MF, *G, *p, *Hs, *ycat, *gs5, *hb, *q;
  float *rstd1, *A16, *Acar, *Hcar, *Hin, *E, *gw, *suv, *su, *sv, *ssa, *ssb, *ss2, *ssf, *wact, *part, *spv, *t16;
  int* eidx;
  unsigned char *U8, *V8;
  unsigned* bar;
  unsigned* au;
  int* rank;
};

__device__ __forceinline__ u16 f2bf(float f) {
  unsigned u = __float_as_uint(f);
  u += 0x7fffu + ((u >> 16) & 1u);
  return (u16)(u >> 16);
}
__device__ __forceinline__ float bf2f(u16 h) { return __uint_as_float(((unsigned)h) << 16); }
__device__ __forceinline__ unsigned pack2(float a, float b) { return (unsigned)f2bf(a) | (((unsigned)f2bf(b)) << 16); }
__device__ __forceinline__ float bflo(unsigned u) { return __uint_as_float(u << 16); }
__device__ __forceinline__ float bfhi(unsigned u) { return __uint_as_float(u & 0xffff0000u); }
__device__ __forceinline__ float sigmoid_(float x) { return __builtin_amdgcn_rcpf(1.f + __expf(-x)); }
__device__ __forceinline__ float gelu_(float x) {
  float z = 0.7978845608028654f * (x + 0.044715f * x * x * x);
  return x * __builtin_amdgcn_rcpf(1.f + __expf(-2.f * z));
}
__device__ __forceinline__ float wsum(float v) {
#pragma unroll
  for (int o = 32; o; o >>= 1) v += __shfl_xor(v, o);
  return v;
}
__device__ __forceinline__ float sq8(uint4 v) {
  float s = 0.f, t;
  t = bflo(v.x); s += t * t; t = bfhi(v.x); s += t * t;
  t = bflo(v.y); s += t * t; t = bfhi(v.y); s += t * t;
  t = bflo(v.z); s += t * t; t = bfhi(v.z); s += t * t;
  t = bflo(v.w); s += t * t; t = bfhi(v.w); s += t * t;
  return s;
}
typedef unsigned u32x4e __attribute__((ext_vector_type(4)));
typedef float f32x2e __attribute__((ext_vector_type(2)));
__device__ __forceinline__ uint4 nt_ld_u4(const void* p) { u32x4e v = __builtin_nontemporal_load((const u32x4e*)p); return make_uint4(v.x, v.y, v.z, v.w); }
__device__ __forceinline__ float4 nt_ld_f4(const void* p) { f32x4 v = __builtin_nontemporal_load((const f32x4*)p); return make_float4(v.x, v.y, v.z, v.w); }
__device__ __forceinline__ float2 nt_ld_f2(const void* p) { f32x2e v = __builtin_nontemporal_load((const f32x2e*)p); return make_float2(v.x, v.y); }
__device__ __forceinline__ void nt_st_f2(float2 v, void* p) { f32x2e t = {v.x, v.y}; __builtin_nontemporal_store(t, (f32x2e*)p); }
#define MFMA16(a, b, c) __builtin_amdgcn_mfma_f32_16x16x32_bf16(a, b, c, 0, 0, 0)
#define MFMA32(a, b, c) __builtin_amdgcn_mfma_f32_32x32x16_bf16(a, b, c, 0, 0, 0)

__device__ void transpose_fold(const float* src, const float* g, u16* dst, int ldd, int K, int N, char* smem) {
  float* tl = (float*)smem;
  const int tid = threadIdx.x;
  const int tk = K / 64, tn = N / 64;
  for (int t = blockIdx.x; t < tk * tn; t += gridDim.x) {
    int k0 = (t / tn) * 64, n0 = (t % tn) * 64;
    __syncthreads();
    for (int i = 0; i < 16; ++i) {
      int k = (tid >> 6) + i * 4, n = tid & 63;
      float v = src[(size_t)(k0 + k) * N + n0 + n];
      if (g) v *= g[k0 + k];
      tl[k * 65 + n] = v;
    }
    __syncthreads();
    for (int i = 0; i < 16; ++i) {
      int n = (tid >> 6) + i * 4, k = tid & 63;
      dst[(size_t)(n0 + n) * ldd + k0 + k] = f2bf(tl[k * 65 + n]);
    }
  }
}

__device__ void s5_prep(const Params& P, char* smem, int g) {
  float* apw = (float*)smem;
  float* bb = apw + 17 * 64 * 2;
  float* kk = bb + 64 * 16 * 2;
  const int tid = threadIdx.x;
  __syncthreads();
  if (tid < 64) {
    int pp = tid;
    float lr = P.s5_lre[g * 64 + pp], li = P.s5_lim[g * 64 + pp];
    float dt = expf(P.s5_logdt[g]);
    float mag = expf(lr * dt);
    double ang = (double)li * (double)dt;
    double kq = rint(ang * 0.15915494309189535);
    float r = (float)(ang - kq * 6.283185307179586);
    float sn = __sinf(r), cs = __cosf(r);
    {
      sn = sinf(r); cs = cosf(r);
    }
    float are = mag * cs, aim = mag * sn;
    float den = lr * lr + li * li;
    float nre = are - 1.f, nim = aim;
    float zre = (nre * lr + nim * li) / den, zim = (nim * lr - nre * li) / den;
    float pr = 1.f, pi = 0.f;
    for (int d = 0; d <= 16; ++d) {
      apw[(d * 64 + pp) * 2] = pr; apw[(d * 64 + pp) * 2 + 1] = pi;
      float nr = pr * are - pi * aim, ni = pr * aim + pi * are;
      pr = nr; pi = ni;
    }
    P.A16[(g * 64 + pp) * 2] = apw[(16 * 64 + pp) * 2];
    P.A16[(g * 64 + pp) * 2 + 1] = apw[(16 * 64 + pp) * 2 + 1];
    for (int j = 0; j < 16; ++j) {
      float br = P.s5_bre[(g * 64 + pp) * 16 + j], bi = P.s5_bim[(g * 64 + pp) * 16 + j];
      bb[(pp * 16 + j) * 2] = zre * br - zim * bi;
      bb[(pp * 16 + j) * 2 + 1] = zre * bi + zim * br;
    }
  }
  __syncthreads();
  for (int rr = 0; rr < 16; ++rr) {
    int e = tid + rr * 256;
    int d = e >> 8, i = (e >> 4) & 15, j = e & 15;
    float s = 0.f;
    for (int pp = 0; pp < 64; ++pp) {
      float cr = P.s5_cre[(g * 16 + i) * 64 + pp], ci = P.s5_cim[(g * 16 + i) * 64 + pp];
      float ar = apw[(d * 64 + pp) * 2], ai = apw[(d * 64 + pp) * 2 + 1];
      float xr = cr * ar - ci * ai, xi = cr * ai + ci * ar;
      s += xr * bb[(pp * 16 + j) * 2] - xi * bb[(pp * 16 + j) * 2 + 1];
    }
    kk[e] = s;
  }
  __syncthreads();
  u16* MFg = P.MF + (size_t)g * 256 * 384;
  for (int it = 0; it < 192; ++it) {
    int e = tid + it * 256;
    int m = e / 192, cp = (e % 192) * 2;
    int t = m >> 4, i = m & 15;
    float v[2];
    for (int q = 0; q < 2; ++q) {
      int col = cp + q;
      float val;
      if (col < 256) {
        int sg = col >> 4, j = col & 15;
        val = (sg <= t) ? kk[((t - sg) * 16 + i) * 16 + j] : 0.f;
        if (sg == t && i == j) val += P.s5_d[g * 16 + i];
      } else {
        int pc = col - 256, pp = pc & 63, im = pc >> 6;
        float cr = P.s5_cre[(g * 16 + i) * 64 + pp], ci = P.s5_cim[(g * 16 + i) * 64 + pp];
        float ar = apw[((t + 1) * 64 + pp) * 2], ai = apw[((t + 1) * 64 + pp) * 2 + 1];
        float xr = cr * ar - ci * ai, xi = cr * ai + ci * ar;
        val = im ? -xi : xr;
      }
      v[q] = val;
    }
    *(unsigned*)(MFg + (size_t)m * 384 + cp) = pack2(v[0], v[1]);
  }
  u16* Gg = P.G + (size_t)g * 128 * 256;
  for (int it = 0; it < 64; ++it) {
    int e = tid + it * 256;
    int row = e >> 7, cp = (e & 127) * 2;
    int im = row >> 6, pp = row & 63;
    float v[2];
    for (int q = 0; q < 2; ++q) {
      int col = cp + q, sg = col >> 4, j = col & 15;
      float ar = apw[((15 - sg) * 64 + pp) * 2], ai = apw[((15 - sg) * 64 + pp) * 2 + 1];
      float br = bb[(pp * 16 + j) * 2], bi = bb[(pp * 16 + j) * 2 + 1];
      v[q] = im ? (ar * bi + ai * br) : (ar * br - ai * bi);
    }
    *(unsigned*)(Gg + (size_t)row * 256 + cp) = pack2(v[0], v[1]);
  }
}

__device__ void wqk_prep(const Params& P, char* smem) {
  float* Wt = (float*)smem;
  float* Kt = Wt + 64 * 129;
  const int tid = threadIdx.x;
  for (int item = blockIdx.x; item < 512; item += gridDim.x) {
    const int hs = item >> 5, kb = (item >> 1) & 15, kh = item & 1;
    const int cbase = (hs >> 1) * 256 + (hs & 1) * 128, k0 = kb * 64;
    __syncthreads();
    for (int i = 0; i < 32; ++i) {
      const int idx = tid + i * 256, row = idx >> 7, col = idx & 127;
      Wt[row * 129 + col] = P.wq[(size_t)(k0 + row) * 2048 + cbase + col] * P.norm2_g[k0 + row];
      const int ko = kh * 64 * 128 + idx;
      Kt[idx] = (hs & 1) ? P.k2[ko] : P.k1[ko];
    }
    __syncthreads();
    const int kk = tid & 63, q = tid >> 6;
    float acc[16];
#pragma unroll
    for (int i = 0; i < 16; ++i) acc[i] = 0.f;
    for (int d = 0; d < 128; d += 4) {
      const float w0 = Wt[kk * 129 + d], w1 = Wt[kk * 129 + d + 1], w2 = Wt[kk * 129 + d + 2], w3 = Wt[kk * 129 + d + 3];
#pragma unroll
      for (int i = 0; i < 16; ++i) {
        const float4 kv = *(const float4*)(Kt + (q * 16 + i) * 128 + d);
        acc[i] += w0 * kv.x + w1 * kv.y + w2 * kv.z + w3 * kv.w;
      }
    }
#pragma unroll
    for (int i = 0; i < 16; ++i) P.WqT[(size_t)(hs * 128 + kh * 64 + q * 16 + i) * 1024 + k0 + kk] = f2bf(acc[i]);
  }
}

__device__ void phase_prep(const Params& P, char* smem) {
  const int tid = threadIdx.x, lane = tid & 63, w = tid >> 6;
  {
    int g = (int)gridDim.x - 1 - (int)blockIdx.x;
    if (g < 32) s5_prep(P, smem, g);
  }
  for (int i = blockIdx.x * 256 + tid; i < 512; i += gridDim.x * 256) { const float lam = P.lru_lambda[i]; P.spv[i] = fmaxf(-lam, 0.f) + log1pf(expf(-fabsf(lam))); }
  for (int i = blockIdx.x * 256 + tid; i < T_TOK; i += gridDim.x * 256) { P.ssa[i] = 0.f; P.ssb[i] = 0.f; P.ss2[i] = 0.f; P.ssf[i] = 0.f; }
  const bool split = gridDim.x > 64;
  const bool bulk = !split || (int)blockIdx.x < (int)gridDim.x - 32;
  const int nbulk = split ? (int)gridDim.x - 32 : (int)gridDim.x;
  if (bulk) {
    const int gwv = blockIdx.x * 4 + w, nw = nbulk * 4;
    for (int r = gwv; r < T_TOK; r += nw) {
      const float4* src = (const float4*)(P.x + (size_t)r * 1024);
      float4 v[4];
      float ss = 0.f;
#pragma unroll
      for (int i = 0; i < 4; ++i) {
        v[i] = src[i * 64 + lane];
        ss += v[i].x * v[i].x + v[i].y * v[i].y + v[i].z * v[i].z + v[i].w * v[i].w;
      }
      ss = wsum(ss);
      if (lane == 0) P.rstd1[r] = rsqrtf(ss * (1.f / 1024.f) + EPSF);
      uint2* dst = (uint2*)(P.xb + (size_t)r * 1024);
#pragma unroll
      for (int i = 0; i < 4; ++i) dst[i * 64 + lane] = make_uint2(pack2(v[i].x, v[i].y), pack2(v[i].z, v[i].w));
    }
  }
  {
    const int gwv = blockIdx.x * 4 + w, nw = nbulk * 4;
    if (bulk)
    for (int r = gwv; r < 32768; r += nw) {
      const int isv = r >> 14, e = r & 16383;
      const float* src = (isv ? P.pv : P.pu) + (size_t)e * 1024 + lane * 16;
      float4 v[4];
      float m = 0.f;
#pragma unroll
      for (int i = 0; i < 4; ++i) {
        {
          float4 t = *(const float4*)(src + i * 4);
          const float4 g2 = *(const float4*)(P.norm2_g + lane * 16 + i * 4);
          v[i] = isv ? t : make_float4(t.x * g2.x, t.y * g2.y, t.z * g2.z, t.w * g2.w);
        }
        m = fmaxf(m, fmaxf(fmaxf(fabsf(v[i].x), fabsf(v[i].y)), fmaxf(fabsf(v[i].z), fabsf(v[i].w))));
      }
#pragma unroll
      for (int o = 32; o; o >>= 1) m = fmaxf(m, __shfl_xor(m, o));
      int ex = (int)((__float_as_uint(m) >> 23) & 255u) - 127;
      ex = ex < -100 ? -100 : (ex > 100 ? 100 : ex);
      const float sc = __uint_as_float((unsigned)(127 + 7 - ex) << 23);
      const float isc = __uint_as_float((unsigned)(127 - 7 + ex) << 23);
      unsigned pk[4];
#pragma unroll
      for (int i = 0; i < 4; ++i) {
        int t = __builtin_amdgcn_cvt_pk_fp8_f32(v[i].x * sc, v[i].y * sc, 0, false);
        t = __builtin_amdgcn_cvt_pk_fp8_f32(v[i].z * sc, v[i].w * sc, t, true);
        pk[i] = (unsigned)t;
      }
      unsigned char* dst = isv ? (P.V8 + (size_t)(lane >> 3) * (16384 * 128) + (size_t)e * 128 + (lane & 7) * 16)
                               : (P.U8 + (size_t)(lane >> 3) * (16384 * 128) + (size_t)e * 128 + (lane & 7) * 16);
      *(uint4*)dst = make_uint4(pk[0], pk[1], pk[2], pk[3]);
      if (lane == 0) { if (isv) P.sv[e] = isc; else P.su[e] = isc; }
    }
    size_t gt = (size_t)blockIdx.x * 256 + tid, nt = (size_t)gridDim.x * 256;
    for (size_t i = gt; i < 4096; i += nt) {
      float4 a = ((const float4*)P.k1)[i];
      ((uint2*)P.K1b)[i] = make_uint2(pack2(a.x, a.y), pack2(a.z, a.w));
      float4 b = ((const float4*)P.k2)[i];
      ((uint2*)P.K2b)[i] = make_uint2(pack2(b.x, b.y), pack2(b.z, b.w));
    }
  }
  transpose_fold(P.w_in, P.norm1_g, P.WinT, 1024, 1024, 1536, smem);
  transpose_fold(P.glu_w, nullptr, P.GluT, 512, 512, 512, smem);
  transpose_fold(P.w_out, P.gnorm_lru, P.WoutT, 1024, 512, 1024, smem);
  transpose_fold(P.w_out + 512 * 1024, P.gnorm_s5, P.WoutT + 512, 1024, 512, 1024, smem);
  wqk_prep(P, smem);
  for (int h = 0; h < 8; ++h) {
    transpose_fold(P.lru_wa + h * 4096, nullptr, P.WaT + h * 4096, 64, 64, 64, smem);
    transpose_fold(P.lru_wx + h * 4096, nullptr, P.WxT + h * 4096, 64, 64, 64, smem);
  }
}

__device__ __forceinline__ void ce(float& hi, float& lo) {
  float a = hi, b = lo;
  asm("v_max_f32 %0, %1, %2" : "=v"(hi) : "v"(a), "v"(b));
  asm("v_min_f32 %0, %1, %2" : "=v"(lo) : "v"(a), "v"(b));
}
__device__ __forceinline__ float vmaxf(float a, float b) {
  float r;
  asm("v_max_f32 %0, %1, %2" : "=v"(r) : "v"(a), "v"(b));
  return r;
}
__device__ __forceinline__ void sort16(float (&v)[16]) {
#pragma unroll
  for (int k = 2; k <= 16; k <<= 1)
#pragma unroll
    for (int j = k >> 1; j > 0; j >>= 1)
#pragma unroll
      for (int i = 0; i < 16; ++i) {
        int l = i ^ j;
        if (l > i) {
          if ((i & k) == 0) ce(v[i], v[l]); else ce(v[l], v[i]);
        }
      }
}
__device__ __forceinline__ void bmerge16(float (&v)[16]) {
#pragma unroll
  for (int j = 8; j > 0; j >>= 1)
#pragma unroll
    for (int i = 0; i < 16; ++i) {
      int l = i ^ j;
      if (l > i) ce(v[i], v[l]);
    }
}
__device__ __forceinline__ void merge_top16(float (&x)[16], const float (&y)[16]) {
#pragma unroll
  for (int i = 0; i < 16; ++i) x[i] = vmaxf(x[i], y[15 - i]);
  bmerge16(x);
}

enum { EPI_INPROJ = 0, EPI_GLU = 1, EPI_OUT = 2, EPI_Q = 3 };
#define LDT 64

template <int EPI>
__device__ void gemm_phase(const Params& P, char* smem, const u16* __restrict__ A, const u16* __restrict__ Bt,
                           int M, int N, int K) {
  constexpr int TE = 128 * LDT;
  u16* AsB = (u16*)smem;
  u16* BsB = AsB + 2 * TE;
  const int tid = threadIdx.x, lane = tid & 63, w = tid >> 6, wm = w >> 1, wn = w & 1;
  const int l15 = lane & 15, lq = lane >> 4;
  const int NT = N / 128, MT = M / 128, ntiles = MT * NT, nk = K / 64;
  int vb = blockIdx.x;
  if ((gridDim.x & 7) == 0) vb = (blockIdx.x & 7) * (gridDim.x >> 3) + (blockIdx.x >> 3);
  const int ldr = tid >> 3, ldc = (tid & 7) * 8;
  const int ldsw = ((tid & 7) ^ ((ldr >> 1) & 7)) * 8;
  const int rsw = (l15 >> 1) & 7;
  const int cnt = (vb < ntiles) ? (ntiles - vb + (int)gridDim.x - 1) / (int)gridDim.x : 0;
  const int total = cnt * nk;
  if (total == 0) return;
  f32x4 acc[4][4];
#pragma unroll
  for (int i = 0; i < 4; ++i)
#pragma unroll
    for (int j = 0; j < 4; ++j) acc[i][j] = (f32x4){0.f, 0.f, 0.f, 0.f};
  uint4 pa0, pa1, pa2, pa3, pb0, pb1, pb2, pb3, qa0, qa1, qa2, qa3, qb0, qb1, qb2, qb3;
  const u16 *Ag, *Bg;
#define STEP_ADDR(st) { int st_ = (st) < total ? (st) : total - 1; int ti_ = st_ / nk, kk_ = st_ - ti_ * nk; \
      int tl_ = vb + ti_ * (int)gridDim.x; int r0_ = (tl_ / NT) * 128, c0_ = (tl_ % NT) * 128; \
      { const int hm_ = (nk >> 1) - 1; kk_ = (kk_ & ~hm_) | ((kk_ + (tl_ % NT) + (tl_ / NT)) & hm_); } \
      Ag = A + (size_t)(r0_ + ldr) * K + ldc + kk_ * 64; Bg = Bt + (size_t)(c0_ + ldr) * K + ldc + kk_ * 64; }
#define GLD2(S, i) { S##a##i = *(const uint4*)(Ag + (size_t)(32 * i) * K); S##b##i = *(const uint4*)(Bg + (size_t)(32 * i) * K); }
#define GLDS(S, st) { STEP_ADDR(st) GLD2(S, 0) GLD2(S, 1) GLD2(S, 2) GLD2(S, 3) }
#define LST2(S, i, buf) { *(uint4*)(AsB + (buf) * TE + (ldr + 32 * i) * LDT + ldsw) = S##a##i; \
                          *(uint4*)(BsB + (buf) * TE + (ldr + 32 * i) * LDT + ldsw) = S##b##i; }
#define LSTS(S, buf) { LST2(S, 0, buf) LST2(S, 1, buf) LST2(S, 2, buf) LST2(S, 3, buf) }
#define COMPUTE(buf) { \
      const u16* As_ = AsB + (buf) * TE; const u16* Bs_ = BsB + (buf) * TE; \
      _Pragma("unroll") for (int ks = 0; ks < 2; ++ks) { \
        bf16x8 af[4], bfr[4]; \
        _Pragma("unroll") for (int mt = 0; mt < 4; ++mt) \
          af[mt] = *(const bf16x8*)(As_ + (wm * 64 + mt * 16 + l15) * LDT + (((ks * 4 + lq) ^ rsw) * 8)); \
        _Pragma("unroll") for (int nt = 0; nt < 4; ++nt) \
          bfr[nt] = *(const bf16x8*)(Bs_ + (wn * 64 + nt * 16 + l15) * LDT + (((ks * 4 + lq) ^ rsw) * 8)); \
        _Pragma("unroll") for (int mt = 0; mt < 4; ++mt) \
          _Pragma("unroll") for (int nt = 0; nt < 4; ++nt) acc[mt][nt] = MFMA16(bfr[nt], af[mt], acc[mt][nt]); \
      } }
#define RESCALE() { if (EPI == EPI_OUT) { \
      _Pragma("unroll") for (int mt = 0; mt < 4; ++mt) { \
        const int row = row0 + wm * 64 + mt * 16 + l15; \
        const float ra_ = rsqrtf(P.ssa[row] * (1.f / 512.f) + EPSF), rb_ = rsqrtf(P.ssb[row] * (1.f / 512.f) + EPSF); \
        const float ratio = ra_ / rb_; \
        _Pragma("unroll") for (int nt = 0; nt < 4; ++nt) acc[mt][nt] *= ratio; } } }
  __syncthreads();
  GLDS(p, 0)
  __builtin_amdgcn_sched_barrier(0);
  GLDS(q, 1)
  __builtin_amdgcn_sched_barrier(0);
  LSTS(p, 0)
  GLDS(p, 2)
  __builtin_amdgcn_sched_barrier(0);
  for (int st = 0; st < total; st += 2) {
    const int ti = st / nk, kt = st - ti * nk;
    const int tile = vb + ti * (int)gridDim.x;
    const int row0 = (tile / NT) * 128, col0 = (tile % NT) * 128;
    __syncthreads();
    LSTS(q, 1)
    GLDS(q, st + 3)
    __builtin_amdgcn_sched_barrier(0);
    if (kt == nk / 2) RESCALE()
    COMPUTE(0)
    __syncthreads();
    LSTS(p, 0)
    GLDS(p, st + 4)
    __builtin_amdgcn_sched_barrier(0);
    COMPUTE(1)
    if (kt + 2 < nk) continue;
    if (EPI == EPI_Q) {
      float* xch = (float*)(smem + 65536);
      float lst[4][16];
#pragma unroll
      for (int mt = 0; mt < 4; ++mt) {
        const int lr = wm * 64 + mt * 16 + l15;
        const float sc = rsqrtf(P.ss2[row0 + lr] * (1.f / 1024.f) + EPSF);
#pragma unroll
        for (int nt = 0; nt < 4; ++nt)
#pragma unroll
          for (int j = 0; j < 4; ++j) {
            const unsigned kidx = (unsigned)(wn * 64 + nt * 16 + lq * 4 + j);
            lst[mt][nt * 4 + j] = __uint_as_float((__float_as_uint(acc[mt][nt][j] * sc) & 0xffffff80u) | kidx);
          }
#pragma unroll
        for (int nt = 0; nt < 4; ++nt) acc[mt][nt] = (f32x4){0.f, 0.f, 0.f, 0.f};
        sort16(lst[mt]);
        float y[16];
#pragma unroll
        for (int i = 0; i < 16; ++i) y[i] = __shfl_xor(lst[mt][i], 16);
        merge_top16(lst[mt], y);
#pragma unroll
        for (int i = 0; i < 16; ++i) y[i] = __shfl_xor(lst[mt][i], 32);
        merge_top16(lst[mt], y);
      }
      if (wn == 1 && lq == 0) {
#pragma unroll
        for (int mt = 0; mt < 4; ++mt) {
          float4* d4 = (float4*)(xch + (wm * 64 + mt * 16 + l15) * 16);
#pragma unroll
          for (int i = 0; i < 4; ++i) d4[i] = make_float4(lst[mt][i * 4], lst[mt][i * 4 + 1], lst[mt][i * 4 + 2], lst[mt][i * 4 + 3]);
        }
      }
      __syncthreads();
      if (wn == 0) {
        const int hs = col0 >> 7;
#pragma unroll
        for (int mt = 0; mt < 4; ++mt) {
          const int lr = wm * 64 + mt * 16 + l15;
          const float4* s4 = (const float4*)(xch + lr * 16);
          float y[16];
#pragma unroll
          for (int i = 0; i < 4; ++i) { const float4 t = s4[i]; y[i * 4] = t.x; y[i * 4 + 1] = t.y; y[i * 4 + 2] = t.z; y[i * 4 + 3] = t.w; }
          merge_top16(lst[mt], y);
          if (lq == 0) {
            float4* d4 = (float4*)(P.t16 + ((size_t)(row0 + lr) * 16 + hs) * 16);
#pragma unroll
            for (int i = 0; i < 4; ++i) d4[i] = make_float4(lst[mt][i * 4], lst[mt][i * 4 + 1], lst[mt][i * 4 + 2], lst[mt][i * 4 + 3]);
          }
        }
      }
      continue;
    }
#pragma unroll
    for (int mt = 0; mt < 4; ++mt) {
      const int lr = wm * 64 + mt * 16 + l15;
      const size_t row = (size_t)(row0 + lr);
      float sc = 1.f;
      if (EPI == EPI_INPROJ) sc = P.rstd1[row];
      if (EPI == EPI_OUT) sc = rsqrtf(P.ssb[row] * (1.f / 512.f) + EPSF);
      if (EPI == EPI_Q) sc = rsqrtf(P.ss2[row] * (1.f / 1024.f) + EPSF);
      float sq = 0.f;
#pragma unroll
      for (int nt = 0; nt < 4; ++nt) {
        const int col = col0 + wn * 64 + nt * 16 + lq * 4;
        f32x4 v = acc[mt][nt];
        if (EPI == EPI_INPROJ) {
          *(uint2*)(P.p + row * 1536 + col) = make_uint2(pack2(v[0] * sc, v[1] * sc), pack2(v[2] * sc, v[3] * sc));
        } else if (EPI == EPI_GLU) {
          uint2 gg = *(const uint2*)(P.gs5 + row * 512 + col);
          float4 gb = *(const float4*)(P.glu_b + col);
          float g0 = bflo(gg.x), g1 = bfhi(gg.x), g2 = bflo(gg.y), g3 = bfhi(gg.y);
          float o0 = g0 * sigmoid_(v[0] + gb.x), o1 = g1 * sigmoid_(v[1] + gb.y);
          float o2 = g2 * sigmoid_(v[2] + gb.z), o3 = g3 * sigmoid_(v[3] + gb.w);
          sq += o0 * o0 + o1 * o1 + o2 * o2 + o3 * o3;
          *(uint2*)(P.ycat + row * 1024 + 512 + col) = make_uint2(pack2(o0, o1), pack2(o2, o3));
        } else {
          float4 xv = *(const float4*)(P.x + row * 1024 + col);
          float4 h = make_float4(xv.x + v[0] * sc, xv.y + v[1] * sc, xv.z + v[2] * sc, xv.w + v[3] * sc);
          sq += h.x * h.x + h.y * h.y + h.z * h.z + h.w * h.w;
          *(float4*)(P.out + row * 1024 + col) = h;
          *(uint2*)(P.hb + row * 1024 + col) = make_uint2(pack2(h.x, h.y), pack2(h.z, h.w));
        }
      }
      if (EPI == EPI_GLU || EPI == EPI_OUT) {
        sq += __shfl_xor(sq, 16);
        sq += __shfl_xor(sq, 32);
        if (lq == 0) atomicAdd((EPI == EPI_GLU ? P.ssb : P.ss2) + row, sq);
      }
#pragma unroll
      for (int nt = 0; nt < 4; ++nt) acc[mt][nt] = (f32x4){0.f, 0.f, 0.f, 0.f};
    }
  }
}

template <int EPI>
__device__ void gemm256_phase(const Params& P, char* smem, const u16* __restrict__ A, const u16* __restrict__ Bt,
                              int M, int N, int K) {
  u16* As = (u16*)smem;
  u16* Bs = As + 256 * 64;
  const int tid = threadIdx.x, lane = tid & 63, w = tid >> 6, wm = w >> 1, wn = w & 1;
  const int l15 = lane & 15, lq = lane >> 4;
  const int NT = N / 128, MT = M / 256, ntiles = MT * NT, nk = K / 64;
  int vb = blockIdx.x;
  if ((gridDim.x & 7) == 0) vb = (blockIdx.x & 7) * (gridDim.x >> 3) + (blockIdx.x >> 3);
  const int ldr = tid >> 3, ldc = (tid & 7) * 8;
  const int ldsw = ((tid & 7) ^ ((ldr >> 1) & 7)) * 8;
  const int rsw = (l15 >> 1) & 7;
  const int cnt = (vb < ntiles) ? (ntiles - vb + (int)gridDim.x - 1) / (int)gridDim.x : 0;
  const int total = cnt * nk;
  if (total == 0) return;
  f32x4 acc[8][4];
#pragma unroll
  for (int i = 0; i < 8; ++i)
#pragma unroll
    for (int j = 0; j < 4; ++j) acc[i][j] = (f32x4){0.f, 0.f, 0.f, 0.f};
  uint4 ga0, ga1, ga2, ga3, ga4, ga5, ga6, ga7, gb0, gb1, gb2, gb3;
  const u16 *Ag, *Bg;
#define G2_ADDR(st) { int st_ = (st) < total ? (st) : total - 1; int ti_ = st_ / nk, kk_ = st_ - ti_ * nk; \
      int tl_ = vb + ti_ * (int)gridDim.x; int r0_ = (tl_ / NT) * 256, c0_ = (tl_ % NT) * 128; \
      Ag = A + (size_t)(r0_ + ldr) * K + ldc + kk_ * 64; Bg = Bt + (size_t)(c0_ + ldr) * K + ldc + kk_ * 64; }
#define G2_LDA(i) ga##i = *(const uint4*)(Ag + (size_t)(32 * i) * K);
#define G2_LDB(i) gb##i = *(const uint4*)(Bg + (size_t)(32 * i) * K);
#define G2_GLD(st) { G2_ADDR(st) G2_LDA(0) G2_LDA(1) G2_LDA(2) G2_LDA(3) G2_LDA(4) G2_LDA(5) G2_LDA(6) G2_LDA(7) G2_LDB(0) G2_LDB(1) G2_LDB(2) G2_LDB(3) }
#define G2_STA(i) *(uint4*)(As + (ldr + 32 * i) * 64 + ldsw) = ga##i;
#define G2_STB(i) *(uint4*)(Bs + (ldr + 32 * i) * 64 + ldsw) = gb##i;
#define G2_LST() { G2_STA(0) G2_STA(1) G2_STA(2) G2_STA(3) G2_STA(4) G2_STA(5) G2_STA(6) G2_STA(7) G2_STB(0) G2_STB(1) G2_STB(2) G2_STB(3) }
  G2_GLD(0)
  for (int st = 0; st < total; ++st) {
    const int ti = st / nk, kt = st - ti * nk;
    const int tile = vb + ti * (int)gridDim.x;
    const int row0 = (tile / NT) * 256, col0 = (tile % NT) * 128;
    __syncthreads();
    G2_LST()
    G2_GLD(st + 1)
    __builtin_amdgcn_sched_barrier(0);
    __syncthreads();
    if (EPI == EPI_OUT && kt == nk / 2) {
#pragma unroll
      for (int mt = 0; mt < 8; ++mt) {
        const int row = row0 + wm * 128 + mt * 16 + l15;
        const float ra_ = rsqrtf(P.ssa[row] * (1.f / 512.f) + EPSF), rb_ = rsqrtf(P.ssb[row] * (1.f / 512.f) + EPSF);
        const float ratio = ra_ / rb_;
#pragma unroll
        for (int nt = 0; nt < 4; ++nt) acc[mt][nt] *= ratio;
      }
    }
#pragma unroll
    for (int ks = 0; ks < 2; ++ks) {
      bf16x8 bfr[4];
#pragma unroll
      for (int nt = 0; nt < 4; ++nt)
        bfr[nt] = *(const bf16x8*)(Bs + (wn * 64 + nt * 16 + l15) * 64 + (((ks * 4 + lq) ^ rsw) * 8));
#pragma unroll
      for (int hh = 0; hh < 2; ++hh) {
        bf16x8 af[4];
#pragma unroll
        for (int m = 0; m < 4; ++m)
          af[m] = *(const bf16x8*)(As + (wm * 128 + (hh * 4 + m) * 16 + l15) * 64 + (((ks * 4 + lq) ^ rsw) * 8));
#pragma unroll
        for (int m = 0; m < 4; ++m)
#pragma unroll
          for (int nt = 0; nt < 4; ++nt) acc[hh * 4 + m][nt] = MFMA16(bfr[nt], af[m], acc[hh * 4 + m][nt]);
      }
    }
    if (kt + 1 < nk) continue;
    if (EPI == EPI_Q) {
      float* xch = (float*)(smem + 49152);
      float lst[8][16];
#pragma unroll
      for (int mt = 0; mt < 8; ++mt) {
        const int lr = wm * 128 + mt * 16 + l15;
        const float sc = rsqrtf(P.ss2[row0 + lr] * (1.f / 1024.f) + EPSF);
#pragma unroll
        for (int nt = 0; nt < 4; ++nt)
#pragma unroll
          for (int j = 0; j < 4; ++j) {
            const unsigned kidx = (unsigned)(wn * 64 + nt * 16 + lq * 4 + j);
            lst[mt][nt * 4 + j] = __uint_as_float((__float_as_uint(acc[mt][nt][j] * sc) & 0xffffff80u) | kidx);
          }
#pragma unroll
        for (int nt = 0; nt < 4; ++nt) acc[mt][nt] = (f32x4){0.f, 0.f, 0.f, 0.f};
        sort16(lst[mt]);
        float y[16];
#pragma unroll
        for (int i = 0; i < 16; ++i) y[i] = __shfl_xor(lst[mt][i], 16);
        merge_top16(lst[mt], y);
#pragma unroll
        for (int i = 0; i < 16; ++i) y[i] = __shfl_xor(lst[mt][i], 32);
        merge_top16(lst[mt], y);
      }
      if (wn == 1 && lq == 0) {
#pragma unroll
        for (int mt = 0; mt < 8; ++mt) {
          float4* d4 = (float4*)(xch + (wm * 128 + mt * 16 + l15) * 16);
#pragma unroll
          for (int i = 0; i < 4; ++i) d4[i] = make_float4(lst[mt][i * 4], lst[mt][i * 4 + 1], lst[mt][i * 4 + 2], lst[mt][i * 4 + 3]);
        }
      }
      __syncthreads();
      if (wn == 0) {
        const int hs = col0 >> 7;
#pragma unroll
        for (int mt = 0; mt < 8; ++mt) {
          const int lr = wm * 128 + mt * 16 + l15;
          const float4* s4 = (const float4*)(xch + lr * 16);
          float y[16];
#pragma unroll
          for (int i = 0; i < 4; ++i) { const float4 t = s4[i]; y[i * 4] = t.x; y[i * 4 + 1] = t.y; y[i * 4 + 2] = t.z; y[i * 4 + 3] = t.w; }
          merge_top16(lst[mt], y);
          if (lq == 0) {
            float4* d4 = (float4*)(P.t16 + ((size_t)(row0 + lr) * 16 + hs) * 16);
#pragma unroll
            for (int i = 0; i < 4; ++i) d4[i] = make_float4(lst[mt][i * 4], lst[mt][i * 4 + 1], lst[mt][i * 4 + 2], lst[mt][i * 4 + 3]);
          }
        }
      }
      continue;
    }
#pragma unroll
    for (int mt = 0; mt < 8; ++mt) {
      const int lr = wm * 128 + mt * 16 + l15;
      const size_t row = (size_t)(row0 + lr);
      float sc = 1.f;
      if (EPI == EPI_INPROJ) sc = P.rstd1[row];
      if (EPI == EPI_OUT) sc = rsqrtf(P.ssb[row] * (1.f / 512.f) + EPSF);
      float sq = 0.f;
#pragma unroll
      for (int nt = 0; nt < 4; ++nt) {
        const int col = col0 + wn * 64 + nt * 16 + lq * 4;
        f32x4 v = acc[mt][nt];
        if (EPI == EPI_INPROJ) {
          *(uint2*)(P.p + row * 1536 + col) = make_uint2(pack2(v[0] * sc, v[1] * sc), pack2(v[2] * sc, v[3] * sc));
        } else if (EPI == EPI_GLU) {
          uint2 gg = *(const uint2*)(P.gs5 + row * 512 + col);
          float4 gb = *(const float4*)(P.glu_b + col);
          float g0 = bflo(gg.x), g1 = bfhi(gg.x), g2 = bflo(gg.y), g3 = bfhi(gg.y);
          float o0 = g0 * sigmoid_(v[0] + gb.x), o1 = g1 * sigmoid_(v[1] + gb.y);
          float o2 = g2 * sigmoid_(v[2] + gb.z), o3 = g3 * sigmoid_(v[3] + gb.w);
          sq += o0 * o0 + o1 * o1 + o2 * o2 + o3 * o3;
          *(uint2*)(P.ycat + row * 1024 + 512 + col) = make_uint2(pack2(o0, o1), pack2(o2, o3));
        } else {
          float4 xv = *(const float4*)(P.x + row * 1024 + col);
          float4 h = make_float4(xv.x + v[0] * sc, xv.y + v[1] * sc, xv.z + v[2] * sc, xv.w + v[3] * sc);
          sq += h.x * h.x + h.y * h.y + h.z * h.z + h.w * h.w;
          *(float4*)(P.out + row * 1024 + col) = h;
          *(uint2*)(P.hb + row * 1024 + col) = make_uint2(pack2(h.x, h.y), pack2(h.z, h.w));
        }
        acc[mt][nt] = (f32x4){0.f, 0.f, 0.f, 0.f};
      }
      if (EPI == EPI_GLU || EPI == EPI_OUT) {
        sq += __shfl_xor(sq, 16);
        sq += __shfl_xor(sq, 32);
        if (lq == 0) atomicAdd((EPI == EPI_GLU ? P.ssb : P.ss2) + row, sq);
      }
    }
  }
}

__device__ __forceinline__ float one_minus_exp(float x) {
  const float ser = -x * (1.f + x * (0.5f + x * (0.16666667f + x * (0.041666668f + x * (0.0083333338f + x * 0.0013888889f)))));
  return (x > -0.5f) ? ser : (1.f - __expf(x));
}

template <bool FINAL>
__device__ void lru_phase(const Params& P, char* smem) {
  float* xcs = (float*)smem;
  float* a_s = xcs + 64 * 65;
  float* segA = a_s + 64 * 65;
  float* segH = segA + 256;
  const int tid = threadIdx.x, lane = tid & 63, w = tid >> 6;
  const int l15 = lane & 15, lq = lane >> 4;
  for (int item = blockIdx.x; item < 8192; item += gridDim.x) {
    const int head = item & 7, tile = (item >> 3) & 31, b = item >> 8;
    const int c0 = head * 64, t0 = tile * 64;
    __syncthreads();
    if (!FINAL) {
      bf16x8 af[2];
      {
        const int tl = w * 16 + l15;
        const int t = t0 + tl;
        const u16* prow = P.p + ((size_t)(b * 2048 + t)) * 1536 + c0;
#pragma unroll
        for (int ks = 0; ks < 2; ++ks) {
          const int ch = ks * 32 + lq * 8;
          float xc[8];
          {
            float4 b0 = *(const float4*)(P.conv_b + c0 + ch), b1 = *(const float4*)(P.conv_b + c0 + ch + 4);
            xc[0] = b0.x; xc[1] = b0.y; xc[2] = b0.z; xc[3] = b0.w; xc[4] = b1.x; xc[5] = b1.y; xc[6] = b1.z; xc[7] = b1.w;
          }
#pragma unroll
          for (int k = 0; k < 4; ++k) {
            if (t - 3 + k >= 0) {
              uint4 v = *(const uint4*)(prow + (k - 3) * 1536 + ch);
              float4 w0 = *(const float4*)(P.conv_w + k * 512 + c0 + ch), w1 = *(const float4*)(P.conv_w + k * 512 + c0 + ch + 4);
              xc[0] += w0.x * bflo(v.x); xc[1] += w0.y * bfhi(v.x); xc[2] += w0.z * bflo(v.y); xc[3] += w0.w * bfhi(v.y);
              xc[4] += w1.x * bflo(v.z); xc[5] += w1.y * bfhi(v.z); xc[6] += w1.z * bflo(v.w); xc[7] += w1.w * bfhi(v.w);
            }
          }
#pragma unroll
          for (int i = 0; i < 8; ++i) xcs[tl * 65 + ch + i] = xc[i];
          unsigned p0 = pack2(xc[0], xc[1]), p1 = pack2(xc[2], xc[3]), p2 = pack2(xc[4], xc[5]), p3 = pack2(xc[6], xc[7]);
          uint4 pk = make_uint4(p0, p1, p2, p3);
          af[ks] = *(bf16x8*)&pk;
        }
      }
      f32x4 accr[4], acci[4];
#pragma unroll
      for (int nt = 0; nt < 4; ++nt) {
        accr[nt] = (f32x4){0.f, 0.f, 0.f, 0.f};
        acci[nt] = (f32x4){0.f, 0.f, 0.f, 0.f};
#pragma unroll
        for (int ks = 0; ks < 2; ++ks) {
          bf16x8 ba = *(const bf16x8*)(P.WaT + head * 4096 + (nt * 16 + l15) * 64 + ks * 32 + lq * 8);
          bf16x8 bx = *(const bf16x8*)(P.WxT + head * 4096 + (nt * 16 + l15) * 64 + ks * 32 + lq * 8);
          accr[nt] = MFMA16(af[ks], ba, accr[nt]);
          acci[nt] = MFMA16(af[ks], bx, acci[nt]);
        }
      }
      __syncthreads();
#pragma unroll
      for (int nt = 0; nt < 4; ++nt) {
        const int ch = nt * 16 + l15;
        const float ba = P.lru_ba[c0 + ch], bx = P.lru_bx[c0 + ch], sp = P.spv[c0 + ch];
#pragma unroll
        for (int r = 0; r < 4; ++r) {
          const int tl = w * 16 + lq * 4 + r;
          float xf = xcs[tl * 65 + ch];
          float rr = sigmoid_(accr[nt][r] + ba), ig = sigmoid_(acci[nt][r] + bx);
          float la = -8.f * rr * sp;
          const float oma = one_minus_exp(la);
          const float om2 = one_minus_exp(2.f * la);
          float u = __builtin_amdgcn_sqrtf(om2) * ig * xf;
          a_s[tl * 65 + ch] = __uint_as_float((unsigned)f2bf(oma) | ((unsigned)f2bf(u) << 16));
        }
      }
      __syncthreads();
    }
    {
      const int ch = tid & 63, seg = tid >> 6;
      const size_t tok0 = (size_t)(b * 2048 + t0 + seg * 16);
      unsigned pk[16];
#pragma unroll
      for (int s = 0; s < 16; ++s) {
        if (!FINAL) {
          pk[s] = __float_as_uint(a_s[(seg * 16 + s) * 65 + ch]);
          P.au[(tok0 + s) * 512 + c0 + ch] = pk[s];
        } else {
          pk[s] = P.au[(tok0 + s) * 512 + c0 + ch];
        }
      }
      float Ap = 1.f, Hl = 0.f;
#pragma unroll
      for (int s = 0; s < 16; ++s) {
        const float a = 1.f - bflo(pk[s]), u = bfhi(pk[s]);
        Hl = a * Hl + u;
        Ap *= a;
      }
      segA[seg * 64 + ch] = Ap;
      segH[seg * 64 + ch] = Hl;
      __syncthreads();
      if (!FINAL) {
        if (seg == 0) {
          float Aa = 1.f, Hh = 0.f;
#pragma unroll
          for (int s = 0; s < 4; ++s) {
            Hh = segA[s * 64 + ch] * Hh + segH[s * 64 + ch];
            Aa *= segA[s * 64 + ch];
          }
          P.Acar[(b * 32 + tile) * 512 + c0 + ch] = Aa;
          P.Hcar[(b * 32 + tile) * 512 + c0 + ch] = Hh;
        }
      } else {
        float gate[16];
#pragma unroll
        for (int s = 0; s < 16; ++s) gate[s] = bf2f(P.p[(tok0 + s) * 1536 + 512 + c0 + ch]);
        float h = P.Hin[(b * 32 + tile) * 512 + c0 + ch];
#pragma unroll
        for (int s = 0; s < 3; ++s)
          if (s < seg) h = segA[s * 64 + ch] * h + segH[s * 64 + ch];
        float sqv[16];
#pragma unroll
        for (int s = 0; s < 16; ++s) {
          h = (1.f - bflo(pk[s])) * h + bfhi(pk[s]);
          const float yv = h * gelu_(gate[s]);
          sqv[s] = yv * yv;
          P.ycat[(tok0 + s) * 1024 + c0 + ch] = f2bf(yv);
        }
        {
          const bool hb = (lane & 32) != 0, b4 = (lane & 16) != 0, b3 = (lane & 8) != 0, b2 = (lane & 4) != 0;
#pragma unroll
          for (int i = 0; i < 8; ++i) { float sd = hb ? sqv[i] : sqv[i + 8], kp = hb ? sqv[i + 8] : sqv[i]; sqv[i] = kp + __shfl_xor(sd, 32); }
#pragma unroll
          for (int i = 0; i < 4; ++i) { float sd = b4 ? sqv[i] : sqv[i + 4], kp = b4 ? sqv[i + 4] : sqv[i]; sqv[i] = kp + __shfl_xor(sd, 16); }
#pragma unroll
          for (int i = 0; i < 2; ++i) { float sd = b3 ? sqv[i] : sqv[i + 2], kp = b3 ? sqv[i + 2] : sqv[i]; sqv[i] = kp + __shfl_xor(sd, 8); }
          { float sd = b2 ? sqv[0] : sqv[1], kp = b2 ? sqv[1] : sqv[0]; sqv[0] = kp + __shfl_xor(sd, 4); }
          sqv[0] += __shfl_xor(sqv[0], 2);
          sqv[0] += __shfl_xor(sqv[0], 1);
          if ((lane & 3) == 0) atomicAdd(P.ssa + tok0 + (lane >> 2), sqv[0]);
        }
      }
    }
  }
}

__device__ void carry_phase(const Params& P) {
  const int gt = blockIdx.x * 256 + threadIdx.x, nth = gridDim.x * 256;
  for (int i = gt; i < 16384 + 65536; i += nth) {
    if (i < 16384) {
      const int b = i >> 9, ch = i & 511;
      float h = 0.f;
      for (int t0 = 0; t0 < 32; t0 += 8) {
        float a[8], hh[8];
#pragma unroll
        for (int j = 0; j < 8; ++j) {
          a[j] = P.Acar[(b * 32 + t0 + j) * 512 + ch];
          hh[j] = P.Hcar[(b * 32 + t0 + j) * 512 + ch];
        }
#pragma unroll
        for (int j = 0; j < 8; ++j) {
          P.Hin[(b * 32 + t0 + j) * 512 + ch] = h;
          h = a[j] * h + hh[j];
        }
      }
    } else {
      const int k = i - 16384;
      const int pp = k & 63, g = (k >> 6) & 31, b = k >> 11;
      const float ar = P.A16[(g * 64 + pp) * 2], ai = P.A16[(g * 64 + pp) * 2 + 1];
      float hr = 0.f, hi = 0.f;
      for (int c0 = 0; c0 < 128; c0 += 8) {
        float er[8], ei[8];
#pragma unroll
        for (int j = 0; j < 8; ++j) {
          size_t base = ((size_t)(b * 128 + c0 + j) * 32 + g) * 128;
          er[j] = P.E[base + pp];
          ei[j] = P.E[base + 64 + pp];
        }
#pragma unroll
        for (int j = 0; j < 8; ++j) {
          size_t base = ((size_t)(b * 128 + c0 + j) * 32 + g) * 128;
          P.Hs[base + pp] = f2bf(hr);
          P.Hs[base + 64 + pp] = f2bf(hi);
          float nr = ar * hr - ai * hi + er[j], ni = ar * hi + ai * hr + ei[j];
          hr = nr; hi = ni;
        }
      }
    }
  }
}

template <bool YPH>
__device__ void s5_phase(const Params& P) {
  constexpr int MTW = YPH ? 4 : 2;
  const int tid = threadIdx.x, lane = tid & 63, w = tid >> 6;
  const int l15 = lane & 15, lq = lane >> 4;
  for (int item = blockIdx.x; item < 2048; item += gridDim.x) {
    const int g = ((item & 7) << 2) | ((item >> 3) & 3), cb = item >> 5;
    f32x4 acc[MTW][4];
#pragma unroll
    for (int i = 0; i < MTW; ++i)
#pragma unroll
      for (int j = 0; j < 4; ++j) acc[i][j] = (f32x4){0.f, 0.f, 0.f, 0.f};
    const u16* Am = YPH ? (P.MF + (size_t)g * 256 * 384) : (P.G + (size_t)g * 128 * 256);
    constexpr int LD = YPH ? 384 : 256;
    for (int ks = 0; ks < 8; ++ks) {
      bf16x8 bu[4];
#pragma unroll
      for (int nt = 0; nt < 4; ++nt) {
        const int Ncol = cb * 64 + nt * 16 + l15;
        const int b = Ncol >> 7, c = Ncol & 127;
        const int tau = ks * 2 + (lq >> 1), j0 = (lq & 1) * 8;
        bu[nt] = *(const bf16x8*)(P.p + ((size_t)(b * 2048 + c * 16 + tau)) * 1536 + 1024 + g * 16 + j0);
      }
#pragma unroll
      for (int mt = 0; mt < MTW; ++mt) {
        const int m = (w * MTW + mt) * 16 + l15;
        bf16x8 a = *(const bf16x8*)(Am + (size_t)m * LD + ks * 32 + lq * 8);
#pragma unroll
        for (int nt = 0; nt < 4; ++nt) acc[mt][nt] = MFMA16(a, bu[nt], acc[mt][nt]);
      }
    }
    if (YPH) {
      for (int ks = 0; ks < 4; ++ks) {
        bf16x8 bh[4];
#pragma unroll
        for (int nt = 0; nt < 4; ++nt) {
          const int Ncol = cb * 64 + nt * 16 + l15;
          bh[nt] = *(const bf16x8*)(P.Hs + ((size_t)Ncol * 32 + g) * 128 + ks * 32 + lq * 8);
        }
#pragma unroll
        for (int mt = 0; mt < MTW; ++mt) {
          const int m = (w * MTW + mt) * 16 + l15;
          bf16x8 a = *(const bf16x8*)(Am + (size_t)m * LD + 256 + ks * 32 + lq * 8);
#pragma unroll
          for (int nt = 0; nt < 4; ++nt) acc[mt][nt] = MFMA16(a, bh[nt], acc[mt][nt]);
        }
      }
    }
#pragma unroll
    for (int mt = 0; mt < MTW; ++mt)
#pragma unroll
      for (int nt = 0; nt < 4; ++nt) {
        const int Ncol = cb * 64 + nt * 16 + l15;
        f32x4 v = acc[mt][nt];
        if (!YPH) {
          const int m0 = (w * MTW + mt) * 16 + lq * 4;
          *(float4*)(P.E + ((size_t)Ncol * 32 + g) * 128 + m0) = make_float4(v[0], v[1], v[2], v[3]);
        } else {
          const int b = Ncol >> 7, c = Ncol & 127;
          const int tloc = w * MTW + mt;
          const size_t tok = (size_t)(b * 2048 + c * 16 + tloc);
          *(uint2*)(P.gs5 + tok * 512 + g * 16 + lq * 4) =
              make_uint2(pack2(gelu_(v[0]), gelu_(v[1])), pack2(gelu_(v[2]), gelu_(v[3])));
        }
      }
  }
}

__device__ __forceinline__ void top16_of_64(f32x16 (&acc)[4], int half, float (&res)[16]) {
  float g[4][16];
#pragma unroll
  for (int mt = 0; mt < 4; ++mt) {
#pragma unroll
    for (int i = 0; i < 16; ++i) {
      unsigned idx = mt * 32 + (i >> 2) * 8 + (i & 3);
      unsigned bits = (__float_as_uint(acc[mt][i]) & 0xffffff80u) | idx | (unsigned)(half * 4);
      g[mt][i] = __uint_as_float(bits);
    }
    sort16(g[mt]);
  }
  merge_top16(g[0], g[1]);
  merge_top16(g[2], g[3]);
  merge_top16(g[0], g[2]);
  float y[16];
#pragma unroll
  for (int i = 0; i < 16; ++i) y[i] = __shfl_xor(g[0][i], 32);
  merge_top16(g[0], y);
#pragma unroll
  for (int i = 0; i < 16; ++i) res[i] = g[0][i];
}
__host__ __device__ constexpr int cand_off(int i) {
  int s = 0;
  for (int q = 0; q < i; ++q) s += 16 / (q + 1);
  return s;
}

__device__ void cand_phase(const Params& P, char* smem) {
  const int tid = threadIdx.x;
  unsigned char* lut = (unsigned char*)smem + tid * 36;
  for (int gi = blockIdx.x * 256 + tid; gi < T_TOK * 8; gi += gridDim.x * 256) {
    const size_t tok = (size_t)(gi >> 3);
    const int head = gi & 7;
    float a[16], bl[16];
    {
      const float4* src = (const float4*)(P.t16 + (size_t)gi * 32);
#pragma unroll
      for (int i = 0; i < 4; ++i) {
        const float4 t = src[i], u = src[4 + i];
        a[i * 4] = t.x; a[i * 4 + 1] = t.y; a[i * 4 + 2] = t.z; a[i * 4 + 3] = t.w;
        bl[i * 4] = u.x; bl[i * 4 + 1] = u.y; bl[i * 4 + 2] = u.z; bl[i * 4 + 3] = u.w;
      }
    }
    float va[16], vb[16];
#pragma unroll
    for (int i = 0; i < 16; ++i) {
      va[i] = __uint_as_float(__float_as_uint(a[i]) & 0xffffff80u);
      vb[i] = __uint_as_float(__float_as_uint(bl[i]) & 0xffffff80u);
    }
    float cg4[4][16];
#pragma unroll
    for (int i = 0; i < 4; ++i)
#pragma unroll
      for (int j = 0; j < 16; ++j) cg4[i][j] = __uint_as_float(0xff800000u);
#pragma unroll
    for (int i = 0; i < 16; ++i)
#pragma unroll
      for (int j = 0; j < 16; ++j)
        if ((i + 1) * (j + 1) <= 16) {
          const int pos = cand_off(i) + j;
          float sm = va[i] + vb[j];
          cg4[pos >> 4][pos & 15] = __uint_as_float((__float_as_uint(sm) & 0xffffff00u) | (unsigned)(i * 16 + j));
        }
#pragma unroll
    for (int i = 0; i < 4; ++i) sort16(cg4[i]);
    merge_top16(cg4[0], cg4[1]);
    merge_top16(cg4[2], cg4[3]);
    merge_top16(cg4[0], cg4[2]);
    {
      unsigned* lw = (unsigned*)lut;
#pragma unroll
      for (int i = 0; i < 4; ++i) {
        lw[i] = (__float_as_uint(a[i * 4]) & 127u) | ((__float_as_uint(a[i * 4 + 1]) & 127u) << 8) |
                ((__float_as_uint(a[i * 4 + 2]) & 127u) << 16) | ((__float_as_uint(a[i * 4 + 3]) & 127u) << 24);
        lw[4 + i] = (__float_as_uint(bl[i * 4]) & 127u) | ((__float_as_uint(bl[i * 4 + 1]) & 127u) << 8) |
                    ((__float_as_uint(bl[i * 4 + 2]) & 127u) << 16) | ((__float_as_uint(bl[i * 4 + 3]) & 127u) << 24);
      }
    }
    float sc[16];
    int ee[16];
    const float mx = __uint_as_float(__float_as_uint(cg4[0][0]) & 0xffffff00u);
    float ssum = 0.f;
#pragma unroll
    for (int k = 0; k < 16; ++k) {
      unsigned bits = __float_as_uint(cg4[0][k]);
      unsigned code = bits & 255u;
      float v = __uint_as_float(bits & 0xffffff00u);
      sc[k] = __expf(v - mx);
      ssum += sc[k];
      int i1 = lut[code >> 4], i2 = lut[16 + (code & 15u)];
      ee[k] = i1 * 128 + i2;
    }
    const float inv = 1.f / ssum;
    int4* de = (int4*)(P.eidx + tok * 128 + head * 16);
    float4* ds = (float4*)(P.suv + tok * 128 + head * 16);
    float4* dg = (float4*)(P.gw + tok * 128 + head * 16);
#pragma unroll
    for (int i = 0; i < 4; ++i) {
      de[i] = make_int4(ee[i * 4], ee[i * 4 + 1], ee[i * 4 + 2], ee[i * 4 + 3]);
      ds[i] = make_float4(P.su[ee[i * 4]], P.su[ee[i * 4 + 1]], P.su[ee[i * 4 + 2]], P.su[ee[i * 4 + 3]]);
      dg[i] = make_float4(sc[i * 4] * inv * P.sv[ee[i * 4]], sc[i * 4 + 1] * inv * P.sv[ee[i * 4 + 1]],
                          sc[i * 4 + 2] * inv * P.sv[ee[i * 4 + 2]], sc[i * 4 + 3] * inv * P.sv[ee[i * 4 + 3]]);
    }
  }
}

typedef float f2v __attribute__((ext_vector_type(2)));
__device__ __forceinline__ float dot16_fp8(uint4 u, const f2v* x) {
  f2v acc = {0.f, 0.f};
  acc = __builtin_amdgcn_cvt_pk_f32_fp8(u.x, false) * x[0] + acc;
  acc = __builtin_amdgcn_cvt_pk_f32_fp8(u.x, true) * x[1] + acc;
  acc = __builtin_amdgcn_cvt_pk_f32_fp8(u.y, false) * x[2] + acc;
  acc = __builtin_amdgcn_cvt_pk_f32_fp8(u.y, true) * x[3] + acc;
  acc = __builtin_amdgcn_cvt_pk_f32_fp8(u.z, false) * x[4] + acc;
  acc = __builtin_amdgcn_cvt_pk_f32_fp8(u.z, true) * x[5] + acc;
  acc = __builtin_amdgcn_cvt_pk_f32_fp8(u.w, false) * x[6] + acc;
  acc = __builtin_amdgcn_cvt_pk_f32_fp8(u.w, true) * x[7] + acc;
  return acc.x + acc.y;
}
__device__ __forceinline__ void axpy16_fp8(f2v* o, float wgt, uint4 v) {
  const f2v ww = {wgt, wgt};
  o[0] = __builtin_amdgcn_cvt_pk_f32_fp8(v.x, false) * ww + o[0];
  o[1] = __builtin_amdgcn_cvt_pk_f32_fp8(v.x, true) * ww + o[1];
  o[2] = __builtin_amdgcn_cvt_pk_f32_fp8(v.y, false) * ww + o[2];
  o[3] = __builtin_amdgcn_cvt_pk_f32_fp8(v.y, true) * ww + o[3];
  o[4] = __builtin_amdgcn_cvt_pk_f32_fp8(v.z, false) * ww + o[4];
  o[5] = __builtin_amdgcn_cvt_pk_f32_fp8(v.z, true) * ww + o[5];
  o[6] = __builtin_amdgcn_cvt_pk_f32_fp8(v.w, false) * ww + o[6];
  o[7] = __builtin_amdgcn_cvt_pk_f32_fp8(v.w, true) * ww + o[7];
}

__device__ void peer_phase(const Params& P) {
  const int lane = threadIdx.x & 63;
  const int w = __builtin_amdgcn_readfirstlane(threadIdx.x >> 6);
  const int gwv = blockIdx.x * 4 + w, nw = gridDim.x * 4;
  const bool hb = (lane & 32) != 0, b4 = (lane & 16) != 0, b3 = (lane & 8) != 0;
  float4 g2v[4];
#pragma unroll
  for (int c = 0; c < 4; ++c) g2v[c] = *(const float4*)(P.norm2_g + lane * 16 + c * 4);
  float4 hn[4];
  if (gwv < T_TOK) {
#pragma unroll
    for (int c = 0; c < 4; ++c) hn[c] = *(const float4*)(P.out + (size_t)gwv * 1024 + lane * 16 + c * 4);
  }
  for (int tok = gwv; tok < T_TOK; tok += nw) {
    float4 hc[4];
#pragma unroll
    for (int c = 0; c < 4; ++c) hc[c] = hn[c];
    {
      const int ntok = (tok + nw < T_TOK) ? tok + nw : tok;
#pragma unroll
      for (int c = 0; c < 4; ++c) hn[c] = *(const float4*)(P.out + (size_t)ntok * 1024 + lane * 16 + c * 4);
    }
    const int* ep = P.eidx + (size_t)tok * 128;
    const float* gp = P.gw + (size_t)tok * 128;
    const float* sp = P.suv + (size_t)tok * 128;
    uint4 uA[8], uB[8];
    float suA, gA, suB, gB;
    int elA, elB;
#define LOADU(U, SU, G, EL, kb) { _Pragma("unroll") for (int j = 0; j < 8; ++j) { const int e = ep[(kb) + j]; \
        U[j] = *(const uint4*)(P.U8 + (size_t)e * 1024 + lane * 16); } \
      SU = sp[(kb) + (lane >> 3)]; G = gp[(kb) + (lane >> 3)]; EL = ep[(kb) + (lane >> 3)]; }
    LOADU(uA, suA, gA, elA, 0)
    __builtin_amdgcn_sched_barrier(0);
    float ss = 0.f;
#pragma unroll
    for (int c = 0; c < 4; ++c) ss += hc[c].x * hc[c].x + hc[c].y * hc[c].y + hc[c].z * hc[c].z + hc[c].w * hc[c].w;
    ss = wsum(ss);
    const float rstd2 = rsqrtf(ss * (1.f / 1024.f) + EPSF);
    f2v xn[8];
#pragma unroll
    for (int c = 0; c < 4; ++c) {
      xn[c * 2 + 0] = (f2v){hc[c].x * rstd2 * g2v[c].x, hc[c].y * rstd2 * g2v[c].y};
      xn[c * 2 + 1] = (f2v){hc[c].z * rstd2 * g2v[c].z, hc[c].w * rstd2 * g2v[c].w};
    }
#define PROCU(U, SU, G, EL, kb) { float d[8]; \
      _Pragma("unroll") for (int j = 0; j < 8; ++j) d[j] = dot16_fp8(U[j], xn); \
      _Pragma("unroll") for (int i = 0; i < 4; ++i) { float send = hb ? d[i] : d[i + 4], keep = hb ? d[i + 4] : d[i]; d[i] = keep + __shfl_xor(send, 32); } \
      _Pragma("unroll") for (int i = 0; i < 2; ++i) { float send = b4 ? d[i] : d[i + 2], keep = b4 ? d[i + 2] : d[i]; d[i] = keep + __shfl_xor(send, 16); } \
      { float send = b3 ? d[0] : d[1], keep = b3 ? d[1] : d[0]; d[0] = keep + __shfl_xor(send, 8); } \
      d[0] += __shfl_xor(d[0], 4); d[0] += __shfl_xor(d[0], 2); d[0] += __shfl_xor(d[0], 1); \
      const float act = gelu_(d[0] * SU) * G; \
      if ((lane & 7) == 0) ((unsigned*)P.wact)[(size_t)tok * 128 + (kb) + (lane >> 3)] = ((unsigned)f2bf(act) << 16) | (unsigned)EL; }
    for (int k0 = 0; k0 < 128; k0 += 16) {
      LOADU(uB, suB, gB, elB, k0 + 8)
      __builtin_amdgcn_sched_barrier(0);
      PROCU(uA, suA, gA, elA, k0)
      { const int kn = (k0 + 16 < 128) ? k0 + 16 : 112; LOADU(uA, suA, gA, elA, kn) }
      __builtin_amdgcn_sched_barrier(0);
      PROCU(uB, suB, gB, elB, k0 + 8)
    }
  }
}

__device__ void udot_phase(const Params& P) {
  const int my_xcc = (int)((unsigned)__builtin_amdgcn_s_getreg((3 << 11) | 20) & 7u), my_rank = P.rank[blockIdx.x];
  const int lane = threadIdx.x & 63, w = threadIdx.x >> 6;
  const int r = lane >> 3, c = lane & 7;
  const bool b2 = (lane & 4) != 0, b1 = (lane & 2) != 0, b0 = (lane & 1) != 0;
  int cen_ok = 1, cen_sum = 0, cen_mine = 0;
#pragma unroll
  for (int x = 0; x < 8; ++x) {
    const int cx = (int)__hip_atomic_load(P.bar + 15 * 512 + x * 32, __ATOMIC_RELAXED, __HIP_MEMORY_SCOPE_AGENT);
    cen_ok &= (cx > 0); cen_sum += cx; if (x == my_xcc) cen_mine = cx;
  }
  const bool fast = cen_ok && cen_sum == (int)gridDim.x;
  const int nwt = fast ? cen_mine * 4 : (int)gridDim.x * 4;
  const int wv = fast ? my_rank * 4 + w : (int)blockIdx.x * 4 + w;
  const int total = fast ? T_TOK : T_TOK * 8;
  const int cnt = (wv < total) ? (total - wv + nwt - 1) / nwt : 0;
  if (cnt == 0) return;
  const int slf = my_xcc;
#define UTOK(n, SL, TK) { int it_ = wv + ((n) < cnt ? (n) : cnt - 1) * nwt; SL = fast ? slf : (it_ & 7); TK = fast ? it_ : (it_ >> 3); }
#define ULOADE(E, n) { int sl_, tk_; UTOK(n, sl_, tk_) (void)sl_; const uint4* ep_ = (const uint4*)(P.eidx + (size_t)tk_ * 128 + r * 16); \
      _Pragma("unroll") for (int i = 0; i < 4; ++i) E[i] = ep_[i]; }
#define UGATHER(V, E, n) { int sl_, tk_; UTOK(n, sl_, tk_) (void)tk_; const unsigned char* ub_ = P.U8 + (size_t)sl_ * (16384 * 128) + c * 16; \
      _Pragma("unroll") for (int i = 0; i < 4; ++i) { \
        V[i * 4 + 0] = *(const uint4*)(ub_ + (size_t)E[i].x * 128); V[i * 4 + 1] = *(const uint4*)(ub_ + (size_t)E[i].y * 128); \
        V[i * 4 + 2] = *(const uint4*)(ub_ + (size_t)E[i].z * 128); V[i * 4 + 3] = *(const uint4*)(ub_ + (size_t)E[i].w * 128); } }
#define UHLOAD(H, S2, n) { int sl_, tk_; UTOK(n, sl_, tk_) const float* hp_ = P.out + (size_t)tk_ * 1024 + sl_ * 128 + c * 16; \
      _Pragma("unroll") for (int i = 0; i < 4; ++i) H[i] = *(const float4*)(hp_ + i * 4); (void)S2; }
#define UPROC(V, H, S2, n) { int sl_, tk_; UTOK(n, sl_, tk_) \
      f2v xn_[8]; \
      _Pragma("unroll") for (int i = 0; i < 4; ++i) { xn_[i * 2] = (f2v){H[i].x, H[i].y}; xn_[i * 2 + 1] = (f2v){H[i].z, H[i].w}; } \
      float d[16]; _Pragma("unroll") for (int i = 0; i < 16; ++i) d[i] = dot16_fp8(V[i], xn_); \
      _Pragma("unroll") for (int i = 0; i < 8; ++i) { float sd = b2 ? d[i] : d[i + 8], kp = b2 ? d[i + 8] : d[i]; d[i] = kp + __shfl_xor(sd, 4); } \
      _Pragma("unroll") for (int i = 0; i < 4; ++i) { float sd = b1 ? d[i] : d[i + 4], kp = b1 ? d[i + 4] : d[i]; d[i] = kp + __shfl_xor(sd, 2); } \
      _Pragma("unroll") for (int i = 0; i < 2; ++i) { float sd = b0 ? d[i] : d[i + 2], kp = b0 ? d[i + 2] : d[i]; d[i] = kp + __shfl_xor(sd, 1); } \
      nt_st_f2(make_float2(d[0], d[1]), P.part + ((size_t)sl_ * T_TOK + tk_) * 128 + lane * 2); }
  uint4 eA[4], eB[4];
  uint4 vA[16], vB[16];
  ULOADE(eA, 0)
  ULOADE(eB, 1)
  UGATHER(vA, eA, 0)
  __builtin_amdgcn_sched_barrier(0);
  for (int n = 0; n < cnt; n += 2) {
    { float4 h_[4]; float s2_ = 0.f; UHLOAD(h_, s2_, n) UGATHER(vB, eB, n + 1) ULOADE(eA, n + 2)
      __builtin_amdgcn_sched_barrier(0); UPROC(vA, h_, s2_, n) }
    if (n + 1 < cnt) {
      float4 h_[4]; float s2_ = 0.f; UHLOAD(h_, s2_, n + 1) UGATHER(vA, eA, n + 2) ULOADE(eB, n + 3)
      __builtin_amdgcn_sched_barrier(0); UPROC(vB, h_, s2_, n + 1)
    }
  }
}

__device__ void ucomb_phase(const Params& P) {
  const size_t gt = (size_t)blockIdx.x * 256 + threadIdx.x, nt = (size_t)gridDim.x * 256;
  for (size_t i = gt; i < (size_t)T_TOK * 32; i += nt) {
    float4 a = ((const float4*)P.part)[i];
#pragma unroll
    for (int sl = 1; sl < 8; ++sl) {
      const float4 b = ((const float4*)P.part)[(size_t)sl * T_TOK * 32 + i];
      a.x += b.x; a.y += b.y; a.z += b.z; a.w += b.w;
    }
    float4 su = ((const float4*)P.suv)[i]; const float4 g = ((const float4*)P.gw)[i];
    { const float r2 = rsqrtf(P.ss2[i >> 5] * (1.f / 1024.f) + EPSF); su.x *= r2; su.y *= r2; su.z *= r2; su.w *= r2; }
    const int4 e = ((const int4*)P.eidx)[i];
    uint4 o;
    o.x = ((unsigned)f2bf(gelu_(a.x * su.x) * g.x) << 16) | (unsigned)e.x;
    o.y = ((unsigned)f2bf(gelu_(a.y * su.y) * g.y) << 16) | (unsigned)e.y;
    o.z = ((unsigned)f2bf(gelu_(a.z * su.z) * g.z) << 16) | (unsigned)e.z;
    o.w = ((unsigned)f2bf(gelu_(a.w * su.w) * g.w) << 16) | (unsigned)e.w;
    ((uint4*)P.wact)[i] = o;
  }
}

__device__ void vacc_phase(const Params& P) {
  const int my_xcc = (int)((unsigned)__builtin_amdgcn_s_getreg((3 << 11) | 20) & 7u), my_rank = P.rank[blockIdx.x];
  const int lane = threadIdx.x & 63, w = threadIdx.x >> 6;
  const int r = lane >> 3, c = lane & 7;
  const bool hb = (lane & 32) != 0, b4 = (lane & 16) != 0, b3 = (lane & 8) != 0;
  int cen_ok = 1, cen_sum = 0, cen_mine = 0;
#pragma unroll
  for (int x = 0; x < 8; ++x) {
    const int cx = (int)__hip_atomic_load(P.bar + 15 * 512 + x * 32, __ATOMIC_RELAXED, __HIP_MEMORY_SCOPE_AGENT);
    cen_ok &= (cx > 0); cen_sum += cx; if (x == my_xcc) cen_mine = cx;
  }
  const bool fast = cen_ok && cen_sum == (int)gridDim.x;
  const int nwt = fast ? cen_mine * 4 : (int)gridDim.x * 4;
  const int wv = fast ? my_rank * 4 + w : (int)blockIdx.x * 4 + w;
  const int total = fast ? T_TOK : T_TOK * 8;
  const int cnt = (wv < total) ? (total - wv + nwt - 1) / nwt : 0;
  if (cnt == 0) return;
  const int slf = my_xcc;
#define VTOK(n, SL, TK) { int it_ = wv + ((n) < cnt ? (n) : cnt - 1) * nwt; SL = fast ? slf : (it_ & 7); TK = fast ? it_ : (it_ >> 3); }
#define VLOADEW(E, W, n) { int sl_, tk_; VTOK(n, sl_, tk_) (void)sl_; \
      const uint4* ep_ = (const uint4*)(P.wact + (size_t)tk_ * 128 + r * 16); \
      _Pragma("unroll") for (int i = 0; i < 4; ++i) { E[i] = ep_[i]; } }
#define VGATHER(V, E, n) { int sl_, tk_; VTOK(n, sl_, tk_) (void)tk_; const unsigned char* vb_ = P.V8 + (size_t)sl_ * (16384 * 128) + c * 16; \
      _Pragma("unroll") for (int i = 0; i < 4; ++i) { \
        V[i * 4 + 0] = *(const uint4*)(vb_ + (size_t)(E[i].x & 0xffffu) * 128); V[i * 4 + 1] = *(const uint4*)(vb_ + (size_t)(E[i].y & 0xffffu) * 128); \
        V[i * 4 + 2] = *(const uint4*)(vb_ + (size_t)(E[i].z & 0xffffu) * 128); V[i * 4 + 3] = *(const uint4*)(vb_ + (size_t)(E[i].w & 0xffffu) * 128); } }
#define VPROC(V, W, HV, n) { int sl_, tk_; VTOK(n, sl_, tk_) \
      f2v o[8]; _Pragma("unroll") for (int i = 0; i < 8; ++i) o[i] = (f2v){0.f, 0.f}; \
      _Pragma("unroll") for (int i = 0; i < 4; ++i) { axpy16_fp8(o, bfhi(W[i].x), V[i * 4 + 0]); axpy16_fp8(o, bfhi(W[i].y), V[i * 4 + 1]); \
        axpy16_fp8(o, bfhi(W[i].z), V[i * 4 + 2]); axpy16_fp8(o, bfhi(W[i].w), V[i * 4 + 3]); } \
      float f[16]; _Pragma("unroll") for (int i = 0; i < 8; ++i) { f[i * 2] = o[i].x; f[i * 2 + 1] = o[i].y; } \
      _Pragma("unroll") for (int i = 0; i < 8; ++i) { float sd = hb ? f[i] : f[i + 8], kp = hb ? f[i + 8] : f[i]; f[i] = kp + __shfl_xor(sd, 32); } \
      _Pragma("unroll") for (int i = 0; i < 4; ++i) { float sd = b4 ? f[i] : f[i + 4], kp = b4 ? f[i + 4] : f[i]; f[i] = kp + __shfl_xor(sd, 16); } \
      _Pragma("unroll") for (int i = 0; i < 2; ++i) { float sd = b3 ? f[i] : f[i + 2], kp = b3 ? f[i + 2] : f[i]; f[i] = kp + __shfl_xor(sd, 8); } \
      float2* hp_ = (float2*)(P.out + (size_t)tk_ * 1024 + sl_ * 128 + c * 16 + r * 2); \
      float2 hv_ = HV; hv_.x += f[0]; hv_.y += f[1]; nt_st_f2(hv_, hp_); \
      float sq_ = wsum(hv_.x * hv_.x + hv_.y * hv_.y); if (lane == 0) atomicAdd(P.ssf + tk_, sq_); }
#define VHLOAD(HV, n) { int sl_, tk_; VTOK(n, sl_, tk_) HV = *(const float2*)(P.out + (size_t)tk_ * 1024 + sl_ * 128 + c * 16 + r * 2); }
#define IT2(VC, EC, VN, EN, n) { float2 hv0_; VHLOAD(hv0_, n) VGATHER(VN, EN, (n) + 1) VLOADEW(eC, eC, (n) + 2) \
      __builtin_amdgcn_sched_barrier(0); VPROC(VC, EC, hv0_, n) \
      _Pragma("unroll") for (int i = 0; i < 4; ++i) EC[i] = eC[i]; }
  uint4 eA[4], eB[4], eC[4];
  uint4 vA[16], vB[16];
  VLOADEW(eA, eA, 0)
  VLOADEW(eB, eB, 1)
  VGATHER(vA, eA, 0)
  __builtin_amdgcn_sched_barrier(0);
  for (int n = 0; n < cnt; n += 2) {
    IT2(vA, eA, vB, eB, n)
    if (n + 1 < cnt) IT2(vB, eB, vA, eA, n + 1)
  }
}

__device__ void final_phase(const Params& P) {
  const int lane = threadIdx.x & 63, w = threadIdx.x >> 6;
  const int gwv = blockIdx.x * 4 + w, nw = gridDim.x * 4;
  float4 g[4];
#pragma unroll
  for (int c = 0; c < 4; ++c) g[c] = *(const float4*)(P.normf_g + lane * 16 + c * 4);
  for (int tok = gwv; tok < T_TOK; tok += nw) {
    float* hrow = P.out + (size_t)tok * 1024 + lane * 16;
    const float rf = rsqrtf(P.ssf[tok] * (1.f / 1024.f) + EPSF);
#pragma unroll
    for (int c = 0; c < 4; ++c) {
      float4 v = *(const float4*)(hrow + c * 4);
      *(float4*)(hrow + c * 4) = make_float4(v.x * rf * g[c].x, v.y * rf * g[c].y, v.z * rf * g[c].z, v.w * rf * g[c].w);
    }
  }
}

__device__ __forceinline__ void gbar(unsigned* bar, int k) {
  asm volatile("s_waitcnt vmcnt(0)" ::: "memory");
  __syncthreads();
  if (threadIdx.x == 0) {
    unsigned* base = bar + k * 512;
    const unsigned g = blockIdx.x & 7u;
    const unsigned gsz = (gridDim.x - g + 7u) >> 3;
    const unsigned ngroups = gridDim.x < 8u ? gridDim.x : 8u;
    __builtin_amdgcn_fence(__ATOMIC_RELEASE, "agent");
    asm volatile("s_waitcnt vmcnt(0)" ::: "memory");
    const unsigned old = __hip_atomic_fetch_add(base + g * 32, 1u, __ATOMIC_RELAXED, __HIP_MEMORY_SCOPE_AGENT);
    if (old == gsz - 1u) __hip_atomic_fetch_add(base + 256, 1u, __ATOMIC_RELAXED, __HIP_MEMORY_SCOPE_AGENT);
    unsigned spins = 0;
    while (__hip_atomic_load(base + 256, __ATOMIC_RELAXED, __HIP_MEMORY_SCOPE_AGENT) < ngroups && spins < (1u << 22)) {
      __builtin_amdgcn_s_sleep(1);
      ++spins;
    }
    __builtin_amdgcn_fence(__ATOMIC_ACQUIRE, "agent");
    asm volatile("s_waitcnt vmcnt(0)" ::: "memory");
  }
  __syncthreads();
}

#define SMEM_BYTES 74752

template <int PH>
__device__ __forceinline__ void run_phase(const Params& P, char* smem) {
  if (PH == 0) phase_prep(P, smem);
  if (PH == 1) gemm256_phase<EPI_INPROJ>(P, smem, P.xb, P.WinT, T_TOK, 1536, 1024);
  if (PH == 2) { lru_phase<false>(P, smem); s5_phase<false>(P); }
  if (PH == 3) carry_phase(P);
  if (PH == 4) { lru_phase<true>(P, smem); s5_phase<true>(P); }
  if (PH == 5) gemm_phase<EPI_GLU>(P, smem, P.gs5, P.GluT, T_TOK, 512, 512);
  if (PH == 6) gemm256_phase<EPI_OUT>(P, smem, P.ycat, P.WoutT, T_TOK, 1024, 1024);
  if (PH == 7) gemm256_phase<EPI_Q>(P, smem, P.hb, P.WqT, T_TOK, 2048, 1024);
  if (PH == 8) cand_phase(P, smem);
  if (PH == 9) udot_phase(P);
  if (PH == 10) ucomb_phase(P);
  if (PH == 11) vacc_phase(P);
  if (PH == 12) final_phase(P);
}

template <int LO, int HI>
__global__ void __launch_bounds__(256, 2) mk(Params P) {
  __shared__ __attribute__((aligned(16))) char smem[SMEM_BYTES];
  cg::grid_group grid = cg::this_grid();
#ifndef REPEAT_MASK
#define REPEAT_MASK 0
#endif
#define PHASE(n) if (LO <= n && n <= HI) { if ((REPEAT_MASK >> n) & 1) { run_phase<n>(P, smem); grid.sync(); } run_phase<n>(P, smem); if (n < HI) gbar(P.bar, n); }
  if (threadIdx.x == 0) {
    const unsigned xcc = (unsigned)__builtin_amdgcn_s_getreg((3 << 11) | 20) & 7u;
    const unsigned rk = __hip_atomic_fetch_add(P.bar + 15 * 512 + xcc * 32, 1u, __ATOMIC_RELAXED, __HIP_MEMORY_SCOPE_AGENT);
    P.rank[blockIdx.x] = (int)rk;
  }
  if (P.bar == nullptr) grid.sync();
  PHASE(0) PHASE(1) PHASE(2) PHASE(3) PHASE(4) PHASE(5) PHASE(6) PHASE(7) PHASE(8) PHASE(9) PHASE(10) PHASE(11) PHASE(12)
}

extern "C" void kernel_launch(void* const* d_in, const int* in_sizes, int n_in, void* d_out, int out_size,
                              void* d_ws, size_t ws_size, hipStream_t stream) {
  Params P{};
  const float** pin = (const float**)&P;
  for (int i = 0; i < 30; ++i) pin[i] = (const float*)d_in[i];
  P.out = (float*)d_out;
  char* ws = (char*)d_ws;
  size_t off = 0;
  auto take = [&](size_t bytes) { char* r = ws + off; off += (bytes + 255) & ~(size_t)255; return r; };
  const size_t MB = 1024 * 1024;
  char* RA = take(128 * MB);
  char* RB = take(256 * MB);
  char* RC = take(128 * MB);
  char* RD = take(96 * MB);
  P.xb = (u16*)RA; P.ycat = (u16*)RA;
  P.p = (u16*)RB; P.q = (u16*)RB;
  P.E = (float*)RC; P.Hs = (u16*)(RC + 64 * MB); P.hb = (u16*)RC;
  P.gs5 = (u16*)RD; P.eidx = (int*)RD; P.gw = (float*)(RD + 32 * MB); P.suv = (float*)(RD + 64 * MB);
  P.U8 = (unsigned char*)take(16 * MB); P.V8 = (unsigned char*)take(16 * MB);
  P.su = (float*)take(16384 * 4); P.sv = (float*)take(16384 * 4);
  P.WinT = (u16*)take(1536 * 1024 * 2); P.GluT = (u16*)take(512 * 512 * 2);
  P.WoutT = (u16*)take(1024 * 1024 * 2); P.WqT = (u16*)take(2048 * 1024 * 2);
  P.K1b = (u16*)take(128 * 128 * 2); P.K2b = (u16*)take(128 * 128 * 2);
  P.WaT = (u16*)take(8 * 4096 * 2); P.WxT = (u16*)take(8 * 4096 * 2);
  P.MF = (u16*)take(32 * 256 * 384 * 2); P.G = (u16*)take(32 * 128 * 256 * 2);
  P.spv = (float*)take(512 * 4);
  P.ssf = (float*)take(T_TOK * 4); P.wact = (float*)RA; P.part = (float*)RB; P.t16 = (float*)RB;
  P.ssa = (float*)take(T_TOK * 4); P.ssb = (float*)take(T_TOK * 4); P.ss2 = (float*)take(T_TOK * 4);
  P.rstd1 = (float*)take(T_TOK * 4); P.A16 = (float*)take(32 * 64 * 2 * 4);
  P.Acar = (float*)take(32 * 32 * 512 * 4); P.Hcar = (float*)take(32 * 32 * 512 * 4); P.Hin = (float*)take(32 * 32 * 512 * 4);

  P.bar = (unsigned*)take(16 * 2048);
  P.au = (unsigned*)take((size_t)T_TOK * 512 * 4);
  P.rank = (int*)take(4096 * 4);
  static int grid_blocks = 0;
#if ONE_LAUNCH
  (void)hipMemsetAsync(P.bar, 0, 16 * 2048, stream);
  if (!grid_blocks) {
    int dev = 0, cus = 0, per_cu = 0;
    (void)hipGetDevice(&dev);
    (void)hipDeviceGetAttribute(&cus, hipDeviceAttributeMultiprocessorCount, dev);
    (void)hipOccupancyMaxActiveBlocksPerMultiprocessor(&per_cu, mk<0, NPHASE - 1>, 256, 0);
    if (per_cu > 2) per_cu = 2;
    if (per_cu < 1) per_cu = 1;
    grid_blocks = cus * per_cu;
  }
  void* args[] = {&P};
  hipError_t e = hipLaunchCooperativeKernel((void*)mk<0, NPHASE - 1>, dim3(grid_blocks), dim3(256), args, 0, stream);
  if (e != hipSuccess) fprintf(stderr, "cooperative launch failed: %s (grid %d)\n", hipGetErrorString(e), grid_blocks);
#else
  if (!grid_blocks) {
    int dev = 0, cus = 0;
    (void)hipGetDevice(&dev);
    (void)hipDeviceGetAttribute(&cus, hipDeviceAttributeMultiprocessorCount, dev);
    grid_blocks = cus * 2;
  }
  mk<0, 0><<<grid_blocks, 256, 0, stream>>>(P);
  mk<1, 1><<<grid_blocks, 256, 0, stream>>>(P);
  mk<2, 2><<<grid_blocks, 256, 0, stream>>>(P);
  mk<3, 3><<<grid_blocks, 256, 0, stream>>>(P);
  mk<4, 4><<<grid_blocks, 256, 0, stream>>>(P);
  mk<5, 5><<<grid_blocks, 256, 0, stream>>>(P);
  mk<6, 6><<<grid_blocks, 256, 0, stream>>>(P);
  mk<7, 7><<<grid_blocks, 256, 0, stream>>>(P);
  mk<8, 8><<<grid_blocks, 256, 0, stream>>>(P);
  mk<9, 9><<<grid_blocks, 256, 0, stream>>>(P);
#endif
}
```

```cpp
#include <hip/hip_runtime.h>
#include <hip/hip_cooperative_groups.h>
#include <cstdio>
namespace cg = cooperative_groups;

typedef unsigned short u16;
using bf16x8 = __attribute__((ext_vector_type(8))) short;
using f32x4 = __attribute__((ext_vector_type(4))) float;
using f32x16 = __attribute__((ext_vector_type(16))) float;

#ifndef ONE_LAUNCH
#define ONE_LAUNCH 1
#endif

#define T_TOK 65536
#define EPSF 1e-6f
#define NPHASE 13

struct Params {
  const float *x, *norm1_g, *w_in, *conv_w, *conv_b, *lru_wa, *lru_ba, *lru_wx, *lru_bx, *lru_lambda;
  const float *s5_lre, *s5_lim, *s5_logdt, *s5_bre, *s5_bim, *s5_cre, *s5_cim, *s5_d, *glu_w, *glu_b;
  const float *gnorm_lru, *gnorm_s5, *w_out, *norm2_g, *wq, *k1, *k2, *pu, *pv, *normf_g;
  float* out;
  u16 *xb, *WinT, *GluT, *WoutT, *WqT, *K1b, *K2b, *Ub, *Vb, *WaT, *WxT, *MF, *G, *p, *Hs, *ycat, *gs5, *hb, *q;
  float *rstd1, *A16, *Acar, *Hcar, *Hin, *E, *gw, *suv, *su, *sv, *ssa, *ssb, *ss2, *ssf, *wact, *part, *spv, *t16;
  int* eidx;
  unsigned char *U8, *V8;
  unsigned* bar;
  unsigned* au;
  int* rank;
};

__device__ __forceinline__ u16 f2bf(float f) {
  unsigned u = __float_as_uint(f);
  u += 0x7fffu + ((u >> 16) & 1u);
  return (u16)(u >> 16);
}
__device__ __forceinline__ float bf2f(u16 h) { return __uint_as_float(((unsigned)h) << 16); }
__device__ __forceinline__ unsigned pack2(float a, float b) { return (unsigned)f2bf(a) | (((unsigned)f2bf(b)) << 16); }
__device__ __forceinline__ float bflo(unsigned u) { return __uint_as_float(u << 16); }
__device__ __forceinline__ float bfhi(unsigned u) { return __uint_as_float(u & 0xffff0000u); }
__device__ __forceinline__ float sigmoid_(float x) { return __builtin_amdgcn_rcpf(1.f + __expf(-x)); }
__device__ __forceinline__ float gelu_(float x) {
  float z = 0.7978845608028654f * (x + 0.044715f * x * x * x);
  return x * __builtin_amdgcn_rcpf(1.f + __expf(-2.f * z));
}
__device__ __forceinline__ float wsum(float v) {
#pragma unroll
  for (int o = 32; o; o >>= 1) v += __shfl_xor(v, o);
  return v;
}
__device__ __forceinline__ float sq8(uint4 v) {
  float s = 0.f, t;
  t = bflo(v.x); s += t * t; t = bfhi(v.x); s += t * t;
  t = bflo(v.y); s += t * t; t = bfhi(v.y); s += t * t;
  t = bflo(v.z); s += t * t; t = bfhi(v.z); s += t * t;
  t = bflo(v.w); s += t * t; t = bfhi(v.w); s += t * t;
  return s;
}
typedef unsigned u32x4e __attribute__((ext_vector_type(4)));
typedef float f32x2e __attribute__((ext_vector_type(2)));
__device__ __forceinline__ uint4 nt_ld_u4(const void* p) { u32x4e v = __builtin_nontemporal_load((const u32x4e*)p); return make_uint4(v.x, v.y, v.z, v.w); }
__device__ __forceinline__ float4 nt_ld_f4(const void* p) { f32x4 v = __builtin_nontemporal_load((const f32x4*)p); return make_float4(v.x, v.y, v.z, v.w); }
__device__ __forceinline__ float2 nt_ld_f2(const void* p) { f32x2e v = __builtin_nontemporal_load((const f32x2e*)p); return make_float2(v.x, v.y); }
__device__ __forceinline__ void nt_st_f2(float2 v, void* p) { f32x2e t = {v.x, v.y}; __builtin_nontemporal_store(t, (f32x2e*)p); }
#define MFMA16(a, b, c) __builtin_amdgcn_mfma_f32_16x16x32_bf16(a, b, c, 0, 0, 0)
#define MFMA32(a, b, c) __builtin_amdgcn_mfma_f32_32x32x16_bf16(a, b, c, 0, 0, 0)

__device__ void transpose_fold(const float* src, const float* g, u16* dst, int ldd, int K, int N, char* smem) {
  float* tl = (float*)smem;
  const int tid = threadIdx.x;
  const int tk = K / 64, tn = N / 64;
  for (int t = blockIdx.x; t < tk * tn; t += gridDim.x) {
    int k0 = (t / tn) * 64, n0 = (t % tn) * 64;
    __syncthreads();
    for (int i = 0; i < 16; ++i) {
      int k = (tid >> 6) + i * 4, n = tid & 63;
      float v = src[(size_t)(k0 + k) * N + n0 + n];
      if (g) v *= g[k0 + k];
      tl[k * 65 + n] = v;
    }
    __syncthreads();
    for (int i = 0; i < 16; ++i) {
      int n = (tid >> 6) + i * 4, k = tid & 63;
      dst[(size_t)(n0 + n) * ldd + k0 + k] = f2bf(tl[k * 65 + n]);
    }
  }
}

__device__ void s5_prep(const Params& P, char* smem, int g) {
  float* apw = (float*)smem;
  float* bb = apw + 17 * 64 * 2;
  float* kk = bb + 64 * 16 * 2;
  const int tid = threadIdx.x;
  __syncthreads();
  if (tid < 64) {
    int pp = tid;
    float lr = P.s5_lre[g * 64 + pp], li = P.s5_lim[g * 64 + pp];
    float dt = expf(P.s5_logdt[g]);
    float mag = expf(lr * dt);
    double ang = (double)li * (double)dt;
    double kq = rint(ang * 0.15915494309189535);
    float r = (float)(ang - kq * 6.283185307179586);
    float sn = __sinf(r), cs = __cosf(r);
    {
      sn = sinf(r); cs = cosf(r);
    }
    float are = mag * cs, aim = mag * sn;
    float den = lr * lr + li * li;
    float nre = are - 1.f, nim = aim;
    float zre = (nre * lr + nim * li) / den, zim = (nim * lr - nre * li) / den;
    float pr = 1.f, pi = 0.f;
    for (int d = 0; d <= 16; ++d) {
      apw[(d * 64 + pp) * 2] = pr; apw[(d * 64 + pp) * 2 + 1] = pi;
      float nr = pr * are - pi * aim, ni = pr * aim + pi * are;
      pr = nr; pi = ni;
    }
    P.A16[(g * 64 + pp) * 2] = apw[(16 * 64 + pp) * 2];
    P.A16[(g * 64 + pp) * 2 + 1] = apw[(16 * 64 + pp) * 2 + 1];
    for (int j = 0; j < 16; ++j) {
      float br = P.s5_bre[(g * 64 + pp) * 16 + j], bi = P.s5_bim[(g * 64 + pp) * 16 + j];
      bb[(pp * 16 + j) * 2] = zre * br - zim * bi;
      bb[(pp * 16 + j) * 2 + 1] = zre * bi + zim * br;
    }
  }
  __syncthreads();
  for (int rr = 0; rr < 16; ++rr) {
    int e = tid + rr * 256;
    int d = e >> 8, i = (e >> 4) & 15, j = e & 15;
    float s = 0.f;
    for (int pp = 0; pp < 64; ++pp) {
      float cr = P.s5_cre[(g * 16 + i) * 64 + pp], ci = P.s5_cim[(g * 16 + i) * 64 + pp];
      float ar = apw[(d * 64 + pp) * 2], ai = apw[(d * 64 + pp) * 2 + 1];
      float xr = cr * ar - ci * ai, xi = cr * ai + ci * ar;
      s += xr * bb[(pp * 16 + j) * 2] - xi * bb[(pp * 16 + j) * 2 + 1];
    }
    kk[e] = s;
  }
  __syncthreads();
  u16* MFg = P.MF + (size_t)g * 256 * 384;
  for (int it = 0; it < 192; ++it) {
    int e = tid + it * 256;
    int m = e / 192, cp = (e % 192) * 2;
    int t = m >> 4, i = m & 15;
    float v[2];
    for (int q = 0; q < 2; ++q) {
      int col = cp + q;
      float val;
      if (col < 256) {
        int sg = col >> 4, j = col & 15;
        val = (sg <= t) ? kk[((t - sg) * 16 + i) * 16 + j] : 0.f;
        if (sg == t && i == j) val += P.s5_d[g * 16 + i];
      } else {
        int pc = col - 256, pp = pc & 63, im = pc >> 6;
        float cr = P.s5_cre[(g * 16 + i) * 64 + pp], ci = P.s5_cim[(g * 16 + i) * 64 + pp];
        float ar = apw[((t + 1) * 64 + pp) * 2], ai = apw[((t + 1) * 64 + pp) * 2 + 1];
        float xr = cr * ar - ci * ai, xi = cr * ai + ci * ar;
        val = im ? -xi : xr;
      }
      v[q] = val;
    }
    *(unsigned*)(MFg + (size_t)m * 384 + cp) = pack2(v[0], v[1]);
  }
  u16* Gg = P.G + (size_t)g * 128 * 256;
  for (int it = 0; it < 64; ++it) {
    int e = tid + it * 256;
    int row = e >> 7, cp = (e & 127) * 2;
    int im = row >> 6, pp = row & 63;
    float v[2];
    for (int q = 0; q < 2; ++q) {
      int col = cp + q, sg = col >> 4, j = col & 15;
      float ar = apw[((15 - sg) * 64 + pp) * 2], ai = apw[((15 - sg) * 64 + pp) * 2 + 1];
      float br = bb[(pp * 16 + j) * 2], bi = bb[(pp * 16 + j) * 2 + 1];
      v[q] = im ? (ar * bi + ai * br) : (ar * br - ai * bi);
    }
    *(unsigned*)(Gg + (size_t)row * 256 + cp) = pack2(v[0], v[1]);
  }
}

__device__ void wqk_prep(const Params& P, char* smem) {
  float* Wt = (float*)smem;
  float* Kt = Wt + 64 * 129;
  const int tid = threadIdx.x;
  for (int item = blockIdx.x; item < 512; item += gridDim.x) {
    const int hs = item >> 5, kb = (item >> 1) & 15, kh = item & 1;
    const int cbase = (hs >> 1) * 256 + (hs & 1) * 128, k0 = kb * 64;
    __syncthreads();
    for (int i = 0; i < 32; ++i) {
      const int idx = tid + i * 256, row = idx >> 7, col = idx & 127;
      Wt[row * 129 + col] = P.wq[(size_t)(k0 + row) * 2048 + cbase + col] * P.norm2_g[k0 + row];
      const int ko = kh * 64 * 128 + idx;
      Kt[idx] = (hs & 1) ? P.k2[ko] : P.k1[ko];
    }
    __syncthreads();
    const int kk = tid & 63, q = tid >> 6;
    float acc[16];
#pragma unroll
    for (int i = 0; i < 16; ++i) acc[i] = 0.f;
    for (int d = 0; d < 128; d += 4) {
      const float w0 = Wt[kk * 129 + d], w1 = Wt[kk * 129 + d + 1], w2 = Wt[kk * 129 + d + 2], w3 = Wt[kk * 129 + d + 3];
#pragma unroll
      for (int i = 0; i < 16; ++i) {
        const float4 kv = *(const float4*)(Kt + (q * 16 + i) * 128 + d);
        acc[i] += w0 * kv.x + w1 * kv.y + w2 * kv.z + w3 * kv.w;
      }
    }
#pragma unroll
    for (int i = 0; i < 16; ++i) P.WqT[(size_t)(hs * 128 + kh * 64 + q * 16 + i) * 1024 + k0 + kk] = f2bf(acc[i]);
  }
}

__device__ void phase_prep(const Params& P, char* smem) {
  const int tid = threadIdx.x, lane = tid & 63, w = tid >> 6;
  {
    int g = (int)gridDim.x - 1 - (int)blockIdx.x;
    if (g < 32) s5_prep(P, smem, g);
  }
  for (int i = blockIdx.x * 256 + tid; i < 512; i += gridDim.x * 256) { const float lam = P.lru_lambda[i]; P.spv[i] = fmaxf(-lam, 0.f) + log1pf(expf(-fabsf(lam))); }
  for (int i = blockIdx.x * 256 + tid; i < T_TOK; i += gridDim.x * 256) { P.ssa[i] = 0.f; P.ssb[i] = 0.f; P.ss2[i] = 0.f; P.ssf[i] = 0.f; }
  const bool split = gridDim.x > 64;
  const bool bulk = !split || (int)blockIdx.x < (int)gridDim.x - 32;
  const int nbulk = split ? (int)gridDim.x - 32 : (int)gridDim.x;
  if (bulk) {
    const int gwv = blockIdx.x * 4 + w, nw = nbulk * 4;
    for (int r = gwv; r < T_TOK; r += nw) {
      const float4* src = (const float4*)(P.x + (size_t)r * 1024);
      float4 v[4];
      float ss = 0.f;
#pragma unroll
      for (int i = 0; i < 4; ++i) {
        v[i] = src[i * 64 + lane];
        ss += v[i].x * v[i].x + v[i].y * v[i].y + v[i].z * v[i].z + v[i].w * v[i].w;
      }
      ss = wsum(ss);
      if (lane == 0) P.rstd1[r] = rsqrtf(ss * (1.f / 1024.f) + EPSF);
      uint2* dst = (uint2*)(P.xb + (size_t)r * 1024);
#pragma unroll
      for (int i = 0; i < 4; ++i) dst[i * 64 + lane] = make_uint2(pack2(v[i].x, v[i].y), pack2(v[i].z, v[i].w));
    }
  }
  {
    const int gwv = blockIdx.x * 4 + w, nw = nbulk * 4;
    if (bulk)
    for (int r = gwv; r < 32768; r += nw) {
      const int isv = r >> 14, e = r & 16383;
      const float* src = (isv ? P.pv : P.pu) + (size_t)e * 1024 + lane * 16;
      float4 v[4];
      float m = 0.f;
#pragma unroll
      for (int i = 0; i < 4; ++i) {
        {
          float4 t = *(const float4*)(src + i * 4);
          const float4 g2 = *(const float4*)(P.norm2_g + lane * 16 + i * 4);
          v[i] = isv ? t : make_float4(t.x * g2.x, t.y * g2.y, t.z * g2.z, t.w * g2.w);
        }
        m = fmaxf(m, fmaxf(fmaxf(fabsf(v[i].x), fabsf(v[i].y)), fmaxf(fabsf(v[i].z), fabsf(v[i].w))));
      }
#pragma unroll
      for (int o = 32; o; o >>= 1) m = fmaxf(m, __shfl_xor(m, o));
      int ex = (int)((__float_as_uint(m) >> 23) & 255u) - 127;
      ex = ex < -100 ? -100 : (ex > 100 ? 100 : ex);
      const float sc = __uint_as_float((unsigned)(127 + 7 - ex) << 23);
      const float isc = __uint_as_float((unsigned)(127 - 7 + ex) << 23);
      unsigned pk[4];
#pragma unroll
      for (int i = 0; i < 4; ++i) {
        int t = __builtin_amdgcn_cvt_pk_fp8_f32(v[i].x * sc, v[i].y * sc, 0, false);
        t = __builtin_amdgcn_cvt_pk_fp8_f32(v[i].z * sc, v[i].w * sc, t, true);
        pk[i] = (unsigned)t;
      }
      unsigned char* dst = isv ? (P.V8 + (size_t)(lane >> 3) * (16384 * 128) + (size_t)e * 128 + (lane & 7) * 16)
                               : (P.U8 + (size_t)(lane >> 3) * (16384 * 128) + (size_t)e * 128 + (lane & 7) * 16);
      *(uint4*)dst = make_uint4(pk[0], pk[1], pk[2], pk[3]);
      if (lane == 0) { if (isv) P.sv[e] = isc; else P.su[e] = isc; }
    }
    size_t gt = (size_t)blockIdx.x * 256 + tid, nt = (size_t)gridDim.x * 256;
    for (size_t i = gt; i < 4096; i += nt) {
      float4 a = ((const float4*)P.k1)[i];
      ((uint2*)P.K1b)[i] = make_uint2(pack2(a.x, a.y), pack2(a.z, a.w));
      float4 b = ((const float4*)P.k2)[i];
      ((uint2*)P.K2b)[i] = make_uint2(pack2(b.x, b.y), pack2(b.z, b.w));
    }
  }
  transpose_fold(P.w_in, P.norm1_g, P.WinT, 1024, 1024, 1536, smem);
  transpose_fold(P.glu_w, nullptr, P.GluT, 512, 512, 512, smem);
  transpose_fold(P.w_out, P.gnorm_lru, P.WoutT, 1024, 512, 1024, smem);
  transpose_fold(P.w_out + 512 * 1024, P.gnorm_s5, P.WoutT + 512, 1024, 512, 1024, smem);
  wqk_prep(P, smem);
  for (int h = 0; h < 8; ++h) {
    transpose_fold(P.lru_wa + h * 4096, nullptr, P.WaT + h * 4096, 64, 64, 64, smem);
    transpose_fold(P.lru_wx + h * 4096, nullptr, P.WxT + h * 4096, 64, 64, 64, smem);
  }
}

__device__ __forceinline__ void ce(float& hi, float& lo) {
  float a = hi, b = lo;
  asm("v_max_f32 %0, %1, %2" : "=v"(hi) : "v"(a), "v"(b));
  asm("v_min_f32 %0, %1, %2" : "=v"(lo) : "v"(a), "v"(b));
}
__device__ __forceinline__ float vmaxf(float a, float b) {
  float r;
  asm("v_max_f32 %0, %1, %2" : "=v"(r) : "v"(a), "v"(b));
  return r;
}
__device__ __forceinline__ void sort16(float (&v)[16]) {
#pragma unroll
  for (int k = 2; k <= 16; k <<= 1)
#pragma unroll
    for (int j = k >> 1; j > 0; j >>= 1)
#pragma unroll
      for (int i = 0; i < 16; ++i) {
        int l = i ^ j;
        if (l > i) {
          if ((i & k) == 0) ce(v[i], v[l]); else ce(v[l], v[i]);
        }
      }
}
__device__ __forceinline__ void bmerge16(float (&v)[16]) {
#pragma unroll
  for (int j = 8; j > 0; j >>= 1)
#pragma unroll
    for (int i = 0; i < 16; ++i) {
      int l = i ^ j;
      if (l > i) ce(v[i], v[l]);
    }
}
__device__ __forceinline__ void merge_top16(float (&x)[16], const float (&y)[16]) {
#pragma unroll
  for (int i = 0; i < 16; ++i) x[i] = vmaxf(x[i], y[15 - i]);
  bmerge16(x);
}

enum { EPI_INPROJ = 0, EPI_GLU = 1, EPI_OUT = 2, EPI_Q = 3 };
#define LDT 64

template <int EPI>
__device__ void gemm_phase(const Params& P, char* smem, const u16* __restrict__ A, const u16* __restrict__ Bt,
                           int M, int N, int K) {
  constexpr int TE = 128 * LDT;
  u16* AsB = (u16*)smem;
  u16* BsB = AsB + 2 * TE;
  const int tid = threadIdx.x, lane = tid & 63, w = tid >> 6, wm = w >> 1, wn = w & 1;
  const int l15 = lane & 15, lq = lane >> 4;
  const int NT = N / 128, MT = M / 128, ntiles = MT * NT, nk = K / 64;
  int vb = blockIdx.x;
  if ((gridDim.x & 7) == 0) vb = (blockIdx.x & 7) * (gridDim.x >> 3) + (blockIdx.x >> 3);
  const int ldr = tid >> 3, ldc = (tid & 7) * 8;
  const int ldsw = ((tid & 7) ^ ((ldr >> 1) & 7)) * 8;
  const int rsw = (l15 >> 1) & 7;
  const int cnt = (vb < ntiles) ? (ntiles - vb + (int)gridDim.x - 1) / (int)gridDim.x : 0;
  const int total = cnt * nk;
  if (total == 0) return;
  f32x4 acc[4][4];
#pragma unroll
  for (int i = 0; i < 4; ++i)
#pragma unroll
    for (int j = 0; j < 4; ++j) acc[i][j] = (f32x4){0.f, 0.f, 0.f, 0.f};
  uint4 pa0, pa1, pa2, pa3, pb0, pb1, pb2, pb3, qa0, qa1, qa2, qa3, qb0, qb1, qb2, qb3;
  const u16 *Ag, *Bg;
#define STEP_ADDR(st) { int st_ = (st) < total ? (st) : total - 1; int ti_ = st_ / nk, kk_ = st_ - ti_ * nk; \
      int tl_ = vb + ti_ * (int)gridDim.x; int r0_ = (tl_ / NT) * 128, c0_ = (tl_ % NT) * 128; \
      { const int hm_ = (nk >> 1) - 1; kk_ = (kk_ & ~hm_) | ((kk_ + (tl_ % NT) + (tl_ / NT)) & hm_); } \
      Ag = A + (size_t)(r0_ + ldr) * K + ldc + kk_ * 64; Bg = Bt + (size_t)(c0_ + ldr) * K + ldc + kk_ * 64; }
#define GLD2(S, i) { S##a##i = *(const uint4*)(Ag + (size_t)(32 * i) * K); S##b##i = *(const uint4*)(Bg + (size_t)(32 * i) * K); }
#define GLDS(S, st) { STEP_ADDR(st) GLD2(S, 0) GLD2(S, 1) GLD2(S, 2) GLD2(S, 3) }
#define LST2(S, i, buf) { *(uint4*)(AsB + (buf) * TE + (ldr + 32 * i) * LDT + ldsw) = S##a##i; \
                          *(uint4*)(BsB + (buf) * TE + (ldr + 32 * i) * LDT + ldsw) = S##b##i; }
#define LSTS(S, buf) { LST2(S, 0, buf) LST2(S, 1, buf) LST2(S, 2, buf) LST2(S, 3, buf) }
#define COMPUTE(buf) { \
      const u16* As_ = AsB + (buf) * TE; const u16* Bs_ = BsB + (buf) * TE; \
      _Pragma("unroll") for (int ks = 0; ks < 2; ++ks) { \
        bf16x8 af[4], bfr[4]; \
        _Pragma("unroll") for (int mt = 0; mt < 4; ++mt) \
          af[mt] = *(const bf16x8*)(As_ + (wm * 64 + mt * 16 + l15) * LDT + (((ks * 4 + lq) ^ rsw) * 8)); \
        _Pragma("unroll") for (int nt = 0; nt < 4; ++nt) \
          bfr[nt] = *(const bf16x8*)(Bs_ + (wn * 64 + nt * 16 + l15) * LDT + (((ks * 4 + lq) ^ rsw) * 8)); \
        _Pragma("unroll") for (int mt = 0; mt < 4; ++mt) \
          _Pragma("unroll") for (int nt = 0; nt < 4; ++nt) acc[mt][nt] = MFMA16(bfr[nt], af[mt], acc[mt][nt]); \
      } }
#define RESCALE() { if (EPI == EPI_OUT) { \
      _Pragma("unroll") for (int mt = 0; mt < 4; ++mt) { \
        const int row = row0 + wm * 64 + mt * 16 + l15; \
        const float ra_ = rsqrtf(P.ssa[row] * (1.f / 512.f) + EPSF), rb_ = rsqrtf(P.ssb[row] * (1.f / 512.f) + EPSF); \
        const float ratio = ra_ / rb_; \
        _Pragma("unroll") for (int nt = 0; nt < 4; ++nt) acc[mt][nt] *= ratio; } } }
  __syncthreads();
  GLDS(p, 0)
  __builtin_amdgcn_sched_barrier(0);
  GLDS(q, 1)
  __builtin_amdgcn_sched_barrier(0);
  LSTS(p, 0)
  GLDS(p, 2)
  __builtin_amdgcn_sched_barrier(0);
  for (int st = 0; st < total; st += 2) {
    const int ti = st / nk, kt = st - ti * nk;
    const int tile = vb + ti * (int)gridDim.x;
    const int row0 = (tile / NT) * 128, col0 = (tile % NT) * 128;
    __syncthreads();
    LSTS(q, 1)
    GLDS(q, st + 3)
    __builtin_amdgcn_sched_barrier(0);
    if (kt == nk / 2) RESCALE()
    COMPUTE(0)
    __syncthreads();
    LSTS(p, 0)
    GLDS(p, st + 4)
    __builtin_amdgcn_sched_barrier(0);
    COMPUTE(1)
    if (kt + 2 < nk) continue;
    if (EPI == EPI_Q) {
      float* xch = (float*)(smem + 65536);
      float lst[4][16];
#pragma unroll
      for (int mt = 0; mt < 4; ++mt) {
        const int lr = wm * 64 + mt * 16 + l15;
        const float sc = rsqrtf(P.ss2[row0 + lr] * (1.f / 1024.f) + EPSF);
#pragma unroll
        for (int nt = 0; nt < 4; ++nt)
#pragma unroll
          for (int j = 0; j < 4; ++j) {
            const unsigned kidx = (unsigned)(wn * 64 + nt * 16 + lq * 4 + j);
            lst[mt][nt * 4 + j] = __uint_as_float((__float_as_uint(acc[mt][nt][j] * sc) & 0xffffff80u) | kidx);
          }
#pragma unroll
        for (int nt = 0; nt < 4; ++nt) acc[mt][nt] = (f32x4){0.f, 0.f, 0.f, 0.f};
        sort16(lst[mt]);
        float y[16];
#pragma unroll
        for (int i = 0; i < 16; ++i) y[i] = __shfl_xor(lst[mt][i], 16);
        merge_top16(lst[mt], y);
#pragma unroll
        for (int i = 0; i < 16; ++i) y[i] = __shfl_xor(lst[mt][i], 32);
        merge_top16(lst[mt], y);
      }
      if (wn == 1 && lq == 0) {
#pragma unroll
        for (int mt = 0; mt < 4; ++mt) {
          float4* d4 = (float4*)(xch + (wm * 64 + mt * 16 + l15) * 16);
#pragma unroll
          for (int i = 0; i < 4; ++i) d4[i] = make_float4(lst[mt][i * 4], lst[mt][i * 4 + 1], lst[mt][i * 4 + 2], lst[mt][i * 4 + 3]);
        }
      }
      __syncthreads();
      if (wn == 0) {
        const int hs = col0 >> 7;
#pragma unroll
        for (int mt = 0; mt < 4; ++mt) {
          const int lr = wm * 64 + mt * 16 + l15;
          const float4* s4 = (const float4*)(xch + lr * 16);
          float y[16];
#pragma unroll
          for (int i = 0; i < 4; ++i) { const float4 t = s4[i]; y[i * 4] = t.x; y[i * 4 + 1] = t.y; y[i * 4 + 2] = t.z; y[i * 4 + 3] = t.w; }
          merge_top16(lst[mt], y);
          if (lq == 0) {
            float4* d4 = (float4*)(P.t16 + ((size_t)(row0 + lr) * 16 + hs) * 16);
#pragma unroll
            for (int i = 0; i < 4; ++i) d4[i] = make_float4(lst[mt][i * 4], lst[mt][i * 4 + 1], lst[mt][i * 4 + 2], lst[mt][i * 4 + 3]);
          }
        }
      }
      continue;
    }
#pragma unroll
    for (int mt = 0; mt < 4; ++mt) {
      const int lr = wm * 64 + mt * 16 + l15;
      const size_t row = (size_t)(row0 + lr);
      float sc = 1.f;
      if (EPI == EPI_INPROJ) sc = P.rstd1[row];
      if (EPI == EPI_OUT) sc = rsqrtf(P.ssb[row] * (1.f / 512.f) + EPSF);
      if (EPI == EPI_Q) sc = rsqrtf(P.ss2[row] * (1.f / 1024.f) + EPSF);
      float sq = 0.f;
#pragma unroll
      for (int nt = 0; nt < 4; ++nt) {
        const int col = col0 + wn * 64 + nt * 16 + lq * 4;
        f32x4 v = acc[mt][nt];
        if (EPI == EPI_INPROJ) {
          *(uint2*)(P.p + row * 1536 + col) = make_uint2(pack2(v[0] * sc, v[1] * sc), pack2(v[2] * sc, v[3] * sc));
        } else if (EPI == EPI_GLU) {
          uint2 gg = *(const uint2*)(P.gs5 + row * 512 + col);
          float4 gb = *(const float4*)(P.glu_b + col);
          float g0 = bflo(gg.x), g1 = bfhi(gg.x), g2 = bflo(gg.y), g3 = bfhi(gg.y);
          float o0 = g0 * sigmoid_(v[0] + gb.x), o1 = g1 * sigmoid_(v[1] + gb.y);
          float o2 = g2 * sigmoid_(v[2] + gb.z), o3 = g3 * sigmoid_(v[3] + gb.w);
          sq += o0 * o0 + o1 * o1 + o2 * o2 + o3 * o3;
          *(uint2*)(P.ycat + row * 1024 + 512 + col) = make_uint2(pack2(o0, o1), pack2(o2, o3));
        } else {
          float4 xv = *(const float4*)(P.x + row * 1024 + col);
          float4 h = make_float4(xv.x + v[0] * sc, xv.y + v[1] * sc, xv.z + v[2] * sc, xv.w + v[3] * sc);
          sq += h.x * h.x + h.y * h.y + h.z * h.z + h.w * h.w;
          *(float4*)(P.out + row * 1024 + col) = h;
          *(uint2*)(P.hb + row * 1024 + col) = make_uint2(pack2(h.x, h.y), pack2(h.z, h.w));
        }
      }
      if (EPI == EPI_GLU || EPI == EPI_OUT) {
        sq += __shfl_xor(sq, 16);
        sq += __shfl_xor(sq, 32);
        if (lq == 0) atomicAdd((EPI == EPI_GLU ? P.ssb : P.ss2) + row, sq);
      }
#pragma unroll
      for (int nt = 0; nt < 4; ++nt) acc[mt][nt] = (f32x4){0.f, 0.f, 0.f, 0.f};
    }
  }
}

template <int EPI>
__device__ void gemm256_phase(const Params& P, char* smem, const u16* __restrict__ A, const u16* __restrict__ Bt,
                              int M, int N, int K) {
  u16* As = (u16*)smem;
  u16* Bs = As + 256 * 64;
  const int tid = threadIdx.x, lane = tid & 63, w = tid >> 6, wm = w >> 1, wn = w & 1;
  const int l15 = lane & 15, lq = lane >> 4;
  const int NT = N / 128, MT = M / 256, ntiles = MT * NT, nk = K / 64;
  int vb = blockIdx.x;
  if ((gridDim.x & 7) == 0) vb = (blockIdx.x & 7) * (gridDim.x >> 3) + (blockIdx.x >> 3);
  const int ldr = tid >> 3, ldc = (tid & 7) * 8;
  const int ldsw = ((tid & 7) ^ ((ldr >> 1) & 7)) * 8;
  const int rsw = (l15 >> 1) & 7;
  const int cnt = (vb < ntiles) ? (ntiles - vb + (int)gridDim.x - 1) / (int)gridDim.x : 0;
  const int total = cnt * nk;
  if (total == 0) return;
  f32x4 acc[8][4];
#pragma unroll
  for (int i = 0; i < 8; ++i)
#pragma unroll
    for (int j = 0; j < 4; ++j) acc[i][j] = (f32x4){0.f, 0.f, 0.f, 0.f};
  uint4 ga0, ga1, ga2, ga3, ga4, ga5, ga6, ga7, gb0, gb1, gb2, gb3;
  const u16 *Ag, *Bg;
#define G2_ADDR(st) { int st_ = (st) < total ? (st) : total - 1; int ti_ = st_ / nk, kk_ = st_ - ti_ * nk; \
      int tl_ = vb + ti_ * (int)gridDim.x; int r0_ = (tl_ / NT) * 256, c0_ = (tl_ % NT) * 128; \
      Ag = A + (size_t)(r0_ + ldr) * K + ldc + kk_ * 64; Bg = Bt + (size_t)(c0_ + ldr) * K + ldc + kk_ * 64; }
#define G2_LDA(i) ga##i = *(const uint4*)(Ag + (size_t)(32 * i) * K);
#define G2_LDB(i) gb##i = *(const uint4*)(Bg + (size_t)(32 * i) * K);
#define G2_GLD(st) { G2_ADDR(st) G2_LDA(0) G2_LDA(1) G2_LDA(2) G2_LDA(3) G2_LDA(4) G2_LDA(5) G2_LDA(6) G2_LDA(7) G2_LDB(0) G2_LDB(1) G2_LDB(2) G2_LDB(3) }
#define G2_STA(i) *(uint4*)(As + (ldr + 32 * i) * 64 + ldsw) = ga##i;
#define G2_STB(i) *(uint4*)(Bs + (ldr + 32 * i) * 64 + ldsw) = gb##i;
#define G2_LST() { G2_STA(0) G2_STA(1) G2_STA(2) G2_STA(3) G2_STA(4) G2_STA(5) G2_STA(6) G2_STA(7) G2_STB(0) G2_STB(1) G2_STB(2) G2_STB(3) }
  G2_GLD(0)
  for (int st = 0; st < total; ++st) {
    const int ti = st / nk, kt = st - ti * nk;
    const int tile = vb + ti * (int)gridDim.x;
    const int row0 = (tile / NT) * 256, col0 = (tile % NT) * 128;
    __syncthreads();
    G2_LST()
    G2_GLD(st + 1)
    __builtin_amdgcn_sched_barrier(0);
    __syncthreads();
    if (EPI == EPI_OUT && kt == nk / 2) {
#pragma unroll
      for (int mt = 0; mt < 8; ++mt) {
        const int row = row0 + wm * 128 + mt * 16 + l15;
        const float ra_ = rsqrtf(P.ssa[row] * (1.f / 512.f) + EPSF), rb_ = rsqrtf(P.ssb[row] * (1.f / 512.f) + EPSF);
        const float ratio = ra_ / rb_;
#pragma unroll
        for (int nt = 0; nt < 4; ++nt) acc[mt][nt] *= ratio;
      }
    }
#pragma unroll
    for (int ks = 0; ks < 2; ++ks) {
      bf16x8 bfr[4];
#pragma unroll
      for (int nt = 0; nt < 4; ++nt)
        bfr[nt] = *(const bf16x8*)(Bs + (wn * 64 + nt * 16 + l15) * 64 + (((ks * 4 + lq) ^ rsw) * 8));
#pragma unroll
      for (int hh = 0; hh < 2; ++hh) {
        bf16x8 af[4];
#pragma unroll
        for (int m = 0; m < 4; ++m)
          af[m] = *(const bf16x8*)(As + (wm * 128 + (hh * 4 + m) * 16 + l15) * 64 + (((ks * 4 + lq) ^ rsw) * 8));
#pragma unroll
        for (int m = 0; m < 4; ++m)
#pragma unroll
          for (int nt = 0; nt < 4; ++nt) acc[hh * 4 + m][nt] = MFMA16(bfr[nt], af[m], acc[hh * 4 + m][nt]);
      }
    }
    if (kt + 1 < nk) continue;
    if (EPI == EPI_Q) {
      float* xch = (float*)(smem + 49152);
      float lst[8][16];
#pragma unroll
      for (int mt = 0; mt < 8; ++mt) {
        const int lr = wm * 128 + mt * 16 + l15;
        const float sc = rsqrtf(P.ss2[row0 + lr] * (1.f / 1024.f) + EPSF);
#pragma unroll
        for (int nt = 0; nt < 4; ++nt)
#pragma unroll
          for (int j = 0; j < 4; ++j) {
            const unsigned kidx = (unsigned)(wn * 64 + nt * 16 + lq * 4 + j);
            lst[mt][nt * 4 + j] = __uint_as_float((__float_as_uint(acc[mt][nt][j] * sc) & 0xffffff80u) | kidx);
          }
#pragma unroll
        for (int nt = 0; nt < 4; ++nt) acc[mt][nt] = (f32x4){0.f, 0.f, 0.f, 0.f};
        sort16(lst[mt]);
        float y[16];
#pragma unroll
        for (int i = 0; i < 16; ++i) y[i] = __shfl_xor(lst[mt][i], 16);
        merge_top16(lst[mt], y);
#pragma unroll
        for (int i = 0; i < 16; ++i) y[i] = __shfl_xor(lst[mt][i], 32);
        merge_top16(lst[mt], y);
      }
      if (wn == 1 && lq == 0) {
#pragma unroll
        for (int mt = 0; mt < 8; ++mt) {
          float4* d4 = (float4*)(xch + (wm * 128 + mt * 16 + l15) * 16);
#pragma unroll
          for (int i = 0; i < 4; ++i) d4[i] = make_float4(lst[mt][i * 4], lst[mt][i * 4 + 1], lst[mt][i * 4 + 2], lst[mt][i * 4 + 3]);
        }
      }
      __syncthreads();
      if (wn == 0) {
        const int hs = col0 >> 7;
#pragma unroll
        for (int mt = 0; mt < 8; ++mt) {
          const int lr = wm * 128 + mt * 16 + l15;
          const float4* s4 = (const float4*)(xch + lr * 16);
          float y[16];
#pragma unroll
          for (int i = 0; i < 4; ++i) { const float4 t = s4[i]; y[i * 4] = t.x; y[i * 4 + 1] = t.y; y[i * 4 + 2] = t.z; y[i * 4 + 3] = t.w; }
          merge_top16(lst[mt], y);
          if (lq == 0) {
            float4* d4 = (float4*)(P.t16 + ((size_t)(row0 + lr) * 16 + hs) * 16);
#pragma unroll
            for (int i = 0; i < 4; ++i) d4[i] = make_float4(lst[mt][i * 4], lst[mt][i * 4 + 1], lst[mt][i * 4 + 2], lst[mt][i * 4 + 3]);
          }
        }
      }
      continue;
    }
#pragma unroll
    for (int mt = 0; mt < 8; ++mt) {
      const int lr = wm * 128 + mt * 16 + l15;
      const size_t row = (size_t)(row0 + lr);
      float sc = 1.f;
      if (EPI == EPI_INPROJ) sc = P.rstd1[row];
      if (EPI == EPI_OUT) sc = rsqrtf(P.ssb[row] * (1.f / 512.f) + EPSF);
      float sq = 0.f;
#pragma unroll
      for (int nt = 0; nt < 4; ++nt) {
        const int col = col0 + wn * 64 + nt * 16 + lq * 4;
        f32x4 v = acc[mt][nt];
        if (EPI == EPI_INPROJ) {
          *(uint2*)(P.p + row * 1536 + col) = make_uint2(pack2(v[0] * sc, v[1] * sc), pack2(v[2] * sc, v[3] * sc));
        } else if (EPI == EPI_GLU) {
          uint2 gg = *(const uint2*)(P.gs5 + row * 512 + col);
          float4 gb = *(const float4*)(P.glu_b + col);
          float g0 = bflo(gg.x), g1 = bfhi(gg.x), g2 = bflo(gg.y), g3 = bfhi(gg.y);
          float o0 = g0 * sigmoid_(v[0] + gb.x), o1 = g1 * sigmoid_(v[1] + gb.y);
          float o2 = g2 * sigmoid_(v[2] + gb.z), o3 = g3 * sigmoid_(v[3] + gb.w);
          sq += o0 * o0 + o1 * o1 + o2 * o2 + o3 * o3;
          *(uint2*)(P.ycat + row * 1024 + 512 + col) = make_uint2(pack2(o0, o1), pack2(o2, o3));
        } else {
          float4 xv = *(const float4*)(P.x + row * 1024 + col);
          float4 h = make_float4(xv.x + v[0] * sc, xv.y + v[1] * sc, xv.z + v[2] * sc, xv.w + v[3] * sc);
          sq += h.x * h.x + h.y * h.y + h.z * h.z + h.w * h.w;
          *(float4*)(P.out + row * 1024 + col) = h;
          *(uint2*)(P.hb + row * 1024 + col) = make_uint2(pack2(h.x, h.y), pack2(h.z, h.w));
        }
        acc[mt][nt] = (f32x4){0.f, 0.f, 0.f, 0.f};
      }
      if (EPI == EPI_GLU || EPI == EPI_OUT) {
        sq += __shfl_xor(sq, 16);
        sq += __shfl_xor(sq, 32);
        if (lq == 0) atomicAdd((EPI == EPI_GLU ? P.ssb : P.ss2) + row, sq);
      }
    }
  }
}

__device__ __forceinline__ float one_minus_exp(float x) {
  const float ser = -x * (1.f + x * (0.5f + x * (0.16666667f + x * (0.041666668f + x * (0.0083333338f + x * 0.0013888889f)))));
  return (x > -0.5f) ? ser : (1.f - __expf(x));
}

template <bool FINAL>
__device__ void lru_phase(const Params& P, char* smem) {
  float* xcs = (float*)smem;
  float* a_s = xcs + 64 * 65;
  float* segA = a_s + 64 * 65;
  float* segH = segA + 256;
  const int tid = threadIdx.x, lane = tid & 63, w = tid >> 6;
  const int l15 = lane & 15, lq = lane >> 4;
  for (int item = blockIdx.x; item < 8192; item += gridDim.x) {
    const int head = item & 7, tile = (item >> 3) & 31, b = item >> 8;
    const int c0 = head * 64, t0 = tile * 64;
    __syncthreads();
    if (!FINAL) {
      bf16x8 af[2];
      {
        const int tl = w * 16 + l15;
        const int t = t0 + tl;
        const u16* prow = P.p + ((size_t)(b * 2048 + t)) * 1536 + c0;
#pragma unroll
        for (int ks = 0; ks < 2; ++ks) {
          const int ch = ks * 32 + lq * 8;
          float xc[8];
          {
            float4 b0 = *(const float4*)(P.conv_b + c0 + ch), b1 = *(const float4*)(P.conv_b + c0 + ch + 4);
            xc[0] = b0.x; xc[1] = b0.y; xc[2] = b0.z; xc[3] = b0.w; xc[4] = b1.x; xc[5] = b1.y; xc[6] = b1.z; xc[7] = b1.w;
          }
#pragma unroll
          for (int k = 0; k < 4; ++k) {
            if (t - 3 + k >= 0) {
              uint4 v = *(const uint4*)(prow + (k - 3) * 1536 + ch);
              float4 w0 = *(const float4*)(P.conv_w + k * 512 + c0 + ch), w1 = *(const float4*)(P.conv_w + k * 512 + c0 + ch + 4);
              xc[0] += w0.x * bflo(v.x); xc[1] += w0.y * bfhi(v.x); xc[2] += w0.z * bflo(v.y); xc[3] += w0.w * bfhi(v.y);
              xc[4] += w1.x * bflo(v.z); xc[5] += w1.y * bfhi(v.z); xc[6] += w1.z * bflo(v.w); xc[7] += w1.w * bfhi(v.w);
            }
          }
#pragma unroll
          for (int i = 0; i < 8; ++i) xcs[tl * 65 + ch + i] = xc[i];
          unsigned p0 = pack2(xc[0], xc[1]), p1 = pack2(xc[2], xc[3]), p2 = pack2(xc[4], xc[5]), p3 = pack2(xc[6], xc[7]);
          uint4 pk = make_uint4(p0, p1, p2, p3);
          af[ks] = *(bf16x8*)&pk;
        }
      }
      f32x4 accr[4], acci[4];
#pragma unroll
      for (int nt = 0; nt < 4; ++nt) {
        accr[nt] = (f32x4){0.f, 0.f, 0.f, 0.f};
        acci[nt] = (f32x4){0.f, 0.f, 0.f, 0.f};
#pragma unroll
        for (int ks = 0; ks < 2; ++ks) {
          bf16x8 ba = *(const bf16x8*)(P.WaT + head * 4096 + (nt * 16 + l15) * 64 + ks * 32 + lq * 8);
          bf16x8 bx = *(const bf16x8*)(P.WxT + head * 4096 + (nt * 16 + l15) * 64 + ks * 32 + lq * 8);
          accr[nt] = MFMA16(af[ks], ba, accr[nt]);
          acci[nt] = MFMA16(af[ks], bx, acci[nt]);
        }
      }
      __syncthreads();
#pragma unroll
      for (int nt = 0; nt < 4; ++nt) {
        const int ch = nt * 16 + l15;
        const float ba = P.lru_ba[c0 + ch], bx = P.lru_bx[c0 + ch], sp = P.spv[c0 + ch];
#pragma unroll
        for (int r = 0; r < 4; ++r) {
          const int tl = w * 16 + lq * 4 + r;
          float xf = xcs[tl * 65 + ch];
          float rr = sigmoid_(accr[nt][r] + ba), ig = sigmoid_(acci[nt][r] + bx);
          float la = -8.f * rr * sp;
          const float oma = one_minus_exp(la);
          const float om2 = one_minus_exp(2.f * la);
          float u = __builtin_amdgcn_sqrtf(om2) * ig * xf;
          a_s[tl * 65 + ch] = __uint_as_float((unsigned)f2bf(oma) | ((unsigned)f2bf(u) << 16));
        }
      }
      __syncthreads();
    }
    {
      const int ch = tid & 63, seg = tid >> 6;
      const size_t tok0 = (size_t)(b * 2048 + t0 + seg * 16);
      unsigned pk[16];
#pragma unroll
      for (int s = 0; s < 16; ++s) {
        if (!FINAL) {
          pk[s] = __float_as_uint(a_s[(seg * 16 + s) * 65 + ch]);
          P.au[(tok0 + s) * 512 + c0 + ch] = pk[s];
        } else {
          pk[s] = P.au[(tok0 + s) * 512 + c0 + ch];
        }
      }
      float Ap = 1.f, Hl = 0.f;
#pragma unroll
      for (int s = 0; s < 16; ++s) {
        const float a = 1.f - bflo(pk[s]), u = bfhi(pk[s]);
        Hl = a * Hl + u;
        Ap *= a;
      }
      segA[seg * 64 + ch] = Ap;
      segH[seg * 64 + ch] = Hl;
      __syncthreads();
      if (!FINAL) {
        if (seg == 0) {
          float Aa = 1.f, Hh = 0.f;
#pragma unroll
          for (int s = 0; s < 4; ++s) {
            Hh = segA[s * 64 + ch] * Hh + segH[s * 64 + ch];
            Aa *= segA[s * 64 + ch];
          }
          P.Acar[(b * 32 + tile) * 512 + c0 + ch] = Aa;
          P.Hcar[(b * 32 + tile) * 512 + c0 + ch] = Hh;
        }
      } else {
        float gate[16];
#pragma unroll
        for (int s = 0; s < 16; ++s) gate[s] = bf2f(P.p[(tok0 + s) * 1536 + 512 + c0 + ch]);
        float h = P.Hin[(b * 32 + tile) * 512 + c0 + ch];
#pragma unroll
        for (int s = 0; s < 3; ++s)
          if (s < seg) h = segA[s * 64 + ch] * h + segH[s * 64 + ch];
        float sqv[16];
#pragma unroll
        for (int s = 0; s < 16; ++s) {
          h = (1.f - bflo(pk[s])) * h + bfhi(pk[s]);
          const float yv = h * gelu_(gate[s]);
          sqv[s] = yv * yv;
          P.ycat[(tok0 + s) * 1024 + c0 + ch] = f2bf(yv);
        }
        {
          const bool hb = (lane & 32) != 0, b4 = (lane & 16) != 0, b3 = (lane & 8) != 0, b2 = (lane & 4) != 0;
#pragma unroll
          for (int i = 0; i < 8; ++i) { float sd = hb ? sqv[i] : sqv[i + 8], kp = hb ? sqv[i + 8] : sqv[i]; sqv[i] = kp + __shfl_xor(sd, 32); }
#pragma unroll
          for (int i = 0; i < 4; ++i) { float sd = b4 ? sqv[i] : sqv[i + 4], kp = b4 ? sqv[i + 4] : sqv[i]; sqv[i] = kp + __shfl_xor(sd, 16); }
#pragma unroll
          for (int i = 0; i < 2; ++i) { float sd = b3 ? sqv[i] : sqv[i + 2], kp = b3 ? sqv[i + 2] : sqv[i]; sqv[i] = kp + __shfl_xor(sd, 8); }
          { float sd = b2 ? sqv[0] : sqv[1], kp = b2 ? sqv[1] : sqv[0]; sqv[0] = kp + __shfl_xor(sd, 4); }
          sqv[0] += __shfl_xor(sqv[0], 2);
          sqv[0] += __shfl_xor(sqv[0], 1);
          if ((lane & 3) == 0) atomicAdd(P.ssa + tok0 + (lane >> 2), sqv[0]);
        }
      }
    }
  }
}

__device__ void carry_phase(const Params& P) {
  const int gt = blockIdx.x * 256 + threadIdx.x, nth = gridDim.x * 256;
  for (int i = gt; i < 16384 + 65536; i += nth) {
    if (i < 16384) {
      const int b = i >> 9, ch = i & 511;
      float h = 0.f;
      for (int t0 = 0; t0 < 32; t0 += 8) {
        float a[8], hh[8];
#pragma unroll
        for (int j = 0; j < 8; ++j) {
          a[j] = P.Acar[(b * 32 + t0 + j) * 512 + ch];
          hh[j] = P.Hcar[(b * 32 + t0 + j) * 512 + ch];
        }
#pragma unroll
        for (int j = 0; j < 8; ++j) {
          P.Hin[(b * 32 + t0 + j) * 512 + ch] = h;
          h = a[j] * h + hh[j];
        }
      }
    } else {
      const int k = i - 16384;
      const int pp = k & 63, g = (k >> 6) & 31, b = k >> 11;
      const float ar = P.A16[(g * 64 + pp) * 2], ai = P.A16[(g * 64 + pp) * 2 + 1];
      float hr = 0.f, hi = 0.f;
      for (int c0 = 0; c0 < 128; c0 += 8) {
        float er[8], ei[8];
#pragma unroll
        for (int j = 0; j < 8; ++j) {
          size_t base = ((size_t)(b * 128 + c0 + j) * 32 + g) * 128;
          er[j] = P.E[base + pp];
          ei[j] = P.E[base + 64 + pp];
        }
#pragma unroll
        for (int j = 0; j < 8; ++j) {
          size_t base = ((size_t)(b * 128 + c0 + j) * 32 + g) * 128;
          P.Hs[base + pp] = f2bf(hr);
          P.Hs[base + 64 + pp] = f2bf(hi);
          float nr = ar * hr - ai * hi + er[j], ni = ar * hi + ai * hr + ei[j];
          hr = nr; hi = ni;
        }
      }
    }
  }
}

template <bool YPH>
__device__ void s5_phase(const Params& P) {
  constexpr int MTW = YPH ? 4 : 2;
  const int tid = threadIdx.x, lane = tid & 63, w = tid >> 6;
  const int l15 = lane & 15, lq = lane >> 4;
  for (int item = blockIdx.x; item < 2048; item += gridDim.x) {
    const int g = ((item & 7) << 2) | ((item >> 3) & 3), cb = item >> 5;
    f32x4 acc[MTW][4];
#pragma unroll
    for (int i = 0; i < MTW; ++i)
#pragma unroll
      for (int j = 0; j < 4; ++j) acc[i][j] = (f32x4){0.f, 0.f, 0.f, 0.f};
    const u16* Am = YPH ? (P.MF + (size_t)g * 256 * 384) : (P.G + (size_t)g * 128 * 256);
    constexpr int LD = YPH ? 384 : 256;
    for (int ks = 0; ks < 8; ++ks) {
      bf16x8 bu[4];
#pragma unroll
      for (int nt = 0; nt < 4; ++nt) {
        const int Ncol = cb * 64 + nt * 16 + l15;
        const int b = Ncol >> 7, c = Ncol & 127;
        const int tau = ks * 2 + (lq >> 1), j0 = (lq & 1) * 8;
        bu[nt] = *(const bf16x8*)(P.p + ((size_t)(b * 2048 + c * 16 + tau)) * 1536 + 1024 + g * 16 + j0);
      }
#pragma unroll
      for (int mt = 0; mt < MTW; ++mt) {
        const int m = (w * MTW + mt) * 16 + l15;
        bf16x8 a = *(const bf16x8*)(Am + (size_t)m * LD + ks * 32 + lq * 8);
#pragma unroll
        for (int nt = 0; nt < 4; ++nt) acc[mt][nt] = MFMA16(a, bu[nt], acc[mt][nt]);
      }
    }
    if (YPH) {
      for (int ks = 0; ks < 4; ++ks) {
        bf16x8 bh[4];
#pragma unroll
        for (int nt = 0; nt < 4; ++nt) {
          const int Ncol = cb * 64 + nt * 16 + l15;
          bh[nt] = *(const bf16x8*)(P.Hs + ((size_t)Ncol * 32 + g) * 128 + ks * 32 + lq * 8);
        }
#pragma unroll
        for (int mt = 0; mt < MTW; ++mt) {
          const int m = (w * MTW + mt) * 16 + l15;
          bf16x8 a = *(const bf16x8*)(Am + (size_t)m * LD + 256 + ks * 32 + lq * 8);
#pragma unroll
          for (int nt = 0; nt < 4; ++nt) acc[mt][nt] = MFMA16(a, bh[nt], acc[mt][nt]);
        }
      }
    }
#pragma unroll
    for (int mt = 0; mt < MTW; ++mt)
#pragma unroll
      for (int nt = 0; nt < 4; ++nt) {
        const int Ncol = cb * 64 + nt * 16 + l15;
        f32x4 v = acc[mt][nt];
        if (!YPH) {
          const int m0 = (w * MTW + mt) * 16 + lq * 4;
          *(float4*)(P.E + ((size_t)Ncol * 32 + g) * 128 + m0) = make_float4(v[0], v[1], v[2], v[3]);
        } else {
          const int b = Ncol >> 7, c = Ncol & 127;
          const int tloc = w * MTW + mt;
          const size_t tok = (size_t)(b * 2048 + c * 16 + tloc);
          *(uint2*)(P.gs5 + tok * 512 + g * 16 + lq * 4) =
              make_uint2(pack2(gelu_(v[0]), gelu_(v[1])), pack2(gelu_(v[2]), gelu_(v[3])));
        }
      }
  }
}

__device__ __forceinline__ void top16_of_64(f32x16 (&acc)[4], int half, float (&res)[16]) {
  float g[4][16];
#pragma unroll
  for (int mt = 0; mt < 4; ++mt) {
#pragma unroll
    for (int i = 0; i < 16; ++i) {
      unsigned idx = mt * 32 + (i >> 2) * 8 + (i & 3);
      unsigned bits = (__float_as_uint(acc[mt][i]) & 0xffffff80u) | idx | (unsigned)(half * 4);
      g[mt][i] = __uint_as_float(bits);
    }
    sort16(g[mt]);
  }
  merge_top16(g[0], g[1]);
  merge_top16(g[2], g[3]);
  merge_top16(g[0], g[2]);
  float y[16];
#pragma unroll
  for (int i = 0; i < 16; ++i) y[i] = __shfl_xor(g[0][i], 32);
  merge_top16(g[0], y);
#pragma unroll
  for (int i = 0; i < 16; ++i) res[i] = g[0][i];
}
__host__ __device__ constexpr int cand_off(int i) {
  int s = 0;
  for (int q = 0; q < i; ++q) s += 16 / (q + 1);
  return s;
}

__device__ void cand_phase(const Params& P, char* smem) {
  const int tid = threadIdx.x;
  unsigned char* lut = (unsigned char*)smem + tid * 36;
  for (int gi = blockIdx.x * 256 + tid; gi < T_TOK * 8; gi += gridDim.x * 256) {
    const size_t tok = (size_t)(gi >> 3);
    const int head = gi & 7;
    float a[16], bl[16];
    {
      const float4* src = (const float4*)(P.t16 + (size_t)gi * 32);
#pragma unroll
      for (int i = 0; i < 4; ++i) {
        const float4 t = src[i], u = src[4 + i];
        a[i * 4] = t.x; a[i * 4 + 1] = t.y; a[i * 4 + 2] = t.z; a[i * 4 + 3] = t.w;
        bl[i * 4] = u.x; bl[i * 4 + 1] = u.y; bl[i * 4 + 2] = u.z; bl[i * 4 + 3] = u.w;
      }
    }
    float va[16], vb[16];
#pragma unroll
    for (int i = 0; i < 16; ++i) {
      va[i] = __uint_as_float(__float_as_uint(a[i]) & 0xffffff80u);
      vb[i] = __uint_as_float(__float_as_uint(bl[i]) & 0xffffff80u);
    }
    float cg4[4][16];
#pragma unroll
    for (int i = 0; i < 4; ++i)
#pragma unroll
      for (int j = 0; j < 16; ++j) cg4[i][j] = __uint_as_float(0xff800000u);
#pragma unroll
    for (int i = 0; i < 16; ++i)
#pragma unroll
      for (int j = 0; j < 16; ++j)
        if ((i + 1) * (j + 1) <= 16) {
          const int pos = cand_off(i) + j;
          float sm = va[i] + vb[j];
          cg4[pos >> 4][pos & 15] = __uint_as_float((__float_as_uint(sm) & 0xffffff00u) | (unsigned)(i * 16 + j));
        }
#pragma unroll
    for (int i = 0; i < 4; ++i) sort16(cg4[i]);
    merge_top16(cg4[0], cg4[1]);
    merge_top16(cg4[2], cg4[3]);
    merge_top16(cg4[0], cg4[2]);
    {
      unsigned* lw = (unsigned*)lut;
#pragma unroll
      for (int i = 0; i < 4; ++i) {
        lw[i] = (__float_as_uint(a[i * 4]) & 127u) | ((__float_as_uint(a[i * 4 + 1]) & 127u) << 8) |
                ((__float_as_uint(a[i * 4 + 2]) & 127u) << 16) | ((__float_as_uint(a[i * 4 + 3]) & 127u) << 24);
        lw[4 + i] = (__float_as_uint(bl[i * 4]) & 127u) | ((__float_as_uint(bl[i * 4 + 1]) & 127u) << 8) |
                    ((__float_as_uint(bl[i * 4 + 2]) & 127u) << 16) | ((__float_as_uint(bl[i * 4 + 3]) & 127u) << 24);
      }
    }
    float sc[16];
    int ee[16];
    const float mx = __uint_as_float(__float_as_uint(cg4[0][0]) & 0xffffff00u);
    float ssum = 0.f;
#pragma unroll
    for (int k = 0; k < 16; ++k) {
      unsigned bits = __float_as_uint(cg4[0][k]);
      unsigned code = bits & 255u;
      float v = __uint_as_float(bits & 0xffffff00u);
      sc[k] = __expf(v - mx);
      ssum += sc[k];
      int i1 = lut[code >> 4], i2 = lut[16 + (code & 15u)];
      ee[k] = i1 * 128 + i2;
    }
    const float inv = 1.f / ssum;
    int4* de = (int4*)(P.eidx + tok * 128 + head * 16);
    float4* ds = (float4*)(P.suv + tok * 128 + head * 16);
    float4* dg = (float4*)(P.gw + tok * 128 + head * 16);
#pragma unroll
    for (int i = 0; i < 4; ++i) {
      de[i] = make_int4(ee[i * 4], ee[i * 4 + 1], ee[i * 4 + 2], ee[i * 4 + 3]);
      ds[i] = make_float4(P.su[ee[i * 4]], P.su[ee[i * 4 + 1]], P.su[ee[i * 4 + 2]], P.su[ee[i * 4 + 3]]);
      dg[i] = make_float4(sc[i * 4] * inv * P.sv[ee[i * 4]], sc[i * 4 + 1] * inv * P.sv[ee[i * 4 + 1]],
                          sc[i * 4 + 2] * inv * P.sv[ee[i * 4 + 2]], sc[i * 4 + 3] * inv * P.sv[ee[i * 4 + 3]]);
    }
  }
}

typedef float f2v __attribute__((ext_vector_type(2)));
__device__ __forceinline__ float dot16_fp8(uint4 u, const f2v* x) {
  f2v acc = {0.f, 0.f};
  acc = __builtin_amdgcn_cvt_pk_f32_fp8(u.x, false) * x[0] + acc;
  acc = __builtin_amdgcn_cvt_pk_f32_fp8(u.x, true) * x[1] + acc;
  acc = __builtin_amdgcn_cvt_pk_f32_fp8(u.y, false) * x[2] + acc;
  acc = __builtin_amdgcn_cvt_pk_f32_fp8(u.y, true) * x[3] + acc;
  acc = __builtin_amdgcn_cvt_pk_f32_fp8(u.z, false) * x[4] + acc;
  acc = __builtin_amdgcn_cvt_pk_f32_fp8(u.z, true) * x[5] + acc;
  acc = __builtin_amdgcn_cvt_pk_f32_fp8(u.w, false) * x[6] + acc;
  acc = __builtin_amdgcn_cvt_pk_f32_fp8(u.w, true) * x[7] + acc;
  return acc.x + acc.y;
}
__device__ __forceinline__ void axpy16_fp8(f2v* o, float wgt, uint4 v) {
  const f2v ww = {wgt, wgt};
  o[0] = __builtin_amdgcn_cvt_pk_f32_fp8(v.x, false) * ww + o[0];
  o[1] = __builtin_amdgcn_cvt_pk_f32_fp8(v.x, true) * ww + o[1];
  o[2] = __builtin_amdgcn_cvt_pk_f32_fp8(v.y, false) * ww + o[2];
  o[3] = __builtin_amdgcn_cvt_pk_f32_fp8(v.y, true) * ww + o[3];
  o[4] = __builtin_amdgcn_cvt_pk_f32_fp8(v.z, false) * ww + o[4];
  o[5] = __builtin_amdgcn_cvt_pk_f32_fp8(v.z, true) * ww + o[5];
  o[6] = __builtin_amdgcn_cvt_pk_f32_fp8(v.w, false) * ww + o[6];
  o[7] = __builtin_amdgcn_cvt_pk_f32_fp8(v.w, true) * ww + o[7];
}

__device__ void peer_phase(const Params& P) {
  const int lane = threadIdx.x & 63;
  const int w = __builtin_amdgcn_readfirstlane(threadIdx.x >> 6);
  const int gwv = blockIdx.x * 4 + w, nw = gridDim.x * 4;
  const bool hb = (lane & 32) != 0, b4 = (lane & 16) != 0, b3 = (lane & 8) != 0;
  float4 g2v[4];
#pragma unroll
  for (int c = 0; c < 4; ++c) g2v[c] = *(const float4*)(P.norm2_g + lane * 16 + c * 4);
  float4 hn[4];
  if (gwv < T_TOK) {
#pragma unroll
    for (int c = 0; c < 4; ++c) hn[c] = *(const float4*)(P.out + (size_t)gwv * 1024 + lane * 16 + c * 4);
  }
  for (int tok = gwv; tok < T_TOK; tok += nw) {
    float4 hc[4];
#pragma unroll
    for (int c = 0; c < 4; ++c) hc[c] = hn[c];
    {
      const int ntok = (tok + nw < T_TOK) ? tok + nw : tok;
#pragma unroll
      for (int c = 0; c < 4; ++c) hn[c] = *(const float4*)(P.out + (size_t)ntok * 1024 + lane * 16 + c * 4);
    }
    const int* ep = P.eidx + (size_t)tok * 128;
    const float* gp = P.gw + (size_t)tok * 128;
    const float* sp = P.suv + (size_t)tok * 128;
    uint4 uA[8], uB[8];
    float suA, gA, suB, gB;
    int elA, elB;
#define LOADU(U, SU, G, EL, kb) { _Pragma("unroll") for (int j = 0; j < 8; ++j) { const int e = ep[(kb) + j]; \
        U[j] = *(const uint4*)(P.U8 + (size_t)e * 1024 + lane * 16); } \
      SU = sp[(kb) + (lane >> 3)]; G = gp[(kb) + (lane >> 3)]; EL = ep[(kb) + (lane >> 3)]; }
    LOADU(uA, suA, gA, elA, 0)
    __builtin_amdgcn_sched_barrier(0);
    float ss = 0.f;
#pragma unroll
    for (int c = 0; c < 4; ++c) ss += hc[c].x * hc[c].x + hc[c].y * hc[c].y + hc[c].z * hc[c].z + hc[c].w * hc[c].w;
    ss = wsum(ss);
    const float rstd2 = rsqrtf(ss * (1.f / 1024.f) + EPSF);
    f2v xn[8];
#pragma unroll
    for (int c = 0; c < 4; ++c) {
      xn[c * 2 + 0] = (f2v){hc[c].x * rstd2 * g2v[c].x, hc[c].y * rstd2 * g2v[c].y};
      xn[c * 2 + 1] = (f2v){hc[c].z * rstd2 * g2v[c].z, hc[c].w * rstd2 * g2v[c].w};
    }
#define PROCU(U, SU, G, EL, kb) { float d[8]; \
      _Pragma("unroll") for (int j = 0; j < 8; ++j) d[j] = dot16_fp8(U[j], xn); \
      _Pragma("unroll") for (int i = 0; i < 4; ++i) { float send = hb ? d[i] : d[i + 4], keep = hb ? d[i + 4] : d[i]; d[i] = keep + __shfl_xor(send, 32); } \
      _Pragma("unroll") for (int i = 0; i < 2; ++i) { float send = b4 ? d[i] : d[i + 2], keep = b4 ? d[i + 2] : d[i]; d[i] = keep + __shfl_xor(send, 16); } \
      { float send = b3 ? d[0] : d[1], keep = b3 ? d[1] : d[0]; d[0] = keep + __shfl_xor(send, 8); } \
      d[0] += __shfl_xor(d[0], 4); d[0] += __shfl_xor(d[0], 2); d[0] += __shfl_xor(d[0], 1); \
      const float act = gelu_(d[0] * SU) * G; \
      if ((lane & 7) == 0) ((unsigned*)P.wact)[(size_t)tok * 128 + (kb) + (lane >> 3)] = ((unsigned)f2bf(act) << 16) | (unsigned)EL; }
    for (int k0 = 0; k0 < 128; k0 += 16) {
      LOADU(uB, suB, gB, elB, k0 + 8)
      __builtin_amdgcn_sched_barrier(0);
      PROCU(uA, suA, gA, elA, k0)
      { const int kn = (k0 + 16 < 128) ? k0 + 16 : 112; LOADU(uA, suA, gA, elA, kn) }
      __builtin_amdgcn_sched_barrier(0);
      PROCU(uB, suB, gB, elB, k0 + 8)
    }
  }
}

__device__ void udot_phase(const Params& P) {
  const int my_xcc = (int)((unsigned)__builtin_amdgcn_s_getreg((3 << 11) | 20) & 7u), my_rank = P.rank[blockIdx.x];
  const int lane = threadIdx.x & 63, w = threadIdx.x >> 6;
  const int r = lane >> 3, c = lane & 7;
  const bool b2 = (lane & 4) != 0, b1 = (lane & 2) != 0, b0 = (lane & 1) != 0;
  int cen_ok = 1, cen_sum = 0, cen_mine = 0;
#pragma unroll
  for (int x = 0; x < 8; ++x) {
    const int cx = (int)__hip_atomic_load(P.bar + 15 * 512 + x * 32, __ATOMIC_RELAXED, __HIP_MEMORY_SCOPE_AGENT);
    cen_ok &= (cx > 0); cen_sum += cx; if (x == my_xcc) cen_mine = cx;
  }
  const bool fast = cen_ok && cen_sum == (int)gridDim.x;
  const int nwt = fast ? cen_mine * 4 : (int)gridDim.x * 4;
  const int wv = fast ? my_rank * 4 + w : (int)blockIdx.x * 4 + w;
  const int total = fast ? T_TOK : T_TOK * 8;
  const int cnt = (wv < total) ? (total - wv + nwt - 1) / nwt : 0;
  if (cnt == 0) return;
  const int slf = my_xcc;
#define UTOK(n, SL, TK) { int it_ = wv + ((n) < cnt ? (n) : cnt - 1) * nwt; SL = fast ? slf : (it_ & 7); TK = fast ? it_ : (it_ >> 3); }
#define ULOADE(E, n) { int sl_, tk_; UTOK(n, sl_, tk_) (void)sl_; const uint4* ep_ = (const uint4*)(P.eidx + (size_t)tk_ * 128 + r * 16); \
      _Pragma("unroll") for (int i = 0; i < 4; ++i) E[i] = ep_[i]; }
#define UGATHER(V, E, n) { int sl_, tk_; UTOK(n, sl_, tk_) (void)tk_; const unsigned char* ub_ = P.U8 + (size_t)sl_ * (16384 * 128) + c * 16; \
      _Pragma("unroll") for (int i = 0; i < 4; ++i) { \
        V[i * 4 + 0] = *(const uint4*)(ub_ + (size_t)E[i].x * 128); V[i * 4 + 1] = *(const uint4*)(ub_ + (size_t)E[i].y * 128); \
        V[i * 4 + 2] = *(const uint4*)(ub_ + (size_t)E[i].z * 128); V[i * 4 + 3] = *(const uint4*)(ub_ + (size_t)E[i].w * 128); } }
#define UHLOAD(H, S2, n) { int sl_, tk_; UTOK(n, sl_, tk_) const float* hp_ = P.out + (size_t)tk_ * 1024 + sl_ * 128 + c * 16; \
      _Pragma("unroll") for (int i = 0; i < 4; ++i) H[i] = *(const float4*)(hp_ + i * 4); (void)S2; }
#define UPROC(V, H, S2, n) { int sl_, tk_; UTOK(n, sl_, tk_) \
      f2v xn_[8]; \
      _Pragma("unroll") for (int i = 0; i < 4; ++i) { xn_[i * 2] = (f2v){H[i].x, H[i].y}; xn_[i * 2 + 1] = (f2v){H[i].z, H[i].w}; } \
      float d[16]; _Pragma("unroll") for (int i = 0; i < 16; ++i) d[i] = dot16_fp8(V[i], xn_); \
      _Pragma("unroll") for (int i = 0; i < 8; ++i) { float sd = b2 ? d[i] : d[i + 8], kp = b2 ? d[i + 8] : d[i]; d[i] = kp + __shfl_xor(sd, 4); } \
      _Pragma("unroll") for (int i = 0; i < 4; ++i) { float sd = b1 ? d[i] : d[i + 4], kp = b1 ? d[i + 4] : d[i]; d[i] = kp + __shfl_xor(sd, 2); } \
      _Pragma("unroll") for (int i = 0; i < 2; ++i) { float sd = b0 ? d[i] : d[i + 2], kp = b0 ? d[i + 2] : d[i]; d[i] = kp + __shfl_xor(sd, 1); } \
      nt_st_f2(make_float2(d[0], d[1]), P.part + ((size_t)sl_ * T_TOK + tk_) * 128 + lane * 2); }
  uint4 eA[4], eB[4];
  uint4 vA[16], vB[16];
  ULOADE(eA, 0)
  ULOADE(eB, 1)
  UGATHER(vA, eA, 0)
  __builtin_amdgcn_sched_barrier(0);
  for (int n = 0; n < cnt; n += 2) {
    { float4 h_[4]; float s2_ = 0.f; UHLOAD(h_, s2_, n) UGATHER(vB, eB, n + 1) ULOADE(eA, n + 2)
      __builtin_amdgcn_sched_barrier(0); UPROC(vA, h_, s2_, n) }
    if (n + 1 < cnt) {
      float4 h_[4]; float s2_ = 0.f; UHLOAD(h_, s2_, n + 1) UGATHER(vA, eA, n + 2) ULOADE(eB, n + 3)
      __builtin_amdgcn_sched_barrier(0); UPROC(vB, h_, s2_, n + 1)
    }
  }
}

__device__ void ucomb_phase(const Params& P) {
  const size_t gt = (size_t)blockIdx.x * 256 + threadIdx.x, nt = (size_t)gridDim.x * 256;
  for (size_t i = gt; i < (size_t)T_TOK * 32; i += nt) {
    float4 a = ((const float4*)P.part)[i];
#pragma unroll
    for (int sl = 1; sl < 8; ++sl) {
      const float4 b = ((const float4*)P.part)[(size_t)sl * T_TOK * 32 + i];
      a.x += b.x; a.y += b.y; a.z += b.z; a.w += b.w;
    }
    float4 su = ((const float4*)P.suv)[i]; const float4 g = ((const float4*)P.gw)[i];
    { const float r2 = rsqrtf(P.ss2[i >> 5] * (1.f / 1024.f) + EPSF); su.x *= r2; su.y *= r2; su.z *= r2; su.w *= r2; }
    const int4 e = ((const int4*)P.eidx)[i];
    uint4 o;
    o.x = ((unsigned)f2bf(gelu_(a.x * su.x) * g.x) << 16) | (unsigned)e.x;
    o.y = ((unsigned)f2bf(gelu_(a.y * su.y) * g.y) << 16) | (unsigned)e.y;
    o.z = ((unsigned)f2bf(gelu_(a.z * su.z) * g.z) << 16) | (unsigned)e.z;
    o.w = ((unsigned)f2bf(gelu_(a.w * su.w) * g.w) << 16) | (unsigned)e.w;
    ((uint4*)P.wact)[i] = o;
  }
}

__device__ void vacc_phase(const Params& P) {
  const int my_xcc = (int)((unsigned)__builtin_amdgcn_s_getreg((3 << 11) | 20) & 7u), my_rank = P.rank[blockIdx.x];
  const int lane = threadIdx.x & 63, w = threadIdx.x >> 6;
  const int r = lane >> 3, c = lane & 7;
  const bool hb = (lane & 32) != 0, b4 = (lane & 16) != 0, b3 = (lane & 8) != 0;
  int cen_ok = 1, cen_sum = 0, cen_mine = 0;
#pragma unroll
  for (int x = 0; x < 8; ++x) {
    const int cx = (int)__hip_atomic_load(P.bar + 15 * 512 + x * 32, __ATOMIC_RELAXED, __HIP_MEMORY_SCOPE_AGENT);
    cen_ok &= (cx > 0); cen_sum += cx; if (x == my_xcc) cen_mine = cx;
  }
  const bool fast = cen_ok && cen_sum == (int)gridDim.x;
  const int nwt = fast ? cen_mine * 4 : (int)gridDim.x * 4;
  const int wv = fast ? my_rank * 4 + w : (int)blockIdx.x * 4 + w;
  const int total = fast ? T_TOK : T_TOK * 8;
  const int cnt = (wv < total) ? (total - wv + nwt - 1) / nwt : 0;
  if (cnt == 0) return;
  const int slf = my_xcc;
#define VTOK(n, SL, TK) { int it_ = wv + ((n) < cnt ? (n) : cnt - 1) * nwt; SL = fast ? slf : (it_ & 7); TK = fast ? it_ : (it_ >> 3); }
#define VLOADEW(E, W, n) { int sl_, tk_; VTOK(n, sl_, tk_) (void)sl_; \
      const uint4* ep_ = (const uint4*)(P.wact + (size_t)tk_ * 128 + r * 16); \
      _Pragma("unroll") for (int i = 0; i < 4; ++i) { E[i] = ep_[i]; } }
#define VGATHER(V, E, n) { int sl_, tk_; VTOK(n, sl_, tk_) (void)tk_; const unsigned char* vb_ = P.V8 + (size_t)sl_ * (16384 * 128) + c * 16; \
      _Pragma("unroll") for (int i = 0; i < 4; ++i) { \
        V[i * 4 + 0] = *(const uint4*)(vb_ + (size_t)(E[i].x & 0xffffu) * 128); V[i * 4 + 1] = *(const uint4*)(vb_ + (size_t)(E[i].y & 0xffffu) * 128); \
        V[i * 4 + 2] = *(const uint4*)(vb_ + (size_t)(E[i].z & 0xffffu) * 128); V[i * 4 + 3] = *(const uint4*)(vb_ + (size_t)(E[i].w & 0xffffu) * 128); } }
#define VPROC(V, W, HV, n) { int sl_, tk_; VTOK(n, sl_, tk_) \
      f2v o[8]; _Pragma("unroll") for (int i = 0; i < 8; ++i) o[i] = (f2v){0.f, 0.f}; \
      _Pragma("unroll") for (int i = 0; i < 4; ++i) { axpy16_fp8(o, bfhi(W[i].x), V[i * 4 + 0]); axpy16_fp8(o, bfhi(W[i].y), V[i * 4 + 1]); \
        axpy16_fp8(o, bfhi(W[i].z), V[i * 4 + 2]); axpy16_fp8(o, bfhi(W[i].w), V[i * 4 + 3]); } \
      float f[16]; _Pragma("unroll") for (int i = 0; i < 8; ++i) { f[i * 2] = o[i].x; f[i * 2 + 1] = o[i].y; } \
      _Pragma("unroll") for (int i = 0; i < 8; ++i) { float sd = hb ? f[i] : f[i + 8], kp = hb ? f[i + 8] : f[i]; f[i] = kp + __shfl_xor(sd, 32); } \
      _Pragma("unroll") for (int i = 0; i < 4; ++i) { float sd = b4 ? f[i] : f[i + 4], kp = b4 ? f[i + 4] : f[i]; f[i] = kp + __shfl_xor(sd, 16); } \
      _Pragma("unroll") for (int i = 0; i < 2; ++i) { float sd = b3 ? f[i] : f[i + 2], kp = b3 ? f[i + 2] : f[i]; f[i] = kp + __shfl_xor(sd, 8); } \
      float2* hp_ = (float2*)(P.out + (size_t)tk_ * 1024 + sl_ * 128 + c * 16 + r * 2); \
      float2 hv_ = HV; hv_.x += f[0]; hv_.y += f[1]; nt_st_f2(hv_, hp_); \
      float sq_ = wsum(hv_.x * hv_.x + hv_.y * hv_.y); if (lane == 0) atomicAdd(P.ssf + tk_, sq_); }
#define VHLOAD(HV, n) { int sl_, tk_; VTOK(n, sl_, tk_) HV = *(const float2*)(P.out + (size_t)tk_ * 1024 + sl_ * 128 + c * 16 + r * 2); }
#define IT2(VC, EC, VN, EN, n) { float2 hv0_; VHLOAD(hv0_, n) VGATHER(VN, EN, (n) + 1) VLOADEW(eC, eC, (n) + 2) \
      __builtin_amdgcn_sched_barrier(0); VPROC(VC, EC, hv0_, n) \
      _Pragma("unroll") for (int i = 0; i < 4; ++i) EC[i] = eC[i]; }
  uint4 eA[4], eB[4], eC[4];
  uint4 vA[16], vB[16];
  VLOADEW(eA, eA, 0)
  VLOADEW(eB, eB, 1)
  VGATHER(vA, eA, 0)
  __builtin_amdgcn_sched_barrier(0);
  for (int n = 0; n < cnt; n += 2) {
    IT2(vA, eA, vB, eB, n)
    if (n + 1 < cnt) IT2(vB, eB, vA, eA, n + 1)
  }
}

__device__ void final_phase(const Params& P) {
  const int lane = threadIdx.x & 63, w = threadIdx.x >> 6;
  const int gwv = blockIdx.x * 4 + w, nw = gridDim.x * 4;
  float4 g[4];
#pragma unroll
  for (int c = 0; c < 4; ++c) g[c] = *(const float4*)(P.normf_g + lane * 16 + c * 4);
  for (int tok = gwv; tok < T_TOK; tok += nw) {
    float* hrow = P.out + (size_t)tok * 1024 + lane * 16;
    const float rf = rsqrtf(P.ssf[tok] * (1.f / 1024.f) + EPSF);
#pragma unroll
    for (int c = 0; c < 4; ++c) {
      float4 v = *(const float4*)(hrow + c * 4);
      *(float4*)(hrow + c * 4) = make_float4(v.x * rf * g[c].x, v.y * rf * g[c].y, v.z * rf * g[c].z, v.w * rf * g[c].w);
    }
  }
}

__device__ __forceinline__ void gbar(unsigned* bar, int k) {
  asm volatile("s_waitcnt vmcnt(0)" ::: "memory");
  __syncthreads();
  if (threadIdx.x == 0) {
    unsigned* base = bar + k * 512;
    const unsigned g = blockIdx.x & 7u;
    const unsigned gsz = (gridDim.x - g + 7u) >> 3;
    const unsigned ngroups = gridDim.x < 8u ? gridDim.x : 8u;
    __builtin_amdgcn_fence(__ATOMIC_RELEASE, "agent");
    asm volatile("s_waitcnt vmcnt(0)" ::: "memory");
    const unsigned old = __hip_atomic_fetch_add(base + g * 32, 1u, __ATOMIC_RELAXED, __HIP_MEMORY_SCOPE_AGENT);
    if (old == gsz - 1u) __hip_atomic_fetch_add(base + 256, 1u, __ATOMIC_RELAXED, __HIP_MEMORY_SCOPE_AGENT);
    unsigned spins = 0;
    while (__hip_atomic_load(base + 256, __ATOMIC_RELAXED, __HIP_MEMORY_SCOPE_AGENT) < ngroups && spins < (1u << 22)) {
      __builtin_amdgcn_s_sleep(1);
      ++spins;
    }
    __builtin_amdgcn_fence(__ATOMIC_ACQUIRE, "agent");
    asm volatile("s_waitcnt vmcnt(0)" ::: "memory");
  }
  __syncthreads();
}

#define SMEM_BYTES 74752

template <int PH>
__device__ __forceinline__ void run_phase(const Params& P, char* smem) {
  if (PH == 0) phase_prep(P, smem);
  if (PH == 1) gemm256_phase<EPI_INPROJ>(P, smem, P.xb, P.WinT, T_TOK, 1536, 1024);
  if (PH == 2) { lru_phase<false>(P, smem); s5_phase<false>(P); }
  if (PH == 3) carry_phase(P);
  if (PH == 4) { lru_phase<true>(P, smem); s5_phase<true>(P); }
  if (PH == 5) gemm256_phase<EPI_GLU>(P, smem, P.gs5, P.GluT, T_TOK, 512, 512);
  if (PH == 6) gemm256_phase<EPI_OUT>(P, smem, P.ycat, P.WoutT, T_TOK, 1024, 1024);
  if (PH == 7) gemm256_phase<EPI_Q>(P, smem, P.hb, P.WqT, T_TOK, 2048, 1024);
  if (PH == 8) cand_phase(P, smem);
  if (PH == 9) udot_phase(P);
  if (PH == 10) ucomb_phase(P);
  if (PH == 11) vacc_phase(P);
  if (PH == 12) final_phase(P);
}

template <int LO, int HI>
__global__ void __launch_bounds__(256, 2) mk(Params P) {
  __shared__ __attribute__((aligned(16))) char smem[SMEM_BYTES];
  cg::grid_group grid = cg::this_grid();
#ifndef REPEAT_MASK
#define REPEAT_MASK 0
#endif
#define PHASE(n) if (LO <= n && n <= HI) { if ((REPEAT_MASK >> n) & 1) { run_phase<n>(P, smem); grid.sync(); } run_phase<n>(P, smem); if (n < HI) gbar(P.bar, n); }
  if (threadIdx.x == 0) {
    const unsigned xcc = (unsigned)__builtin_amdgcn_s_getreg((3 << 11) | 20) & 7u;
    const unsigned rk = __hip_atomic_fetch_add(P.bar + 15 * 512 + xcc * 32, 1u, __ATOMIC_RELAXED, __HIP_MEMORY_SCOPE_AGENT);
    P.rank[blockIdx.x] = (int)rk;
  }
  if (P.bar == nullptr) grid.sync();
  PHASE(0) PHASE(1) PHASE(2) PHASE(3) PHASE(4) PHASE(5) PHASE(6) PHASE(7) PHASE(8) PHASE(9) PHASE(10) PHASE(11) PHASE(12)
}

extern "C" void kernel_launch(void* const* d_in, const int* in_sizes, int n_in, void* d_out, int out_size,
                              void* d_ws, size_t ws_size, hipStream_t stream) {
  Params P{};
  const float** pin = (const float**)&P;
  for (int i = 0; i < 30; ++i) pin[i] = (const float*)d_in[i];
  P.out = (float*)d_out;
  char* ws = (char*)d_ws;
  size_t off = 0;
  auto take = [&](size_t bytes) { char* r = ws + off; off += (bytes + 255) & ~(size_t)255; return r; };
  const size_t MB = 1024 * 1024;
  char* RA = take(128 * MB);
  char* RB = take(256 * MB);
  char* RC = take(128 * MB);
  char* RD = take(96 * MB);
  P.xb = (u16*)RA; P.ycat = (u16*)RA;
  P.p = (u16*)RB; P.q = (u16*)RB;
  P.E = (float*)RC; P.Hs = (u16*)(RC + 64 * MB); P.hb = (u16*)RC;
  P.gs5 = (u16*)RD; P.eidx = (int*)RD; P.gw = (float*)(RD + 32 * MB); P.suv = (float*)(RD + 64 * MB);
  P.U8 = (unsigned char*)take(16 * MB); P.V8 = (unsigned char*)take(16 * MB);
  P.su = (float*)take(16384 * 4); P.sv = (float*)take(16384 * 4);
  P.WinT = (u16*)take(1536 * 1024 * 2); P.GluT = (u16*)take(512 * 512 * 2);
  P.WoutT = (u16*)take(1024 * 1024 * 2); P.WqT = (u16*)take(2048 * 1024 * 2);
  P.K1b = (u16*)take(128 * 128 * 2); P.K2b = (u16*)take(128 * 128 * 2);
  P.WaT = (u16*)take(8 * 4096 * 2); P.WxT = (u16*)take(8 * 4096 * 2);
  P.MF = (u16*)take(32 * 256 * 384 * 2); P.G = (u16*)take(32 * 128 * 256 * 2);
  P.spv = (float*)take(512 * 4);
  P.ssf = (float*)take(T_TOK * 4); P.wact = (float*)RA; P.part = (float*)RB; P.t16 = (float*)RB;
  P.ssa = (float*)take(T_TOK * 4); P.ssb = (float*)take(T_TOK * 4); P.ss2 = (float*)take(T_TOK * 4);
  P.rstd1 = (float*)take(T_TOK * 4); P.A16 = (float*)take(32 * 64 * 2 * 4);
  P.Acar = (float*)take(32 * 32 * 512 * 4); P.Hcar = (float*)take(32 * 32 * 512 * 4); P.Hin = (float*)take(32 * 32 * 512 * 4);

  P.bar = (unsigned*)take(16 * 2048);
  P.au = (unsigned*)take((size_t)T_TOK * 512 * 4);
  P.rank = (int*)take(4096 * 4);
  static int grid_blocks = 0;
#if ONE_LAUNCH
  (void)hipMemsetAsync(P.bar, 0, 16 * 2048, stream);
  if (!grid_blocks) {
    int dev = 0, cus = 0, per_cu = 0;
    (void)hipGetDevice(&dev);
    (void)hipDeviceGetAttribute(&cus, hipDeviceAttributeMultiprocessorCount, dev);
    (void)hipOccupancyMaxActiveBlocksPerMultiprocessor(&per_cu, mk<0, NPHASE - 1>, 256, 0);
    if (per_cu > 2) per_cu = 2;
    if (per_cu < 1) per_cu = 1;
    grid_blocks = cus * per_cu;
  }
  void* args[] = {&P};
  hipError_t e = hipLaunchCooperativeKernel((void*)mk<0, NPHASE - 1>, dim3(grid_blocks), dim3(256), args, 0, stream);
  if (e != hipSuccess) fprintf(stderr, "cooperative launch failed: %s (grid %d)\n", hipGetErrorString(e), grid_blocks);
#else
  if (!grid_blocks) {
    int dev = 0, cus = 0;
    (void)hipGetDevice(&dev);
    (void)hipDeviceGetAttribute(&cus, hipDeviceAttributeMultiprocessorCount, dev);
    grid_blocks = cus * 2;
  }
  mk<0, 0><<<grid_blocks, 256, 0, stream>>>(P);
  mk<1, 1><<<grid_blocks, 256, 0, stream>>>(P);
  mk<2, 2><<<grid_blocks, 256, 0, stream>>>(P);
  mk<3, 3><<<grid_blocks, 256, 0, stream>>>(P);
  mk<4, 4><<<grid_blocks, 256, 0, stream>>>(P);
  mk<5, 5><<<grid_blocks, 256, 0, stream>>>(P);
  mk<6, 6><<<grid_blocks, 256, 0, stream>>>(P);
  mk<7, 7><<<grid_blocks, 256, 0, stream>>>(P);
  mk<8, 8><<<grid_blocks, 256, 0, stream>>>(P);
  mk<9, 9><<<grid_blocks, 256, 0, stream>>>(P);
#endif
}
```

```cpp
#include <hip/hip_runtime.h>
#include <hip/hip_cooperative_groups.h>
#include <cstdio>
namespace cg = cooperative_groups;

typedef unsigned short u16;
using bf16x8 = __attribute__((ext_vector_type(8))) short;
using f32x4 = __attribute__((ext_vector_type(4))) float;
using f32x16 = __attribute__((ext_vector_type(16))) float;

#ifndef ONE_LAUNCH
#define ONE_LAUNCH 1
#endif

#define T_TOK 65536
#define EPSF 1e-6f
#define NPHASE 13

struct Params {
  const float *x, *norm1_g, *w_in, *conv_w, *conv_b, *lru_wa, *lru_ba, *lru_wx, *lru_bx, *lru_lambda;
  const float *s5_lre, *s5_lim, *s5_logdt, *s5_bre, *s5_bim, *s5_cre, *s5_cim, *s5_d, *glu_w, *glu_b;
  const float *gnorm_lru, *gnorm_s5, *w_out, *norm2_g, *wq, *k1, *k2, *pu, *pv, *normf_g;
  float* out;
  u16 *xb, *WinT, *GluT, *WoutT, *WqT, *K1b, *K2b, *Ub, *Vb, *WaT, *WxT, *MF, *G, *p, *Hs, *ycat, *gs5, *hb, *q;
  float *rstd1, *A16, *Acar, *Hcar, *Hin, *E, *gw, *suv, *su, *sv, *ssa, *ssb, *ss2, *ssf, *wact, *part, *spv, *t16;
  int* eidx;
  unsigned char *U8, *V8;
  unsigned* bar;
  unsigned* au;
  int* rank;
};

__device__ __forceinline__ u16 f2bf(float f) {
  unsigned u = __float_as_uint(f);
  u += 0x7fffu + ((u >> 16) & 1u);
  return (u16)(u >> 16);
}
__device__ __forceinline__ float bf2f(u16 h) { return __uint_as_float(((unsigned)h) << 16); }
__device__ __forceinline__ unsigned pack2(float a, float b) { return (unsigned)f2bf(a) | (((unsigned)f2bf(b)) << 16); }
__device__ __forceinline__ float bflo(unsigned u) { return __uint_as_float(u << 16); }
__device__ __forceinline__ float bfhi(unsigned u) { return __uint_as_float(u & 0xffff0000u); }
__device__ __forceinline__ float sigmoid_(float x) { return __builtin_amdgcn_rcpf(1.f + __expf(-x)); }
__device__ __forceinline__ float gelu_(float x) {
  float z = 0.7978845608028654f * (x + 0.044715f * x * x * x);
  return x * __builtin_amdgcn_rcpf(1.f + __expf(-2.f * z));
}
__device__ __forceinline__ float wsum(float v) {
#pragma unroll
  for (int o = 32; o; o >>= 1) v += __shfl_xor(v, o);
  return v;
}
__device__ __forceinline__ float sq8(uint4 v) {
  float s = 0.f, t;
  t = bflo(v.x); s += t * t; t = bfhi(v.x); s += t * t;
  t = bflo(v.y); s += t * t; t = bfhi(v.y); s += t * t;
  t = bflo(v.z); s += t * t; t = bfhi(v.z); s += t * t;
  t = bflo(v.w); s += t * t; t = bfhi(v.w); s += t * t;
  return s;
}
typedef unsigned u32x4e __attribute__((ext_vector_type(4)));
typedef float f32x2e __attribute__((ext_vector_type(2)));
__device__ __forceinline__ uint4 nt_ld_u4(const void* p) { u32x4e v = __builtin_nontemporal_load((const u32x4e*)p); return make_uint4(v.x, v.y, v.z, v.w); }
__device__ __forceinline__ float4 nt_ld_f4(const void* p) { f32x4 v = __builtin_nontemporal_load((const f32x4*)p); return make_float4(v.x, v.y, v.z, v.w); }
__device__ __forceinline__ float2 nt_ld_f2(const void* p) { f32x2e v = __builtin_nontemporal_load((const f32x2e*)p); return make_float2(v.x, v.y); }
__device__ __forceinline__ void nt_st_f2(float2 v, void* p) { f32x2e t = {v.x, v.y}; __builtin_nontemporal_store(t, (f32x2e*)p); }
#define MFMA16(a, b, c) __builtin_amdgcn_mfma_f32_16x16x32_bf16(a, b, c, 0, 0, 0)
#define MFMA32(a, b, c) __builtin_amdgcn_mfma_f32_32x32x16_bf16(a, b, c, 0, 0, 0)

__device__ void transpose_fold(const float* src, const float* g, u16* dst, int ldd, int K, int N, char* smem) {
  float* tl = (float*)smem;
  const int tid = threadIdx.x;
  const int tk = K / 64, tn = N / 64;
  for (int t = blockIdx.x; t < tk * tn; t += gridDim.x) {
    int k0 = (t / tn) * 64, n0 = (t % tn) * 64;
    __syncthreads();
    for (int i = 0; i < 16; ++i) {
      int k = (tid >> 6) + i * 4, n = tid & 63;
      float v = src[(size_t)(k0 + k) * N + n0 + n];
      if (g) v *= g[k0 + k];
      tl[k * 65 + n] = v;
    }
    __syncthreads();
    for (int i = 0; i < 16; ++i) {
      int n = (tid >> 6) + i * 4, k = tid & 63;
      dst[(size_t)(n0 + n) * ldd + k0 + k] = f2bf(tl[k * 65 + n]);
    }
  }
}

__device__ void s5_prep(const Params& P, char* smem, int g) {
  float* apw = (float*)smem;
  float* bb = apw + 17 * 64 * 2;
  float* kk = bb + 64 * 16 * 2;
  const int tid = threadIdx.x;
  __syncthreads();
  if (tid < 64) {
    int pp = tid;
    float lr = P.s5_lre[g * 64 + pp], li = P.s5_lim[g * 64 + pp];
    float dt = expf(P.s5_logdt[g]);
    float mag = expf(lr * dt);
    double ang = (double)li * (double)dt;
    double kq = rint(ang * 0.15915494309189535);
    float r = (float)(ang - kq * 6.283185307179586);
    float sn = __sinf(r), cs = __cosf(r);
    {
      sn = sinf(r); cs = cosf(r);
    }
    float are = mag * cs, aim = mag * sn;
    float den = lr * lr + li * li;
    float nre = are - 1.f, nim = aim;
    float zre = (nre * lr + nim * li) / den, zim = (nim * lr - nre * li) / den;
    float pr = 1.f, pi = 0.f;
    for (int d = 0; d <= 16; ++d) {
      apw[(d * 64 + pp) * 2] = pr; apw[(d * 64 + pp) * 2 + 1] = pi;
      float nr = pr * are - pi * aim, ni = pr * aim + pi * are;
      pr = nr; pi = ni;
    }
    P.A16[(g * 64 + pp) * 2] = apw[(16 * 64 + pp) * 2];
    P.A16[(g * 64 + pp) * 2 + 1] = apw[(16 * 64 + pp) * 2 + 1];
    for (int j = 0; j < 16; ++j) {
      float br = P.s5_bre[(g * 64 + pp) * 16 + j], bi = P.s5_bim[(g * 64 + pp) * 16 + j];
      bb[(pp * 16 + j) * 2] = zre * br - zim * bi;
      bb[(pp * 16 + j) * 2 + 1] = zre * bi + zim * br;
    }
  }
  __syncthreads();
  for (int rr = 0; rr < 16; ++rr) {
    int e = tid + rr * 256;
    int d = e >> 8, i = (e >> 4) & 15, j = e & 15;
    float s = 0.f;
    for (int pp = 0; pp < 64; ++pp) {
      float cr = P.s5_cre[(g * 16 + i) * 64 + pp], ci = P.s5_cim[(g * 16 + i) * 64 + pp];
      float ar = apw[(d * 64 + pp) * 2], ai = apw[(d * 64 + pp) * 2 + 1];
      float xr = cr * ar - ci * ai, xi = cr * ai + ci * ar;
      s += xr * bb[(pp * 16 + j) * 2] - xi * bb[(pp * 16 + j) * 2 + 1];
    }
    kk[e] = s;
  }
  __syncthreads();
  u16* MFg = P.MF + (size_t)g * 256 * 384;
  for (int it = 0; it < 192; ++it) {
    int e = tid + it * 256;
    int m = e / 192, cp = (e % 192) * 2;
    int t = m >> 4, i = m & 15;
    float v[2];
    for (int q = 0; q < 2; ++q) {
      int col = cp + q;
      float val;
      if (col < 256) {
        int sg = col >> 4, j = col & 15;
        val = (sg <= t) ? kk[((t - sg) * 16 + i) * 16 + j] : 0.f;
        if (sg == t && i == j) val += P.s5_d[g * 16 + i];
      } else {
        int pc = col - 256, pp = pc & 63, im = pc >> 6;
        float cr = P.s5_cre[(g * 16 + i) * 64 + pp], ci = P.s5_cim[(g * 16 + i) * 64 + pp];
        float ar = apw[((t + 1) * 64 + pp) * 2], ai = apw[((t + 1) * 64 + pp) * 2 + 1];
        float xr = cr * ar - ci * ai, xi = cr * ai + ci * ar;
        val = im ? -xi : xr;
      }
      v[q] = val;
    }
    *(unsigned*)(MFg + (size_t)m * 384 + cp) = pack2(v[0], v[1]);
  }
  u16* Gg = P.G + (size_t)g * 128 * 256;
  for (int it = 0; it < 64; ++it) {
    int e = tid + it * 256;
    int row = e >> 7, cp = (e & 127) * 2;
    int im = row >> 6, pp = row & 63;
    float v[2];
    for (int q = 0; q < 2; ++q) {
      int col = cp + q, sg = col >> 4, j = col & 15;
      float ar = apw[((15 - sg) * 64 + pp) * 2], ai = apw[((15 - sg) * 64 + pp) * 2 + 1];
      float br = bb[(pp * 16 + j) * 2], bi = bb[(pp * 16 + j) * 2 + 1];
      v[q] = im ? (ar * bi + ai * br) : (ar * br - ai * bi);
    }
    *(unsigned*)(Gg + (size_t)row * 256 + cp) = pack2(v[0], v[1]);
  }
}

__device__ void wqk_prep(const Params& P, char* smem) {
  float* Wt = (float*)smem;
  float* Kt = Wt + 64 * 129;
  const int tid = threadIdx.x;
  for (int item = blockIdx.x; item < 512; item += gridDim.x) {
    const int hs = item >> 5, kb = (item >> 1) & 15, kh = item & 1;
    const int cbase = (hs >> 1) * 256 + (hs & 1) * 128, k0 = kb * 64;
    __syncthreads();
    for (int i = 0; i < 32; ++i) {
      const int idx = tid + i * 256, row = idx >> 7, col = idx & 127;
      Wt[row * 129 + col] = P.wq[(size_t)(k0 + row) * 2048 + cbase + col] * P.norm2_g[k0 + row];
      const int ko = kh * 64 * 128 + idx;
      Kt[idx] = (hs & 1) ? P.k2[ko] : P.k1[ko];
    }
    __syncthreads();
    const int kk = tid & 63, q = tid >> 6;
    float acc[16];
#pragma unroll
    for (int i = 0; i < 16; ++i) acc[i] = 0.f;
    for (int d = 0; d < 128; d += 4) {
      const float w0 = Wt[kk * 129 + d], w1 = Wt[kk * 129 + d + 1], w2 = Wt[kk * 129 + d + 2], w3 = Wt[kk * 129 + d + 3];
#pragma unroll
      for (int i = 0; i < 16; ++i) {
        const float4 kv = *(const float4*)(Kt + (q * 16 + i) * 128 + d);
        acc[i] += w0 * kv.x + w1 * kv.y + w2 * kv.z + w3 * kv.w;
      }
    }
#pragma unroll
    for (int i = 0; i < 16; ++i) P.WqT[(size_t)(hs * 128 + kh * 64 + q * 16 + i) * 1024 + k0 + kk] = f2bf(acc[i]);
  }
}

__device__ void phase_prep(const Params& P, char* smem) {
  const int tid = threadIdx.x, lane = tid & 63, w = tid >> 6;
  {
    int g = (int)gridDim.x - 1 - (int)blockIdx.x;
    if (g < 32) s5_prep(P, smem, g);
  }
  for (int i = blockIdx.x * 256 + tid; i < 512; i += gridDim.x * 256) { const float lam = P.lru_lambda[i]; P.spv[i] = fmaxf(-lam, 0.f) + log1pf(expf(-fabsf(lam))); }
  for (int i = blockIdx.x * 256 + tid; i < T_TOK; i += gridDim.x * 256) { P.ssa[i] = 0.f; P.ssb[i] = 0.f; P.ss2[i] = 0.f; P.ssf[i] = 0.f; }
  const bool split = gridDim.x > 64;
  const bool bulk = !split || (int)blockIdx.x < (int)gridDim.x - 32;
  const int nbulk = split ? (int)gridDim.x - 32 : (int)gridDim.x;
  if (bulk) {
    const int gwv = blockIdx.x * 4 + w, nw = nbulk * 4;
    for (int r = gwv; r < T_TOK; r += nw) {
      const float4* src = (const float4*)(P.x + (size_t)r * 1024);
      float4 v[4];
      float ss = 0.f;
#pragma unroll
      for (int i = 0; i < 4; ++i) {
        v[i] = src[i * 64 + lane];
        ss += v[i].x * v[i].x + v[i].y * v[i].y + v[i].z * v[i].z + v[i].w * v[i].w;
      }
      ss = wsum(ss);
      if (lane == 0) P.rstd1[r] = rsqrtf(ss * (1.f / 1024.f) + EPSF);
      uint2* dst = (uint2*)(P.xb + (size_t)r * 1024);
#pragma unroll
      for (int i = 0; i < 4; ++i) dst[i * 64 + lane] = make_uint2(pack2(v[i].x, v[i].y), pack2(v[i].z, v[i].w));
    }
  }
  {
    const int gwv = blockIdx.x * 4 + w, nw = nbulk * 4;
    if (bulk)
    for (int r = gwv; r < 32768; r += nw) {
      const int isv = r >> 14, e = r & 16383;
      const float* src = (isv ? P.pv : P.pu) + (size_t)e * 1024 + lane * 16;
      float4 v[4];
      float m = 0.f;
#pragma unroll
      for (int i = 0; i < 4; ++i) {
        {
          float4 t = *(const float4*)(src + i * 4);
          const float4 g2 = *(const float4*)(P.norm2_g + lane * 16 + i * 4);
          v[i] = isv ? t : make_float4(t.x * g2.x, t.y * g2.y, t.z * g2.z, t.w * g2.w);
        }
        m = fmaxf(m, fmaxf(fmaxf(fabsf(v[i].x), fabsf(v[i].y)), fmaxf(fabsf(v[i].z), fabsf(v[i].w))));
      }
#pragma unroll
      for (int o = 32; o; o >>= 1) m = fmaxf(m, __shfl_xor(m, o));
      int ex = (int)((__float_as_uint(m) >> 23) & 255u) - 127;
      ex = ex < -100 ? -100 : (ex > 100 ? 100 : ex);
      const float sc = __uint_as_float((unsigned)(127 + 7 - ex) << 23);
      const float isc = __uint_as_float((unsigned)(127 - 7 + ex) << 23);
      unsigned pk[4];
#pragma unroll
      for (int i = 0; i < 4; ++i) {
        int t = __builtin_amdgcn_cvt_pk_fp8_f32(v[i].x * sc, v[i].y * sc, 0, false);
        t = __builtin_amdgcn_cvt_pk_fp8_f32(v[i].z * sc, v[i].w * sc, t, true);
        pk[i] = (unsigned)t;
      }
      unsigned char* dst = isv ? (P.V8 + (size_t)(lane >> 3) * (16384 * 128) + (size_t)e * 128 + (lane & 7) * 16)
                               : (P.U8 + (size_t)(lane >> 3) * (16384 * 128) + (size_t)e * 128 + (lane & 7) * 16);
      *(uint4*)dst = make_uint4(pk[0], pk[1], pk[2], pk[3]);
      if (lane == 0) { if (isv) P.sv[e] = isc; else P.su[e] = isc; }
    }
    size_t gt = (size_t)blockIdx.x * 256 + tid, nt = (size_t)gridDim.x * 256;
    for (size_t i = gt; i < 4096; i += nt) {
      float4 a = ((const float4*)P.k1)[i];
      ((uint2*)P.K1b)[i] = make_uint2(pack2(a.x, a.y), pack2(a.z, a.w));
      float4 b = ((const float4*)P.k2)[i];
      ((uint2*)P.K2b)[i] = make_uint2(pack2(b.x, b.y), pack2(b.z, b.w));
    }
  }
  transpose_fold(P.w_in, P.norm1_g, P.WinT, 1024, 1024, 1536, smem);
  transpose_fold(P.glu_w, nullptr, P.GluT, 512, 512, 512, smem);
  transpose_fold(P.w_out, P.gnorm_lru, P.WoutT, 1024, 512, 1024, smem);
  transpose_fold(P.w_out + 512 * 1024, P.gnorm_s5, P.WoutT + 512, 1024, 512, 1024, smem);
  wqk_prep(P, smem);
  for (int h = 0; h < 8; ++h) {
    transpose_fold(P.lru_wa + h * 4096, nullptr, P.WaT + h * 4096, 64, 64, 64, smem);
    transpose_fold(P.lru_wx + h * 4096, nullptr, P.WxT + h * 4096, 64, 64, 64, smem);
  }
}

__device__ __forceinline__ void ce(float& hi, float& lo) {
  float a = hi, b = lo;
  asm("v_max_f32 %0, %1, %2" : "=v"(hi) : "v"(a), "v"(b));
  asm("v_min_f32 %0, %1, %2" : "=v"(lo) : "v"(a), "v"(b));
}
__device__ __forceinline__ float vmaxf(float a, float b) {
  float r;
  asm("v_max_f32 %0, %1, %2" : "=v"(r) : "v"(a), "v"(b));
  return r;
}
__device__ __forceinline__ void sort16(float (&v)[16]) {
#pragma unroll
  for (int k = 2; k <= 16; k <<= 1)
#pragma unroll
    for (int j = k >> 1; j > 0; j >>= 1)
#pragma unroll
      for (int i = 0; i < 16; ++i) {
        int l = i ^ j;
        if (l > i) {
          if ((i & k) == 0) ce(v[i], v[l]); else ce(v[l], v[i]);
        }
      }
}
__device__ __forceinline__ void bmerge16(float (&v)[16]) {
#pragma unroll
  for (int j = 8; j > 0; j >>= 1)
#pragma unroll
    for (int i = 0; i < 16; ++i) {
      int l = i ^ j;
      if (l > i) ce(v[i], v[l]);
    }
}
__device__ __forceinline__ void merge_top16(float (&x)[16], const float (&y)[16]) {
#pragma unroll
  for (int i = 0; i < 16; ++i) x[i] = vmaxf(x[i], y[15 - i]);
  bmerge16(x);
}

enum { EPI_INPROJ = 0, EPI_GLU = 1, EPI_OUT = 2, EPI_Q = 3 };
#define LDT 64

template <int EPI>
__device__ void gemm_phase(const Params& P, char* smem, const u16* __restrict__ A, const u16* __restrict__ Bt,
                           int M, int N, int K) {
  constexpr int TE = 128 * LDT;
  u16* AsB = (u16*)smem;
  u16* BsB = AsB + 2 * TE;
  const int tid = threadIdx.x, lane = tid & 63, w = tid >> 6, wm = w >> 1, wn = w & 1;
  const int l15 = lane & 15, lq = lane >> 4;
  const int NT = N / 128, MT = M / 128, ntiles = MT * NT, nk = K / 64;
  int vb = blockIdx.x;
  if ((gridDim.x & 7) == 0) vb = (blockIdx.x & 7) * (gridDim.x >> 3) + (blockIdx.x >> 3);
  const int ldr = tid >> 3, ldc = (tid & 7) * 8;
  const int ldsw = ((tid & 7) ^ ((ldr >> 1) & 7)) * 8;
  const int rsw = (l15 >> 1) & 7;
  const int cnt = (vb < ntiles) ? (ntiles - vb + (int)gridDim.x - 1) / (int)gridDim.x : 0;
  const int total = cnt * nk;
  if (total == 0) return;
  f32x4 acc[4][4];
#pragma unroll
  for (int i = 0; i < 4; ++i)
#pragma unroll
    for (int j = 0; j < 4; ++j) acc[i][j] = (f32x4){0.f, 0.f, 0.f, 0.f};
  uint4 pa0, pa1, pa2, pa3, pb0, pb1, pb2, pb3, qa0, qa1, qa2, qa3, qb0, qb1, qb2, qb3;
  const u16 *Ag, *Bg;
#define STEP_ADDR(st) { int st_ = (st) < total ? (st) : total - 1; int ti_ = st_ / nk, kk_ = st_ - ti_ * nk; \
      int tl_ = vb + ti_ * (int)gridDim.x; int r0_ = (tl_ / NT) * 128, c0_ = (tl_ % NT) * 128; \
      { const int hm_ = (nk >> 1) - 1; kk_ = (kk_ & ~hm_) | ((kk_ + (tl_ % NT) + (tl_ / NT)) & hm_); } \
      Ag = A + (size_t)(r0_ + ldr) * K + ldc + kk_ * 64; Bg = Bt + (size_t)(c0_ + ldr) * K + ldc + kk_ * 64; }
#define GLD2(S, i) { S##a##i = *(const uint4*)(Ag + (size_t)(32 * i) * K); S##b##i = *(const uint4*)(Bg + (size_t)(32 * i) * K); }
#define GLDS(S, st) { STEP_ADDR(st) GLD2(S, 0) GLD2(S, 1) GLD2(S, 2) GLD2(S, 3) }
#define LST2(S, i, buf) { *(uint4*)(AsB + (buf) * TE + (ldr + 32 * i) * LDT + ldsw) = S##a##i; \
                          *(uint4*)(BsB + (buf) * TE + (ldr + 32 * i) * LDT + ldsw) = S##b##i; }
#define LSTS(S, buf) { LST2(S, 0, buf) LST2(S, 1, buf) LST2(S, 2, buf) LST2(S, 3, buf) }
#define COMPUTE(buf) { \
      const u16* As_ = AsB + (buf) * TE; const u16* Bs_ = BsB + (buf) * TE; \
      _Pragma("unroll") for (int ks = 0; ks < 2; ++ks) { \
        bf16x8 af[4], bfr[4]; \
        _Pragma("unroll") for (int mt = 0; mt < 4; ++mt) \
          af[mt] = *(const bf16x8*)(As_ + (wm * 64 + mt * 16 + l15) * LDT + (((ks * 4 + lq) ^ rsw) * 8)); \
        _Pragma("unroll") for (int nt = 0; nt < 4; ++nt) \
          bfr[nt] = *(const bf16x8*)(Bs_ + (wn * 64 + nt * 16 + l15) * LDT + (((ks * 4 + lq) ^ rsw) * 8)); \
        _Pragma("unroll") for (int mt = 0; mt < 4; ++mt) \
          _Pragma("unroll") for (int nt = 0; nt < 4; ++nt) acc[mt][nt] = MFMA16(bfr[nt], af[mt], acc[mt][nt]); \
      } }
#define RESCALE() { if (EPI == EPI_OUT) { \
      _Pragma("unroll") for (int mt = 0; mt < 4; ++mt) { \
        const int row = row0 + wm * 64 + mt * 16 + l15; \
        const float ra_ = rsqrtf(P.ssa[row] * (1.f / 512.f) + EPSF), rb_ = rsqrtf(P.ssb[row] * (1.f / 512.f) + EPSF); \
        const float ratio = ra_ / rb_; \
        _Pragma("unroll") for (int nt = 0; nt < 4; ++nt) acc[mt][nt] *= ratio; } } }
  __syncthreads();
  GLDS(p, 0)
  __builtin_amdgcn_sched_barrier(0);
  GLDS(q, 1)
  __builtin_amdgcn_sched_barrier(0);
  LSTS(p, 0)
  GLDS(p, 2)
  __builtin_amdgcn_sched_barrier(0);
  for (int st = 0; st < total; st += 2) {
    const int ti = st / nk, kt = st - ti * nk;
    const int tile = vb + ti * (int)gridDim.x;
    const int row0 = (tile / NT) * 128, col0 = (tile % NT) * 128;
    __syncthreads();
    LSTS(q, 1)
    GLDS(q, st + 3)
    __builtin_amdgcn_sched_barrier(0);
    if (kt == nk / 2) RESCALE()
    COMPUTE(0)
    __syncthreads();
    LSTS(p, 0)
    GLDS(p, st + 4)
    __builtin_amdgcn_sched_barrier(0);
    COMPUTE(1)
    if (kt + 2 < nk) continue;
    if (EPI == EPI_Q) {
      float* xch = (float*)(smem + 65536);
      float lst[4][16];
#pragma unroll
      for (int mt = 0; mt < 4; ++mt) {
        const int lr = wm * 64 + mt * 16 + l15;
        const float sc = rsqrtf(P.ss2[row0 + lr] * (1.f / 1024.f) + EPSF);
#pragma unroll
        for (int nt = 0; nt < 4; ++nt)
#pragma unroll
          for (int j = 0; j < 4; ++j) {
            const unsigned kidx = (unsigned)(wn * 64 + nt * 16 + lq * 4 + j);
            lst[mt][nt * 4 + j] = __uint_as_float((__float_as_uint(acc[mt][nt][j] * sc) & 0xffffff80u) | kidx);
          }
#pragma unroll
        for (int nt = 0; nt < 4; ++nt) acc[mt][nt] = (f32x4){0.f, 0.f, 0.f, 0.f};
        sort16(lst[mt]);
        float y[16];
#pragma unroll
        for (int i = 0; i < 16; ++i) y[i] = __shfl_xor(lst[mt][i], 16);
        merge_top16(lst[mt], y);
#pragma unroll
        for (int i = 0; i < 16; ++i) y[i] = __shfl_xor(lst[mt][i], 32);
        merge_top16(lst[mt], y);
      }
      if (wn == 1 && lq == 0) {
#pragma unroll
        for (int mt = 0; mt < 4; ++mt) {
          float4* d4 = (float4*)(xch + (wm * 64 + mt * 16 + l15) * 16);
#pragma unroll
          for (int i = 0; i < 4; ++i) d4[i] = make_float4(lst[mt][i * 4], lst[mt][i * 4 + 1], lst[mt][i * 4 + 2], lst[mt][i * 4 + 3]);
        }
      }
      __syncthreads();
      if (wn == 0) {
        const int hs = col0 >> 7;
#pragma unroll
        for (int mt = 0; mt < 4; ++mt) {
          const int lr = wm * 64 + mt * 16 + l15;
          const float4* s4 = (const float4*)(xch + lr * 16);
          float y[16];
#pragma unroll
          for (int i = 0; i < 4; ++i) { const float4 t = s4[i]; y[i * 4] = t.x; y[i * 4 + 1] = t.y; y[i * 4 + 2] = t.z; y[i * 4 + 3] = t.w; }
          merge_top16(lst[mt], y);
          if (lq == 0) {
            float4* d4 = (float4*)(P.t16 + ((size_t)(row0 + lr) * 16 + hs) * 16);
#pragma unroll
            for (int i = 0; i < 4; ++i) d4[i] = make_float4(lst[mt][i * 4], lst[mt][i * 4 + 1], lst[mt][i * 4 + 2], lst[mt][i * 4 + 3]);
          }
        }
      }
      continue;
    }
#pragma unroll
    for (int mt = 0; mt < 4; ++mt) {
      const int lr = wm * 64 + mt * 16 + l15;
      const size_t row = (size_t)(row0 + lr);
      float sc = 1.f;
      if (EPI == EPI_INPROJ) sc = P.rstd1[row];
      if (EPI == EPI_OUT) sc = rsqrtf(P.ssb[row] * (1.f / 512.f) + EPSF);
      if (EPI == EPI_Q) sc = rsqrtf(P.ss2[row] * (1.f / 1024.f) + EPSF);
      float sq = 0.f;
#pragma unroll
      for (int nt = 0; nt < 4; ++nt) {
        const int col = col0 + wn * 64 + nt * 16 + lq * 4;
        f32x4 v = acc[mt][nt];
        if (EPI == EPI_INPROJ) {
          *(uint2*)(P.p + row * 1536 + col) = make_uint2(pack2(v[0] * sc, v[1] * sc), pack2(v[2] * sc, v[3] * sc));
        } else if (EPI == EPI_GLU) {
          uint2 gg = *(const uint2*)(P.gs5 + row * 512 + col);
          float4 gb = *(const float4*)(P.glu_b + col);
          float g0 = bflo(gg.x), g1 = bfhi(gg.x), g2 = bflo(gg.y), g3 = bfhi(gg.y);
          float o0 = g0 * sigmoid_(v[0] + gb.x), o1 = g1 * sigmoid_(v[1] + gb.y);
          float o2 = g2 * sigmoid_(v[2] + gb.z), o3 = g3 * sigmoid_(v[3] + gb.w);
          sq += o0 * o0 + o1 * o1 + o2 * o2 + o3 * o3;
          *(uint2*)(P.ycat + row * 1024 + 512 + col) = make_uint2(pack2(o0, o1), pack2(o2, o3));
        } else {
          float4 xv = *(const float4*)(P.x + row * 1024 + col);
          float4 h = make_float4(xv.x + v[0] * sc, xv.y + v[1] * sc, xv.z + v[2] * sc, xv.w + v[3] * sc);
          sq += h.x * h.x + h.y * h.y + h.z * h.z + h.w * h.w;
          *(float4*)(P.out + row * 1024 + col) = h;
          *(uint2*)(P.hb + row * 1024 + col) = make_uint2(pack2(h.x, h.y), pack2(h.z, h.w));
        }
      }
      if (EPI == EPI_GLU || EPI == EPI_OUT) {
        sq += __shfl_xor(sq, 16);
        sq += __shfl_xor(sq, 32);
        if (lq == 0) atomicAdd((EPI == EPI_GLU ? P.ssb : P.ss2) + row, sq);
      }
#pragma unroll
      for (int nt = 0; nt < 4; ++nt) acc[mt][nt] = (f32x4){0.f, 0.f, 0.f, 0.f};
    }
  }
}

template <int EPI>
__device__ void gemm256_phase(const Params& P, char* smem, const u16* __restrict__ A, const u16* __restrict__ Bt,
                              int M, int N, int K) {
  u16* As = (u16*)smem;
  u16* Bs = As + 256 * 64;
  const int tid = threadIdx.x, lane = tid & 63, w = tid >> 6, wm = w >> 1, wn = w & 1;
  const int l15 = lane & 15, lq = lane >> 4;
  const int NT = N / 128, MT = M / 256, ntiles = MT * NT, nk = K / 64;
  int vb = blockIdx.x;
  if ((gridDim.x & 7) == 0) vb = (blockIdx.x & 7) * (gridDim.x >> 3) + (blockIdx.x >> 3);
  const int ldr = tid >> 3, ldc = (tid & 7) * 8;
  const int ldsw = ((tid & 7) ^ ((ldr >> 1) & 7)) * 8;
  const int rsw = (l15 >> 1) & 7;
  const int cnt = (vb < ntiles) ? (ntiles - vb + (int)gridDim.x - 1) / (int)gridDim.x : 0;
  const int total = cnt * nk;
  if (total == 0) return;
  f32x4 acc[8][4];
#pragma unroll
  for (int i = 0; i < 8; ++i)
#pragma unroll
    for (int j = 0; j < 4; ++j) acc[i][j] = (f32x4){0.f, 0.f, 0.f, 0.f};
  uint4 ga0, ga1, ga2, ga3, ga4, ga5, ga6, ga7, gb0, gb1, gb2, gb3;
  const u16 *Ag, *Bg;
#define G2_ADDR(st) { int st_ = (st) < total ? (st) : total - 1; int ti_ = st_ / nk, kk_ = st_ - ti_ * nk; \
      int tl_ = vb + ti_ * (int)gridDim.x; int r0_ = (tl_ / NT) * 256, c0_ = (tl_ % NT) * 128; \
      Ag = A + (size_t)(r0_ + ldr) * K + ldc + kk_ * 64; Bg = Bt + (size_t)(c0_ + ldr) * K + ldc + kk_ * 64; }
#define G2_LDA(i) ga##i = *(const uint4*)(Ag + (size_t)(32 * i) * K);
#define G2_LDB(i) gb##i = *(const uint4*)(Bg + (size_t)(32 * i) * K);
#define G2_GLD(st) { G2_ADDR(st) G2_LDA(0) G2_LDA(1) G2_LDA(2) G2_LDA(3) G2_LDA(4) G2_LDA(5) G2_LDA(6) G2_LDA(7) G2_LDB(0) G2_LDB(1) G2_LDB(2) G2_LDB(3) }
#define G2_STA(i) *(uint4*)(As + (ldr + 32 * i) * 64 + ldsw) = ga##i;
#define G2_STB(i) *(uint4*)(Bs + (ldr + 32 * i) * 64 + ldsw) = gb##i;
#define G2_LST() { G2_STA(0) G2_STA(1) G2_STA(2) G2_STA(3) G2_STA(4) G2_STA(5) G2_STA(6) G2_STA(7) G2_STB(0) G2_STB(1) G2_STB(2) G2_STB(3) }
  G2_GLD(0)
  for (int st = 0; st < total; ++st) {
    const int ti = st / nk, kt = st - ti * nk;
    const int tile = vb + ti * (int)gridDim.x;
    const int row0 = (tile / NT) * 256, col0 = (tile % NT) * 128;
    __syncthreads();
    G2_LST()
    G2_GLD(st + 1)
    __builtin_amdgcn_sched_barrier(0);
    __syncthreads();
    if (EPI == EPI_OUT && kt == nk / 2) {
#pragma unroll
      for (int mt = 0; mt < 8; ++mt) {
        const int row = row0 + wm * 128 + mt * 16 + l15;
        const float ra_ = rsqrtf(P.ssa[row] * (1.f / 512.f) + EPSF), rb_ = rsqrtf(P.ssb[row] * (1.f / 512.f) + EPSF);
        const float ratio = ra_ / rb_;
#pragma unroll
        for (int nt = 0; nt < 4; ++nt) acc[mt][nt] *= ratio;
      }
    }
#pragma unroll
    for (int ks = 0; ks < 2; ++ks) {
      bf16x8 bfr[4];
#pragma unroll
      for (int nt = 0; nt < 4; ++nt)
        bfr[nt] = *(const bf16x8*)(Bs + (wn * 64 + nt * 16 + l15) * 64 + (((ks * 4 + lq) ^ rsw) * 8));
#pragma unroll
      for (int hh = 0; hh < 2; ++hh) {
        bf16x8 af[4];
#pragma unroll
        for (int m = 0; m < 4; ++m)
          af[m] = *(const bf16x8*)(As + (wm * 128 + (hh * 4 + m) * 16 + l15) * 64 + (((ks * 4 + lq) ^ rsw) * 8));
#pragma unroll
        for (int m = 0; m < 4; ++m)
#pragma unroll
          for (int nt = 0; nt < 4; ++nt) acc[hh * 4 + m][nt] = MFMA16(bfr[nt], af[m], acc[hh * 4 + m][nt]);
      }
    }
    if (kt + 1 < nk) continue;
#pragma unroll
    for (int mt = 0; mt < 8; ++mt) {
      const int lr = wm * 128 + mt * 16 + l15;
      const size_t row = (size_t)(row0 + lr);
      float sc = 1.f;
      if (EPI == EPI_INPROJ) sc = P.rstd1[row];
      if (EPI == EPI_OUT) sc = rsqrtf(P.ssb[row] * (1.f / 512.f) + EPSF);
      float sq = 0.f;
#pragma unroll
      for (int nt = 0; nt < 4; ++nt) {
        const int col = col0 + wn * 64 + nt * 16 + lq * 4;
        f32x4 v = acc[mt][nt];
        if (EPI == EPI_INPROJ) {
          *(uint2*)(P.p + row * 1536 + col) = make_uint2(pack2(v[0] * sc, v[1] * sc), pack2(v[2] * sc, v[3] * sc));
        } else if (EPI == EPI_GLU) {
          uint2 gg = *(const uint2*)(P.gs5 + row * 512 + col);
          float4 gb = *(const float4*)(P.glu_b + col);
          float g0 = bflo(gg.x), g1 = bfhi(gg.x), g2 = bflo(gg.y), g3 = bfhi(gg.y);
          float o0 = g0 * sigmoid_(v[0] + gb.x), o1 = g1 * sigmoid_(v[1] + gb.y);
          float o2 = g2 * sigmoid_(v[2] + gb.z), o3 = g3 * sigmoid_(v[3] + gb.w);
          sq += o0 * o0 + o1 * o1 + o2 * o2 + o3 * o3;
          *(uint2*)(P.ycat + row * 1024 + 512 + col) = make_uint2(pack2(o0, o1), pack2(o2, o3));
        } else {
          float4 xv = *(const float4*)(P.x + row * 1024 + col);
          float4 h = make_float4(xv.x + v[0] * sc, xv.y + v[1] * sc, xv.z + v[2] * sc, xv.w + v[3] * sc);
          sq += h.x * h.x + h.y * h.y + h.z * h.z + h.w * h.w;
          *(float4*)(P.out + row * 1024 + col) = h;
          *(uint2*)(P.hb + row * 1024 + col) = make_uint2(pack2(h.x, h.y), pack2(h.z, h.w));
        }
        acc[mt][nt] = (f32x4){0.f, 0.f, 0.f, 0.f};
      }
      if (EPI == EPI_GLU || EPI == EPI_OUT) {
        sq += __shfl_xor(sq, 16);
        sq += __shfl_xor(sq, 32);
        if (lq == 0) atomicAdd((EPI == EPI_GLU ? P.ssb : P.ss2) + row, sq);
      }
    }
  }
}

__device__ __forceinline__ float one_minus_exp(float x) {
  const float ser = -x * (1.f + x * (0.5f + x * (0.16666667f + x * (0.041666668f + x * (0.0083333338f + x * 0.0013888889f)))));
  return (x > -0.5f) ? ser : (1.f - __expf(x));
}

template <bool FINAL>
__device__ void lru_phase(const Params& P, char* smem) {
  float* xcs = (float*)smem;
  float* a_s = xcs + 64 * 65;
  float* segA = a_s + 64 * 65;
  float* segH = segA + 256;
  const int tid = threadIdx.x, lane = tid & 63, w = tid >> 6;
  const int l15 = lane & 15, lq = lane >> 4;
  for (int item = blockIdx.x; item < 8192; item += gridDim.x) {
    const int head = item & 7, tile = (item >> 3) & 31, b = item >> 8;
    const int c0 = head * 64, t0 = tile * 64;
    __syncthreads();
    if (!FINAL) {
      bf16x8 af[2];
      {
        const int tl = w * 16 + l15;
        const int t = t0 + tl;
        const u16* prow = P.p + ((size_t)(b * 2048 + t)) * 1536 + c0;
#pragma unroll
        for (int ks = 0; ks < 2; ++ks) {
          const int ch = ks * 32 + lq * 8;
          float xc[8];
          {
            float4 b0 = *(const float4*)(P.conv_b + c0 + ch), b1 = *(const float4*)(P.conv_b + c0 + ch + 4);
            xc[0] = b0.x; xc[1] = b0.y; xc[2] = b0.z; xc[3] = b0.w; xc[4] = b1.x; xc[5] = b1.y; xc[6] = b1.z; xc[7] = b1.w;
          }
#pragma unroll
          for (int k = 0; k < 4; ++k) {
            if (t - 3 + k >= 0) {
              uint4 v = *(const uint4*)(prow + (k - 3) * 1536 + ch);
              float4 w0 = *(const float4*)(P.conv_w + k * 512 + c0 + ch), w1 = *(const float4*)(P.conv_w + k * 512 + c0 + ch + 4);
              xc[0] += w0.x * bflo(v.x); xc[1] += w0.y * bfhi(v.x); xc[2] += w0.z * bflo(v.y); xc[3] += w0.w * bfhi(v.y);
              xc[4] += w1.x * bflo(v.z); xc[5] += w1.y * bfhi(v.z); xc[6] += w1.z * bflo(v.w); xc[7] += w1.w * bfhi(v.w);
            }
          }
#pragma unroll
          for (int i = 0; i < 8; ++i) xcs[tl * 65 + ch + i] = xc[i];
          unsigned p0 = pack2(xc[0], xc[1]), p1 = pack2(xc[2], xc[3]), p2 = pack2(xc[4], xc[5]), p3 = pack2(xc[6], xc[7]);
          uint4 pk = make_uint4(p0, p1, p2, p3);
          af[ks] = *(bf16x8*)&pk;
        }
      }
      f32x4 accr[4], acci[4];
#pragma unroll
      for (int nt = 0; nt < 4; ++nt) {
        accr[nt] = (f32x4){0.f, 0.f, 0.f, 0.f};
        acci[nt] = (f32x4){0.f, 0.f, 0.f, 0.f};
#pragma unroll
        for (int ks = 0; ks < 2; ++ks) {
          bf16x8 ba = *(const bf16x8*)(P.WaT + head * 4096 + (nt * 16 + l15) * 64 + ks * 32 + lq * 8);
          bf16x8 bx = *(const bf16x8*)(P.WxT + head * 4096 + (nt * 16 + l15) * 64 + ks * 32 + lq * 8);
          accr[nt] = MFMA16(af[ks], ba, accr[nt]);
          acci[nt] = MFMA16(af[ks], bx, acci[nt]);
        }
      }
      __syncthreads();
#pragma unroll
      for (int nt = 0; nt < 4; ++nt) {
        const int ch = nt * 16 + l15;
        const float ba = P.lru_ba[c0 + ch], bx = P.lru_bx[c0 + ch], sp = P.spv[c0 + ch];
#pragma unroll
        for (int r = 0; r < 4; ++r) {
          const int tl = w * 16 + lq * 4 + r;
          float xf = xcs[tl * 65 + ch];
          float rr = sigmoid_(accr[nt][r] + ba), ig = sigmoid_(acci[nt][r] + bx);
          float la = -8.f * rr * sp;
          const float oma = one_minus_exp(la);
          const float om2 = one_minus_exp(2.f * la);
          float u = __builtin_amdgcn_sqrtf(om2) * ig * xf;
          a_s[tl * 65 + ch] = __uint_as_float((unsigned)f2bf(oma) | ((unsigned)f2bf(u) << 16));
        }
      }
      __syncthreads();
    }
    {
      const int ch = tid & 63, seg = tid >> 6;
      const size_t tok0 = (size_t)(b * 2048 + t0 + seg * 16);
      unsigned pk[16];
#pragma unroll
      for (int s = 0; s < 16; ++s) {
        if (!FINAL) {
          pk[s] = __float_as_uint(a_s[(seg * 16 + s) * 65 + ch]);
          P.au[(tok0 + s) * 512 + c0 + ch] = pk[s];
        } else {
          pk[s] = P.au[(tok0 + s) * 512 + c0 + ch];
        }
      }
      float Ap = 1.f, Hl = 0.f;
#pragma unroll
      for (int s = 0; s < 16; ++s) {
        const float a = 1.f - bflo(pk[s]), u = bfhi(pk[s]);
        Hl = a * Hl + u;
        Ap *= a;
      }
      segA[seg * 64 + ch] = Ap;
      segH[seg * 64 + ch] = Hl;
      __syncthreads();
      if (!FINAL) {
        if (seg == 0) {
          float Aa = 1.f, Hh = 0.f;
#pragma unroll
          for (int s = 0; s < 4; ++s) {
            Hh = segA[s * 64 + ch] * Hh + segH[s * 64 + ch];
            Aa *= segA[s * 64 + ch];
          }
          P.Acar[(b * 32 + tile) * 512 + c0 + ch] = Aa;
          P.Hcar[(b * 32 + tile) * 512 + c0 + ch] = Hh;
        }
      } else {
        float gate[16];
#pragma unroll
        for (int s = 0; s < 16; ++s) gate[s] = bf2f(P.p[(tok0 + s) * 1536 + 512 + c0 + ch]);
        float h = P.Hin[(b * 32 + tile) * 512 + c0 + ch];
#pragma unroll
        for (int s = 0; s < 3; ++s)
          if (s < seg) h = segA[s * 64 + ch] * h + segH[s * 64 + ch];
        float sqv[16];
#pragma unroll
        for (int s = 0; s < 16; ++s) {
          h = (1.f - bflo(pk[s])) * h + bfhi(pk[s]);
          const float yv = h * gelu_(gate[s]);
          sqv[s] = yv * yv;
          P.ycat[(tok0 + s) * 1024 + c0 + ch] = f2bf(yv);
        }
        {
          const bool hb = (lane & 32) != 0, b4 = (lane & 16) != 0, b3 = (lane & 8) != 0, b2 = (lane & 4) != 0;
#pragma unroll
          for (int i = 0; i < 8; ++i) { float sd = hb ? sqv[i] : sqv[i + 8], kp = hb ? sqv[i + 8] : sqv[i]; sqv[i] = kp + __shfl_xor(sd, 32); }
#pragma unroll
          for (int i = 0; i < 4; ++i) { float sd = b4 ? sqv[i] : sqv[i + 4], kp = b4 ? sqv[i + 4] : sqv[i]; sqv[i] = kp + __shfl_xor(sd, 16); }
#pragma unroll
          for (int i = 0; i < 2; ++i) { float sd = b3 ? sqv[i] : sqv[i + 2], kp = b3 ? sqv[i + 2] : sqv[i]; sqv[i] = kp + __shfl_xor(sd, 8); }
          { float sd = b2 ? sqv[0] : sqv[1], kp = b2 ? sqv[1] : sqv[0]; sqv[0] = kp + __shfl_xor(sd, 4); }
          sqv[0] += __shfl_xor(sqv[0], 2);
          sqv[0] += __shfl_xor(sqv[0], 1);
          if ((lane & 3) == 0) atomicAdd(P.ssa + tok0 + (lane >> 2), sqv[0]);
        }
      }
    }
  }
}

__device__ void carry_phase(const Params& P) {
  const int gt = blockIdx.x * 256 + threadIdx.x, nth = gridDim.x * 256;
  for (int i = gt; i < 16384 + 65536; i += nth) {
    if (i < 16384) {
      const int b = i >> 9, ch = i & 511;
      float h = 0.f;
      for (int t0 = 0; t0 < 32; t0 += 8) {
        float a[8], hh[8];
#pragma unroll
        for (int j = 0; j < 8; ++j) {
          a[j] = P.Acar[(b * 32 + t0 + j) * 512 + ch];
          hh[j] = P.Hcar[(b * 32 + t0 + j) * 512 + ch];
        }
#pragma unroll
        for (int j = 0; j < 8; ++j) {
          P.Hin[(b * 32 + t0 + j) * 512 + ch] = h;
          h = a[j] * h + hh[j];
        }
      }
    } else {
      const int k = i - 16384;
      const int pp = k & 63, g = (k >> 6) & 31, b = k >> 11;
      const float ar = P.A16[(g * 64 + pp) * 2], ai = P.A16[(g * 64 + pp) * 2 + 1];
      float hr = 0.f, hi = 0.f;
      for (int c0 = 0; c0 < 128; c0 += 8) {
        float er[8], ei[8];
#pragma unroll
        for (int j = 0; j < 8; ++j) {
          size_t base = ((size_t)(b * 128 + c0 + j) * 32 + g) * 128;
          er[j] = P.E[base + pp];
          ei[j] = P.E[base + 64 + pp];
        }
#pragma unroll
        for (int j = 0; j < 8; ++j) {
          size_t base = ((size_t)(b * 128 + c0 + j) * 32 + g) * 128;
          P.Hs[base + pp] = f2bf(hr);
          P.Hs[base + 64 + pp] = f2bf(hi);
          float nr = ar * hr - ai * hi + er[j], ni = ar * hi + ai * hr + ei[j];
          hr = nr; hi = ni;
        }
      }
    }
  }
}

template <bool YPH>
__device__ void s5_phase(const Params& P) {
  constexpr int MTW = YPH ? 4 : 2;
  const int tid = threadIdx.x, lane = tid & 63, w = tid >> 6;
  const int l15 = lane & 15, lq = lane >> 4;
  for (int item = blockIdx.x; item < 2048; item += gridDim.x) {
    const int g = ((item & 7) << 2) | ((item >> 3) & 3), cb = item >> 5;
    f32x4 acc[MTW][4];
#pragma unroll
    for (int i = 0; i < MTW; ++i)
#pragma unroll
      for (int j = 0; j < 4; ++j) acc[i][j] = (f32x4){0.f, 0.f, 0.f, 0.f};
    const u16* Am = YPH ? (P.MF + (size_t)g * 256 * 384) : (P.G + (size_t)g * 128 * 256);
    constexpr int LD = YPH ? 384 : 256;
    for (int ks = 0; ks < 8; ++ks) {
      bf16x8 bu[4];
#pragma unroll
      for (int nt = 0; nt < 4; ++nt) {
        const int Ncol = cb * 64 + nt * 16 + l15;
        const int b = Ncol >> 7, c = Ncol & 127;
        const int tau = ks * 2 + (lq >> 1), j0 = (lq & 1) * 8;
        bu[nt] = *(const bf16x8*)(P.p + ((size_t)(b * 2048 + c * 16 + tau)) * 1536 + 1024 + g * 16 + j0);
      }
#pragma unroll
      for (int mt = 0; mt < MTW; ++mt) {
        const int m = (w * MTW + mt) * 16 + l15;
        bf16x8 a = *(const bf16x8*)(Am + (size_t)m * LD + ks * 32 + lq * 8);
#pragma unroll
        for (int nt = 0; nt < 4; ++nt) acc[mt][nt] = MFMA16(a, bu[nt], acc[mt][nt]);
      }
    }
    if (YPH) {
      for (int ks = 0; ks < 4; ++ks) {
        bf16x8 bh[4];
#pragma unroll
        for (int nt = 0; nt < 4; ++nt) {
          const int Ncol = cb * 64 + nt * 16 + l15;
          bh[nt] = *(const bf16x8*)(P.Hs + ((size_t)Ncol * 32 + g) * 128 + ks * 32 + lq * 8);
        }
#pragma unroll
        for (int mt = 0; mt < MTW; ++mt) {
          const int m = (w * MTW + mt) * 16 + l15;
          bf16x8 a = *(const bf16x8*)(Am + (size_t)m * LD + 256 + ks * 32 + lq * 8);
#pragma unroll
          for (int nt = 0; nt < 4; ++nt) acc[mt][nt] = MFMA16(a, bh[nt], acc[mt][nt]);
        }
      }
    }
#pragma unroll
    for (int mt = 0; mt < MTW; ++mt)
#pragma unroll
      for (int nt = 0; nt < 4; ++nt) {
        const int Ncol = cb * 64 + nt * 16 + l15;
        f32x4 v = acc[mt][nt];
        if (!YPH) {
          const int m0 = (w * MTW + mt) * 16 + lq * 4;
          *(float4*)(P.E + ((size_t)Ncol * 32 + g) * 128 + m0) = make_float4(v[0], v[1], v[2], v[3]);
        } else {
          const int b = Ncol >> 7, c = Ncol & 127;
          const int tloc = w * MTW + mt;
          const size_t tok = (size_t)(b * 2048 + c * 16 + tloc);
          *(uint2*)(P.gs5 + tok * 512 + g * 16 + lq * 4) =
              make_uint2(pack2(gelu_(v[0]), gelu_(v[1])), pack2(gelu_(v[2]), gelu_(v[3])));
        }
      }
  }
}

__device__ __forceinline__ void top16_of_64(f32x16 (&acc)[4], int half, float (&res)[16]) {
  float g[4][16];
#pragma unroll
  for (int mt = 0; mt < 4; ++mt) {
#pragma unroll
    for (int i = 0; i < 16; ++i) {
      unsigned idx = mt * 32 + (i >> 2) * 8 + (i & 3);
      unsigned bits = (__float_as_uint(acc[mt][i]) & 0xffffff80u) | idx | (unsigned)(half * 4);
      g[mt][i] = __uint_as_float(bits);
    }
    sort16(g[mt]);
  }
  merge_top16(g[0], g[1]);
  merge_top16(g[2], g[3]);
  merge_top16(g[0], g[2]);
  float y[16];
#pragma unroll
  for (int i = 0; i < 16; ++i) y[i] = __shfl_xor(g[0][i], 32);
  merge_top16(g[0], y);
#pragma unroll
  for (int i = 0; i < 16; ++i) res[i] = g[0][i];
}
__host__ __device__ constexpr int cand_off(int i) {
  int s = 0;
  for (int q = 0; q < i; ++q) s += 16 / (q + 1);
  return s;
}

__device__ void cand_phase(const Params& P, char* smem) {
  const int tid = threadIdx.x;
  unsigned char* lut = (unsigned char*)smem + tid * 36;
  for (int gi = blockIdx.x * 256 + tid; gi < T_TOK * 8; gi += gridDim.x * 256) {
    const size_t tok = (size_t)(gi >> 3);
    const int head = gi & 7;
    float a[16], bl[16];
    {
      const float4* src = (const float4*)(P.t16 + (size_t)gi * 32);
#pragma unroll
      for (int i = 0; i < 4; ++i) {
        const float4 t = src[i], u = src[4 + i];
        a[i * 4] = t.x; a[i * 4 + 1] = t.y; a[i * 4 + 2] = t.z; a[i * 4 + 3] = t.w;
        bl[i * 4] = u.x; bl[i * 4 + 1] = u.y; bl[i * 4 + 2] = u.z; bl[i * 4 + 3] = u.w;
      }
    }
    float va[16], vb[16];
#pragma unroll
    for (int i = 0; i < 16; ++i) {
      va[i] = __uint_as_float(__float_as_uint(a[i]) & 0xffffff80u);
      vb[i] = __uint_as_float(__float_as_uint(bl[i]) & 0xffffff80u);
    }
    float cg4[4][16];
#pragma unroll
    for (int i = 0; i < 4; ++i)
#pragma unroll
      for (int j = 0; j < 16; ++j) cg4[i][j] = __uint_as_float(0xff800000u);
#pragma unroll
    for (int i = 0; i < 16; ++i)
#pragma unroll
      for (int j = 0; j < 16; ++j)
        if ((i + 1) * (j + 1) <= 16) {
          const int pos = cand_off(i) + j;
          float sm = va[i] + vb[j];
          cg4[pos >> 4][pos & 15] = __uint_as_float((__float_as_uint(sm) & 0xffffff00u) | (unsigned)(i * 16 + j));
        }
#pragma unroll
    for (int i = 0; i < 4; ++i) sort16(cg4[i]);
    merge_top16(cg4[0], cg4[1]);
    merge_top16(cg4[2], cg4[3]);
    merge_top16(cg4[0], cg4[2]);
    {
      unsigned* lw = (unsigned*)lut;
#pragma unroll
      for (int i = 0; i < 4; ++i) {
        lw[i] = (__float_as_uint(a[i * 4]) & 127u) | ((__float_as_uint(a[i * 4 + 1]) & 127u) << 8) |
                ((__float_as_uint(a[i * 4 + 2]) & 127u) << 16) | ((__float_as_uint(a[i * 4 + 3]) & 127u) << 24);
        lw[4 + i] = (__float_as_uint(bl[i * 4]) & 127u) | ((__float_as_uint(bl[i * 4 + 1]) & 127u) << 8) |
                    ((__float_as_uint(bl[i * 4 + 2]) & 127u) << 16) | ((__float_as_uint(bl[i * 4 + 3]) & 127u) << 24);
      }
    }
    float sc[16];
    int ee[16];
    const float mx = __uint_as_float(__float_as_uint(cg4[0][0]) & 0xffffff00u);
    float ssum = 0.f;
#pragma unroll
    for (int k = 0; k < 16; ++k) {
      unsigned bits = __float_as_uint(cg4[0][k]);
      unsigned code = bits & 255u;
      float v = __uint_as_float(bits & 0xffffff00u);
      sc[k] = __expf(v - mx);
      ssum += sc[k];
      int i1 = lut[code >> 4], i2 = lut[16 + (code & 15u)];
      ee[k] = i1 * 128 + i2;
    }
    const float inv = 1.f / ssum;
    int4* de = (int4*)(P.eidx + tok * 128 + head * 16);
    float4* ds = (float4*)(P.suv + tok * 128 + head * 16);
    float4* dg = (float4*)(P.gw + tok * 128 + head * 16);
#pragma unroll
    for (int i = 0; i < 4; ++i) {
      de[i] = make_int4(ee[i * 4], ee[i * 4 + 1], ee[i * 4 + 2], ee[i * 4 + 3]);
      ds[i] = make_float4(P.su[ee[i * 4]], P.su[ee[i * 4 + 1]], P.su[ee[i * 4 + 2]], P.su[ee[i * 4 + 3]]);
      dg[i] = make_float4(sc[i * 4] * inv * P.sv[ee[i * 4]], sc[i * 4 + 1] * inv * P.sv[ee[i * 4 + 1]],
                          sc[i * 4 + 2] * inv * P.sv[ee[i * 4 + 2]], sc[i * 4 + 3] * inv * P.sv[ee[i * 4 + 3]]);
    }
  }
}

typedef float f2v __attribute__((ext_vector_type(2)));
__device__ __forceinline__ float dot16_fp8(uint4 u, const f2v* x) {
  f2v acc = {0.f, 0.f};
  acc = __builtin_amdgcn_cvt_pk_f32_fp8(u.x, false) * x[0] + acc;
  acc = __builtin_amdgcn_cvt_pk_f32_fp8(u.x, true) * x[1] + acc;
  acc = __builtin_amdgcn_cvt_pk_f32_fp8(u.y, false) * x[2] + acc;
  acc = __builtin_amdgcn_cvt_pk_f32_fp8(u.y, true) * x[3] + acc;
  acc = __builtin_amdgcn_cvt_pk_f32_fp8(u.z, false) * x[4] + acc;
  acc = __builtin_amdgcn_cvt_pk_f32_fp8(u.z, true) * x[5] + acc;
  acc = __builtin_amdgcn_cvt_pk_f32_fp8(u.w, false) * x[6] + acc;
  acc = __builtin_amdgcn_cvt_pk_f32_fp8(u.w, true) * x[7] + acc;
  return acc.x + acc.y;
}
__device__ __forceinline__ void axpy16_fp8(f2v* o, float wgt, uint4 v) {
  const f2v ww = {wgt, wgt};
  o[0] = __builtin_amdgcn_cvt_pk_f32_fp8(v.x, false) * ww + o[0];
  o[1] = __builtin_amdgcn_cvt_pk_f32_fp8(v.x, true) * ww + o[1];
  o[2] = __builtin_amdgcn_cvt_pk_f32_fp8(v.y, false) * ww + o[2];
  o[3] = __builtin_amdgcn_cvt_pk_f32_fp8(v.y, true) * ww + o[3];
  o[4] = __builtin_amdgcn_cvt_pk_f32_fp8(v.z, false) * ww + o[4];
  o[5] = __builtin_amdgcn_cvt_pk_f32_fp8(v.z, true) * ww + o[5];
  o[6] = __builtin_amdgcn_cvt_pk_f32_fp8(v.w, false) * ww + o[6];
  o[7] = __builtin_amdgcn_cvt_pk_f32_fp8(v.w, true) * ww + o[7];
}

__device__ void peer_phase(const Params& P) {
  const int lane = threadIdx.x & 63;
  const int w = __builtin_amdgcn_readfirstlane(threadIdx.x >> 6);
  const int gwv = blockIdx.x * 4 + w, nw = gridDim.x * 4;
  const bool hb = (lane & 32) != 0, b4 = (lane & 16) != 0, b3 = (lane & 8) != 0;
  float4 g2v[4];
#pragma unroll
  for (int c = 0; c < 4; ++c) g2v[c] = *(const float4*)(P.norm2_g + lane * 16 + c * 4);
  float4 hn[4];
  if (gwv < T_TOK) {
#pragma unroll
    for (int c = 0; c < 4; ++c) hn[c] = *(const float4*)(P.out + (size_t)gwv * 1024 + lane * 16 + c * 4);
  }
  for (int tok = gwv; tok < T_TOK; tok += nw) {
    float4 hc[4];
#pragma unroll
    for (int c = 0; c < 4; ++c) hc[c] = hn[c];
    {
      const int ntok = (tok + nw < T_TOK) ? tok + nw : tok;
#pragma unroll
      for (int c = 0; c < 4; ++c) hn[c] = *(const float4*)(P.out + (size_t)ntok * 1024 + lane * 16 + c * 4);
    }
    const int* ep = P.eidx + (size_t)tok * 128;
    const float* gp = P.gw + (size_t)tok * 128;
    const float* sp = P.suv + (size_t)tok * 128;
    uint4 uA[8], uB[8];
    float suA, gA, suB, gB;
    int elA, elB;
#define LOADU(U, SU, G, EL, kb) { _Pragma("unroll") for (int j = 0; j < 8; ++j) { const int e = ep[(kb) + j]; \
        U[j] = *(const uint4*)(P.U8 + (size_t)e * 1024 + lane * 16); } \
      SU = sp[(kb) + (lane >> 3)]; G = gp[(kb) + (lane >> 3)]; EL = ep[(kb) + (lane >> 3)]; }
    LOADU(uA, suA, gA, elA, 0)
    __builtin_amdgcn_sched_barrier(0);
    float ss = 0.f;
#pragma unroll
    for (int c = 0; c < 4; ++c) ss += hc[c].x * hc[c].x + hc[c].y * hc[c].y + hc[c].z * hc[c].z + hc[c].w * hc[c].w;
    ss = wsum(ss);
    const float rstd2 = rsqrtf(ss * (1.f / 1024.f) + EPSF);
    f2v xn[8];
#pragma unroll
    for (int c = 0; c < 4; ++c) {
      xn[c * 2 + 0] = (f2v){hc[c].x * rstd2 * g2v[c].x, hc[c].y * rstd2 * g2v[c].y};
      xn[c * 2 + 1] = (f2v){hc[c].z * rstd2 * g2v[c].z, hc[c].w * rstd2 * g2v[c].w};
    }
#define PROCU(U, SU, G, EL, kb) { float d[8]; \
      _Pragma("unroll") for (int j = 0; j < 8; ++j) d[j] = dot16_fp8(U[j], xn); \
      _Pragma("unroll") for (int i = 0; i < 4; ++i) { float send = hb ? d[i] : d[i + 4], keep = hb ? d[i + 4] : d[i]; d[i] = keep + __shfl_xor(send, 32); } \
      _Pragma("unroll") for (int i = 0; i < 2; ++i) { float send = b4 ? d[i] : d[i + 2], keep = b4 ? d[i + 2] : d[i]; d[i] = keep + __shfl_xor(send, 16); } \
      { float send = b3 ? d[0] : d[1], keep = b3 ? d[1] : d[0]; d[0] = keep + __shfl_xor(send, 8); } \
      d[0] += __shfl_xor(d[0], 4); d[0] += __shfl_xor(d[0], 2); d[0] += __shfl_xor(d[0], 1); \
      const float act = gelu_(d[0] * SU) * G; \
      if ((lane & 7) == 0) ((unsigned*)P.wact)[(size_t)tok * 128 + (kb) + (lane >> 3)] = ((unsigned)f2bf(act) << 16) | (unsigned)EL; }
    for (int k0 = 0; k0 < 128; k0 += 16) {
      LOADU(uB, suB, gB, elB, k0 + 8)
      __builtin_amdgcn_sched_barrier(0);
      PROCU(uA, suA, gA, elA, k0)
      { const int kn = (k0 + 16 < 128) ? k0 + 16 : 112; LOADU(uA, suA, gA, elA, kn) }
      __builtin_amdgcn_sched_barrier(0);
      PROCU(uB, suB, gB, elB, k0 + 8)
    }
  }
}

__device__ void udot_phase(const Params& P) {
  const int my_xcc = (int)((unsigned)__builtin_amdgcn_s_getreg((3 << 11) | 20) & 7u), my_rank = P.rank[blockIdx.x];
  const int lane = threadIdx.x & 63, w = threadIdx.x >> 6;
  const int r = lane >> 3, c = lane & 7;
  const bool b2 = (lane & 4) != 0, b1 = (lane & 2) != 0, b0 = (lane & 1) != 0;
  int cen_ok = 1, cen_sum = 0, cen_mine = 0;
#pragma unroll
  for (int x = 0; x < 8; ++x) {
    const int cx = (int)__hip_atomic_load(P.bar + 15 * 512 + x * 32, __ATOMIC_RELAXED, __HIP_MEMORY_SCOPE_AGENT);
    cen_ok &= (cx > 0); cen_sum += cx; if (x == my_xcc) cen_mine = cx;
  }
  const bool fast = cen_ok && cen_sum == (int)gridDim.x;
  const int nwt = fast ? cen_mine * 4 : (int)gridDim.x * 4;
  const int wv = fast ? my_rank * 4 + w : (int)blockIdx.x * 4 + w;
  const int total = fast ? T_TOK : T_TOK * 8;
  const int cnt = (wv < total) ? (total - wv + nwt - 1) / nwt : 0;
  if (cnt == 0) return;
  const int slf = my_xcc;
#define UTOK(n, SL, TK) { int it_ = wv + ((n) < cnt ? (n) : cnt - 1) * nwt; SL = fast ? slf : (it_ & 7); TK = fast ? it_ : (it_ >> 3); }
#define ULOADE(E, n) { int sl_, tk_; UTOK(n, sl_, tk_) (void)sl_; const uint4* ep_ = (const uint4*)(P.eidx + (size_t)tk_ * 128 + r * 16); \
      _Pragma("unroll") for (int i = 0; i < 4; ++i) E[i] = ep_[i]; }
#define UGATHER(V, E, n) { int sl_, tk_; UTOK(n, sl_, tk_) (void)tk_; const unsigned char* ub_ = P.U8 + (size_t)sl_ * (16384 * 128) + c * 16; \
      _Pragma("unroll") for (int i = 0; i < 4; ++i) { \
        V[i * 4 + 0] = *(const uint4*)(ub_ + (size_t)E[i].x * 128); V[i * 4 + 1] = *(const uint4*)(ub_ + (size_t)E[i].y * 128); \
        V[i * 4 + 2] = *(const uint4*)(ub_ + (size_t)E[i].z * 128); V[i * 4 + 3] = *(const uint4*)(ub_ + (size_t)E[i].w * 128); } }
#define UHLOAD(H, S2, n) { int sl_, tk_; UTOK(n, sl_, tk_) const u16* hp_ = P.hb + (size_t)tk_ * 1024 + sl_ * 128 + c * 16; \
      H[0] = *(const float4*)hp_; H[1] = *(const float4*)(hp_ + 8);     (void)S2; }
#define UPROC(V, H, S2, n) { int sl_, tk_; UTOK(n, sl_, tk_) \
      f2v xn_[8]; \
      _Pragma("unroll") for (int i = 0; i < 2; ++i) { \
        const unsigned u0_ = __float_as_uint(H[i].x), u1_ = __float_as_uint(H[i].y), u2_ = __float_as_uint(H[i].z), u3_ = __float_as_uint(H[i].w); \
        xn_[i * 4] = (f2v){bflo(u0_), bfhi(u0_)}; xn_[i * 4 + 1] = (f2v){bflo(u1_), bfhi(u1_)}; \
        xn_[i * 4 + 2] = (f2v){bflo(u2_), bfhi(u2_)}; xn_[i * 4 + 3] = (f2v){bflo(u3_), bfhi(u3_)}; } \
      float d[16]; _Pragma("unroll") for (int i = 0; i < 16; ++i) d[i] = dot16_fp8(V[i], xn_); \
      _Pragma("unroll") for (int i = 0; i < 8; ++i) { float sd = b2 ? d[i] : d[i + 8], kp = b2 ? d[i + 8] : d[i]; d[i] = kp + __shfl_xor(sd, 4); } \
      _Pragma("unroll") for (int i = 0; i < 4; ++i) { float sd = b1 ? d[i] : d[i + 4], kp = b1 ? d[i + 4] : d[i]; d[i] = kp + __shfl_xor(sd, 2); } \
      _Pragma("unroll") for (int i = 0; i < 2; ++i) { float sd = b0 ? d[i] : d[i + 2], kp = b0 ? d[i + 2] : d[i]; d[i] = kp + __shfl_xor(sd, 1); } \
      nt_st_f2(make_float2(d[0], d[1]), P.part + ((size_t)sl_ * T_TOK + tk_) * 128 + lane * 2); }
  uint4 eA[4], eB[4];
  uint4 vA[16], vB[16];
  ULOADE(eA, 0)
  ULOADE(eB, 1)
  UGATHER(vA, eA, 0)
  __builtin_amdgcn_sched_barrier(0);
  for (int n = 0; n < cnt; n += 2) {
    { float4 h_[4]; float s2_ = 0.f; UHLOAD(h_, s2_, n) UGATHER(vB, eB, n + 1) ULOADE(eA, n + 2)
      __builtin_amdgcn_sched_barrier(0); UPROC(vA, h_, s2_, n) }
    if (n + 1 < cnt) {
      float4 h_[4]; float s2_ = 0.f; UHLOAD(h_, s2_, n + 1) UGATHER(vA, eA, n + 2) ULOADE(eB, n + 3)
      __builtin_amdgcn_sched_barrier(0); UPROC(vB, h_, s2_, n + 1)
    }
  }
}

__device__ void ucomb_phase(const Params& P) {
  const size_t gt = (size_t)blockIdx.x * 256 + threadIdx.x, nt = (size_t)gridDim.x * 256;
  for (size_t i = gt; i < (size_t)T_TOK * 32; i += nt) {
    float4 a = ((const float4*)P.part)[i];
#pragma unroll
    for (int sl = 1; sl < 8; ++sl) {
      const float4 b = ((const float4*)P.part)[(size_t)sl * T_TOK * 32 + i];
      a.x += b.x; a.y += b.y; a.z += b.z; a.w += b.w;
    }
    float4 su = ((const float4*)P.suv)[i]; const float4 g = ((const float4*)P.gw)[i];
    { const float r2 = rsqrtf(P.ss2[i >> 5] * (1.f / 1024.f) + EPSF); su.x *= r2; su.y *= r2; su.z *= r2; su.w *= r2; }
    const int4 e = ((const int4*)P.eidx)[i];
    uint4 o;
    o.x = ((unsigned)f2bf(gelu_(a.x * su.x) * g.x) << 16) | (unsigned)e.x;
    o.y = ((unsigned)f2bf(gelu_(a.y * su.y) * g.y) << 16) | (unsigned)e.y;
    o.z = ((unsigned)f2bf(gelu_(a.z * su.z) * g.z) << 16) | (unsigned)e.z;
    o.w = ((unsigned)f2bf(gelu_(a.w * su.w) * g.w) << 16) | (unsigned)e.w;
    ((uint4*)P.wact)[i] = o;
  }
}

__device__ void vacc_phase(const Params& P) {
  const int my_xcc = (int)((unsigned)__builtin_amdgcn_s_getreg((3 << 11) | 20) & 7u), my_rank = P.rank[blockIdx.x];
  const int lane = threadIdx.x & 63, w = threadIdx.x >> 6;
  const int r = lane >> 3, c = lane & 7;
  const bool hb = (lane & 32) != 0, b4 = (lane & 16) != 0, b3 = (lane & 8) != 0;
  int cen_ok = 1, cen_sum = 0, cen_mine = 0;
#pragma unroll
  for (int x = 0; x < 8; ++x) {
    const int cx = (int)__hip_atomic_load(P.bar + 15 * 512 + x * 32, __ATOMIC_RELAXED, __HIP_MEMORY_SCOPE_AGENT);
    cen_ok &= (cx > 0); cen_sum += cx; if (x == my_xcc) cen_mine = cx;
  }
  const bool fast = cen_ok && cen_sum == (int)gridDim.x;
  const int nwt = fast ? cen_mine * 4 : (int)gridDim.x * 4;
  const int wv = fast ? my_rank * 4 + w : (int)blockIdx.x * 4 + w;
  const int total = fast ? T_TOK : T_TOK * 8;
  const int cnt = (wv < total) ? (total - wv + nwt - 1) / nwt : 0;
  if (cnt == 0) return;
  const int slf = my_xcc;
#define VTOK(n, SL, TK) { int it_ = wv + ((n) < cnt ? (n) : cnt - 1) * nwt; SL = fast ? slf : (it_ & 7); TK = fast ? it_ : (it_ >> 3); }
#define VLOADEW(E, W, n) { int sl_, tk_; VTOK(n, sl_, tk_) (void)sl_; \
      const uint4* ep_ = (const uint4*)(P.wact + (size_t)tk_ * 128 + r * 16); \
      _Pragma("unroll") for (int i = 0; i < 4; ++i) { E[i] = ep_[i]; } }
#define VGATHER(V, E, n) { int sl_, tk_; VTOK(n, sl_, tk_) (void)tk_; const unsigned char* vb_ = P.V8 + (size_t)sl_ * (16384 * 128) + c * 16; \
      _Pragma("unroll") for (int i = 0; i < 4; ++i) { \
        V[i * 4 + 0] = *(const uint4*)(vb_ + (size_t)(E[i].x & 0xffffu) * 128); V[i * 4 + 1] = *(const uint4*)(vb_ + (size_t)(E[i].y & 0xffffu) * 128); \
        V[i * 4 + 2] = *(const uint4*)(vb_ + (size_t)(E[i].z & 0xffffu) * 128); V[i * 4 + 3] = *(const uint4*)(vb_ + (size_t)(E[i].w & 0xffffu) * 128); } }
#define VPROC(V, W, HV, n) { int sl_, tk_; VTOK(n, sl_, tk_) \
      f2v o[8]; _Pragma("unroll") for (int i = 0; i < 8; ++i) o[i] = (f2v){0.f, 0.f}; \
      _Pragma("unroll") for (int i = 0; i < 4; ++i) { axpy16_fp8(o, bfhi(W[i].x), V[i * 4 + 0]); axpy16_fp8(o, bfhi(W[i].y), V[i * 4 + 1]); \
        axpy16_fp8(o, bfhi(W[i].z), V[i * 4 + 2]); axpy16_fp8(o, bfhi(W[i].w), V[i * 4 + 3]); } \
      float f[16]; _Pragma("unroll") for (int i = 0; i < 8; ++i) { f[i * 2] = o[i].x; f[i * 2 + 1] = o[i].y; } \
      _Pragma("unroll") for (int i = 0; i < 8; ++i) { float sd = hb ? f[i] : f[i + 8], kp = hb ? f[i + 8] : f[i]; f[i] = kp + __shfl_xor(sd, 32); } \
      _Pragma("unroll") for (int i = 0; i < 4; ++i) { float sd = b4 ? f[i] : f[i + 4], kp = b4 ? f[i + 4] : f[i]; f[i] = kp + __shfl_xor(sd, 16); } \
      _Pragma("unroll") for (int i = 0; i < 2; ++i) { float sd = b3 ? f[i] : f[i + 2], kp = b3 ? f[i + 2] : f[i]; f[i] = kp + __shfl_xor(sd, 8); } \
      float2* hp_ = (float2*)(P.out + (size_t)tk_ * 1024 + sl_ * 128 + c * 16 + r * 2); \
      float2 hv_ = HV; hv_.x += f[0]; hv_.y += f[1]; nt_st_f2(hv_, hp_); \
      float sq_ = wsum(hv_.x * hv_.x + hv_.y * hv_.y); if (lane == 0) atomicAdd(P.ssf + tk_, sq_); }
#define VHLOAD(HV, n) { int sl_, tk_; VTOK(n, sl_, tk_) HV = *(const float2*)(P.out + (size_t)tk_ * 1024 + sl_ * 128 + c * 16 + r * 2); }
#define IT2(VC, EC, VN, EN, n) { float2 hv0_; VHLOAD(hv0_, n) VGATHER(VN, EN, (n) + 1) VLOADEW(eC, eC, (n) + 2) \
      __builtin_amdgcn_sched_barrier(0); VPROC(VC, EC, hv0_, n) \
      _Pragma("unroll") for (int i = 0; i < 4; ++i) EC[i] = eC[i]; }
  uint4 eA[4], eB[4], eC[4];
  uint4 vA[16], vB[16];
  VLOADEW(eA, eA, 0)
  VLOADEW(eB, eB, 1)
  VGATHER(vA, eA, 0)
  __builtin_amdgcn_sched_barrier(0);
  for (int n = 0; n < cnt; n += 2) {
    IT2(vA, eA, vB, eB, n)
    if (n + 1 < cnt) IT2(vB, eB, vA, eA, n + 1)
  }
}

__device__ void final_phase(const Params& P) {
  const int lane = threadIdx.x & 63, w = threadIdx.x >> 6;
  const int gwv = blockIdx.x * 4 + w, nw = gridDim.x * 4;
  float4 g[4];
#pragma unroll
  for (int c = 0; c < 4; ++c) g[c] = *(const float4*)(P.normf_g + lane * 16 + c * 4);
  for (int tok = gwv; tok < T_TOK; tok += nw) {
    float* hrow = P.out + (size_t)tok * 1024 + lane * 16;
    const float rf = rsqrtf(P.ssf[tok] * (1.f / 1024.f) + EPSF);
#pragma unroll
    for (int c = 0; c < 4; ++c) {
      float4 v = *(const float4*)(hrow + c * 4);
      *(float4*)(hrow + c * 4) = make_float4(v.x * rf * g[c].x, v.y * rf * g[c].y, v.z * rf * g[c].z, v.w * rf * g[c].w);
    }
  }
}

__device__ __forceinline__ void gbar(unsigned* bar, int k) {
  asm volatile("s_waitcnt vmcnt(0)" ::: "memory");
  __syncthreads();
  if (threadIdx.x == 0) {
    unsigned* base = bar + k * 512;
    const unsigned g = blockIdx.x & 7u;
    const unsigned gsz = (gridDim.x - g + 7u) >> 3;
    const unsigned ngroups = gridDim.x < 8u ? gridDim.x : 8u;
    __builtin_amdgcn_fence(__ATOMIC_RELEASE, "agent");
    asm volatile("s_waitcnt vmcnt(0)" ::: "memory");
    const unsigned old = __hip_atomic_fetch_add(base + g * 32, 1u, __ATOMIC_RELAXED, __HIP_MEMORY_SCOPE_AGENT);
    if (old == gsz - 1u) __hip_atomic_fetch_add(base + 256, 1u, __ATOMIC_RELAXED, __HIP_MEMORY_SCOPE_AGENT);
    unsigned spins = 0;
    while (__hip_atomic_load(base + 256, __ATOMIC_RELAXED, __HIP_MEMORY_SCOPE_AGENT) < ngroups && spins < (1u << 22)) {
      __builtin_amdgcn_s_sleep(1);
      ++spins;
    }
    __builtin_amdgcn_fence(__ATOMIC_ACQUIRE, "agent");
    asm volatile("s_waitcnt vmcnt(0)" ::: "memory");
  }
  __syncthreads();
}

#define SMEM_BYTES 74752

template <int PH>
__device__ __forceinline__ void run_phase(const Params& P, char* smem) {
  if (PH == 0) phase_prep(P, smem);
  if (PH == 1) gemm256_phase<EPI_INPROJ>(P, smem, P.xb, P.WinT, T_TOK, 1536, 1024);
  if (PH == 2) { lru_phase<false>(P, smem); s5_phase<false>(P); }
  if (PH == 3) carry_phase(P);
  if (PH == 4) { lru_phase<true>(P, smem); s5_phase<true>(P); }
  if (PH == 5) gemm_phase<EPI_GLU>(P, smem, P.gs5, P.GluT, T_TOK, 512, 512);
  if (PH == 6) gemm256_phase<EPI_OUT>(P, smem, P.ycat, P.WoutT, T_TOK, 1024, 1024);
  if (PH == 7) gemm_phase<EPI_Q>(P, smem, P.hb, P.WqT, T_TOK, 2048, 1024);
  if (PH == 8) cand_phase(P, smem);
  if (PH == 9) udot_phase(P);
  if (PH == 10) ucomb_phase(P);
  if (PH == 11) vacc_phase(P);
  if (PH == 12) final_phase(P);
}

template <int LO, int HI>
__global__ void __launch_bounds__(256, 2) mk(Params P) {
  __shared__ __attribute__((aligned(16))) char smem[SMEM_BYTES];
  cg::grid_group grid = cg::this_grid();
#ifndef REPEAT_MASK
#define REPEAT_MASK 0
#endif
#define PHASE(n) if (LO <= n && n <= HI) { if ((REPEAT_MASK >> n) & 1) { run_phase<n>(P, smem); grid.sync(); } run_phase<n>(P, smem); if (n < HI) gbar(P.bar, n); }
  if (threadIdx.x == 0) {
    const unsigned xcc = (unsigned)__builtin_amdgcn_s_getreg((3 << 11) | 20) & 7u;
    const unsigned rk = __hip_atomic_fetch_add(P.bar + 15 * 512 + xcc * 32, 1u, __ATOMIC_RELAXED, __HIP_MEMORY_SCOPE_AGENT);
    P.rank[blockIdx.x] = (int)rk;
  }
  if (P.bar == nullptr) grid.sync();
  PHASE(0) PHASE(1) PHASE(2) PHASE(3) PHASE(4) PHASE(5) PHASE(6) PHASE(7) PHASE(8) PHASE(9) PHASE(10) PHASE(11) PHASE(12)
}

extern "C" void kernel_launch(void* const* d_in, const int* in_sizes, int n_in, void* d_out, int out_size,
                              void* d_ws, size_t ws_size, hipStream_t stream) {
  Params P{};
  const float** pin = (const float**)&P;
  for (int i = 0; i < 30; ++i) pin[i] = (const float*)d_in[i];
  P.out = (float*)d_out;
  char* ws = (char*)d_ws;
  size_t off = 0;
  auto take = [&](size_t bytes) { char* r = ws + off; off += (bytes + 255) & ~(size_t)255; return r; };
  const size_t MB = 1024 * 1024;
  char* RA = take(128 * MB);
  char* RB = take(256 * MB);
  char* RC = take(128 * MB);
  char* RD = take(96 * MB);
  P.xb = (u16*)RA; P.ycat = (u16*)RA;
  P.p = (u16*)RB; P.q = (u16*)RB;
  P.E = (float*)RC; P.Hs = (u16*)(RC + 64 * MB); P.hb = (u16*)RC;
  P.gs5 = (u16*)RD; P.eidx = (int*)RD; P.gw = (float*)(RD + 32 * MB); P.suv = (float*)(RD + 64 * MB);
  P.U8 = (unsigned char*)take(16 * MB); P.V8 = (unsigned char*)take(16 * MB);
  P.su = (float*)take(16384 * 4); P.sv = (float*)take(16384 * 4);
  P.WinT = (u16*)take(1536 * 1024 * 2); P.GluT = (u16*)take(512 * 512 * 2);
  P.WoutT = (u16*)take(1024 * 1024 * 2); P.WqT = (u16*)take(2048 * 1024 * 2);
  P.K1b = (u16*)take(128 * 128 * 2); P.K2b = (u16*)take(128 * 128 * 2);
  P.WaT = (u16*)take(8 * 4096 * 2); P.WxT = (u16*)take(8 * 4096 * 2);
  P.MF = (u16*)take(32 * 256 * 384 * 2); P.G = (u16*)take(32 * 128 * 256 * 2);
  P.spv = (float*)take(512 * 4);
  P.ssf = (float*)take(T_TOK * 4); P.wact = (float*)RA; P.part = (float*)RB; P.t16 = (float*)RB;
  P.ssa = (float*)take(T_TOK * 4); P.ssb = (float*)take(T_TOK * 4); P.ss2 = (float*)take(T_TOK * 4);
  P.rstd1 = (float*)take(T_TOK * 4); P.A16 = (float*)take(32 * 64 * 2 * 4);
  P.Acar = (float*)take(32 * 32 * 512 * 4); P.Hcar = (float*)take(32 * 32 * 512 * 4); P.Hin = (float*)take(32 * 32 * 512 * 4);

  P.bar = (unsigned*)take(16 * 2048);
  P.au = (unsigned*)take((size_t)T_TOK * 512 * 4);
  P.rank = (int*)take(4096 * 4);
  static int grid_blocks = 0;
#if ONE_LAUNCH
  (void)hipMemsetAsync(P.bar, 0, 16 * 2048, stream);
  if (!grid_blocks) {
    int dev = 0, cus = 0, per_cu = 0;
    (void)hipGetDevice(&dev);
    (void)hipDeviceGetAttribute(&cus, hipDeviceAttributeMultiprocessorCount, dev);
    (void)hipOccupancyMaxActiveBlocksPerMultiprocessor(&per_cu, mk<0, NPHASE - 1>, 256, 0);
    if (per_cu > 2) per_cu = 2;
    if (per_cu < 1) per_cu = 1;
    grid_blocks = cus * per_cu;
  }
  void* args[] = {&P};
  hipError_t e = hipLaunchCooperativeKernel((void*)mk<0, NPHASE - 1>, dim3(grid_blocks), dim3(256), args, 0, stream);
  if (e != hipSuccess) fprintf(stderr, "cooperative launch failed: %s (grid %d)\n", hipGetErrorString(e), grid_blocks);
#else
  if (!grid_blocks) {
    int dev = 0, cus = 0;
    (void)hipGetDevice(&dev);
    (void)hipDeviceGetAttribute(&cus, hipDeviceAttributeMultiprocessorCount, dev);
    grid_blocks = cus * 2;
  }
  mk<0, 0><<<grid_blocks, 256, 0, stream>>>(P);
  mk<1, 1><<<grid_blocks, 256, 0, stream>>>(P);
  mk<2, 2><<<grid_blocks, 256, 0, stream>>>(P);
  mk<3, 3><<<grid_blocks, 256, 0, stream>>>(P);
  mk<4, 4><<<grid_blocks, 256, 0, stream>>>(P);
  mk<5, 5><<<grid_blocks, 256, 0, stream>>>(P);
  mk<6, 6><<<grid_blocks, 256, 0, stream>>>(P);
  mk<7, 7><<<grid_blocks, 256, 0, stream>>>(P);
  mk<8, 8><<<grid_blocks, 256, 0, stream>>>(P);
  mk<9, 9><<<grid_blocks, 256, 0, stream>>>(P);
#endif
}
```

```cpp
#include <hip/hip_runtime.h>
#include <hip/hip_cooperative_groups.h>
#include <cstdio>
namespace cg = cooperative_groups;

typedef unsigned short u16;
using bf16x8 = __attribute__((ext_vector_type(8))) short;
using f32x4 = __attribute__((ext_vector_type(4))) float;
using f32x16 = __attribute__((ext_vector_type(16))) float;

#ifndef ONE_LAUNCH
#define ONE_LAUNCH 1
#endif

#define T_TOK 65536
#define EPSF 1e-6f
#define NPHASE 13

struct Params {
  const float *x, *norm1_g, *w_in, *conv_w, *conv_b, *lru_wa, *lru_ba, *lru_wx, *lru_bx, *lru_lambda;
  const float *s5_lre, *s5_lim, *s5_logdt, *s5_bre, *s5_bim, *s5_cre, *s5_cim, *s5_d, *glu_w, *glu_b;
  const float *gnorm_lru, *gnorm_s5, *w_out, *norm2_g, *wq, *k1, *k2, *pu, *pv, *normf_g;
  float* out;
  u16 *xb, *WinT, *GluT, *WoutT, *WqT, *K1b, *K2b, *Ub, *Vb, *WaT, *WxT, *MF, *G, *p, *Hs, *ycat, *gs5, *hb, *q;
  float *rstd1, *A16, *Acar, *Hcar, *Hin, *E, *gw, *suv, *su, *sv, *ssa, *ssb, *ss2, *ssf, *wact, *part, *spv, *t16;
  int* eidx;
  unsigned char *U8, *V8;
  unsigned* bar;
  unsigned* au;
  int* rank;
};

__device__ __forceinline__ u16 f2bf(float f) {
  unsigned u = __float_as_uint(f);
  u += 0x7fffu + ((u >> 16) & 1u);
  return (u16)(u >> 16);
}
__device__ __forceinline__ float bf2f(u16 h) { return __uint_as_float(((unsigned)h) << 16); }
__device__ __forceinline__ unsigned pack2(float a, float b) { return (unsigned)f2bf(a) | (((unsigned)f2bf(b)) << 16); }
__device__ __forceinline__ float bflo(unsigned u) { return __uint_as_float(u << 16); }
__device__ __forceinline__ float bfhi(unsigned u) { return __uint_as_float(u & 0xffff0000u); }
__device__ __forceinline__ float sigmoid_(float x) { return __builtin_amdgcn_rcpf(1.f + __expf(-x)); }
__device__ __forceinline__ float gelu_(float x) {
  float z = 0.7978845608028654f * (x + 0.044715f * x * x * x);
  return x * __builtin_amdgcn_rcpf(1.f + __expf(-2.f * z));
}
__device__ __forceinline__ float wsum(float v) {
#pragma unroll
  for (int o = 32; o; o >>= 1) v += __shfl_xor(v, o);
  return v;
}
__device__ __forceinline__ float sq8(uint4 v) {
  float s = 0.f, t;
  t = bflo(v.x); s += t * t; t = bfhi(v.x); s += t * t;
  t = bflo(v.y); s += t * t; t = bfhi(v.y); s += t * t;
  t = bflo(v.z); s += t * t; t = bfhi(v.z); s += t * t;
  t = bflo(v.w); s += t * t; t = bfhi(v.w); s += t * t;
  return s;
}
typedef unsigned u32x4e __attribute__((ext_vector_type(4)));
typedef float f32x2e __attribute__((ext_vector_type(2)));
__device__ __forceinline__ uint4 nt_ld_u4(const void* p) { u32x4e v = __builtin_nontemporal_load((const u32x4e*)p); return make_uint4(v.x, v.y, v.z, v.w); }
__device__ __forceinline__ float4 nt_ld_f4(const void* p) { f32x4 v = __builtin_nontemporal_load((const f32x4*)p); return make_float4(v.x, v.y, v.z, v.w); }
__device__ __forceinline__ float2 nt_ld_f2(const void* p) { f32x2e v = __builtin_nontemporal_load((const f32x2e*)p); return make_float2(v.x, v.y); }
__device__ __forceinline__ void nt_st_f2(float2 v, void* p) { f32x2e t = {v.x, v.y}; __builtin_nontemporal_store(t, (f32x2e*)p); }
#define MFMA16(a, b, c) __builtin_amdgcn_mfma_f32_16x16x32_bf16(a, b, c, 0, 0, 0)
#define MFMA32(a, b, c) __builtin_amdgcn_mfma_f32_32x32x16_bf16(a, b, c, 0, 0, 0)

__device__ void transpose_fold(const float* src, const float* g, u16* dst, int ldd, int K, int N, char* smem) {
  float* tl = (float*)smem;
  const int tid = threadIdx.x;
  const int tk = K / 64, tn = N / 64;
  for (int t = blockIdx.x; t < tk * tn; t += gridDim.x) {
    int k0 = (t / tn) * 64, n0 = (t % tn) * 64;
    __syncthreads();
    for (int i = 0; i < 16; ++i) {
      int k = (tid >> 6) + i * 4, n = tid & 63;
      float v = src[(size_t)(k0 + k) * N + n0 + n];
      if (g) v *= g[k0 + k];
      tl[k * 65 + n] = v;
    }
    __syncthreads();
    for (int i = 0; i < 16; ++i) {
      int n = (tid >> 6) + i * 4, k = tid & 63;
      dst[(size_t)(n0 + n) * ldd + k0 + k] = f2bf(tl[k * 65 + n]);
    }
  }
}

__device__ void s5_prep(const Params& P, char* smem, int g) {
  float* apw = (float*)smem;
  float* bb = apw + 17 * 64 * 2;
  float* kk = bb + 64 * 16 * 2;
  const int tid = threadIdx.x;
  __syncthreads();
  if (tid < 64) {
    int pp = tid;
    float lr = P.s5_lre[g * 64 + pp], li = P.s5_lim[g * 64 + pp];
    float dt = expf(P.s5_logdt[g]);
    float mag = expf(lr * dt);
    double ang = (double)li * (double)dt;
    double kq = rint(ang * 0.15915494309189535);
    float r = (float)(ang - kq * 6.283185307179586);
    float sn = __sinf(r), cs = __cosf(r);
    {
      sn = sinf(r); cs = cosf(r);
    }
    float are = mag * cs, aim = mag * sn;
    float den = lr * lr + li * li;
    float nre = are - 1.f, nim = aim;
    float zre = (nre * lr + nim * li) / den, zim = (nim * lr - nre * li) / den;
    float pr = 1.f, pi = 0.f;
    for (int d = 0; d <= 16; ++d) {
      apw[(d * 64 + pp) * 2] = pr; apw[(d * 64 + pp) * 2 + 1] = pi;
      float nr = pr * are - pi * aim, ni = pr * aim + pi * are;
      pr = nr; pi = ni;
    }
    P.A16[(g * 64 + pp) * 2] = apw[(16 * 64 + pp) * 2];
    P.A16[(g * 64 + pp) * 2 + 1] = apw[(16 * 64 + pp) * 2 + 1];
    for (int j = 0; j < 16; ++j) {
      float br = P.s5_bre[(g * 64 + pp) * 16 + j], bi = P.s5_bim[(g * 64 + pp) * 16 + j];
      bb[(pp * 16 + j) * 2] = zre * br - zim * bi;
      bb[(pp * 16 + j) * 2 + 1] = zre * bi + zim * br;
    }
  }
  __syncthreads();
  for (int rr = 0; rr < 16; ++rr) {
    int e = tid + rr * 256;
    int d = e >> 8, i = (e >> 4) & 15, j = e & 15;
    float s = 0.f;
    for (int pp = 0; pp < 64; ++pp) {
      float cr = P.s5_cre[(g * 16 + i) * 64 + pp], ci = P.s5_cim[(g * 16 + i) * 64 + pp];
      float ar = apw[(d * 64 + pp) * 2], ai = apw[(d * 64 + pp) * 2 + 1];
      float xr = cr * ar - ci * ai, xi = cr * ai + ci * ar;
      s += xr * bb[(pp * 16 + j) * 2] - xi * bb[(pp * 16 + j) * 2 + 1];
    }
    kk[e] = s;
  }
  __syncthreads();
  u16* MFg = P.MF + (size_t)g * 256 * 384;
  for (int it = 0; it < 192; ++it) {
    int e = tid + it * 256;
    int m = e / 192, cp = (e % 192) * 2;
    int t = m >> 4, i = m & 15;
    float v[2];
    for (int q = 0; q < 2; ++q) {
      int col = cp + q;
      float val;
      if (col < 256) {
        int sg = col >> 4, j = col & 15;
        val = (sg <= t) ? kk[((t - sg) * 16 + i) * 16 + j] : 0.f;
        if (sg == t && i == j) val += P.s5_d[g * 16 + i];
      } else {
        int pc = col - 256, pp = pc & 63, im = pc >> 6;
        float cr = P.s5_cre[(g * 16 + i) * 64 + pp], ci = P.s5_cim[(g * 16 + i) * 64 + pp];
        float ar = apw[((t + 1) * 64 + pp) * 2], ai = apw[((t + 1) * 64 + pp) * 2 + 1];
        float xr = cr * ar - ci * ai, xi = cr * ai + ci * ar;
        val = im ? -xi : xr;
      }
      v[q] = val;
    }
    *(unsigned*)(MFg + (size_t)m * 384 + cp) = pack2(v[0], v[1]);
  }
  u16* Gg = P.G + (size_t)g * 128 * 256;
  for (int it = 0; it < 64; ++it) {
    int e = tid + it * 256;
    int row = e >> 7, cp = (e & 127) * 2;
    int im = row >> 6, pp = row & 63;
    float v[2];
    for (int q = 0; q < 2; ++q) {
      int col = cp + q, sg = col >> 4, j = col & 15;
      float ar = apw[((15 - sg) * 64 + pp) * 2], ai = apw[((15 - sg) * 64 + pp) * 2 + 1];
      float br = bb[(pp * 16 + j) * 2], bi = bb[(pp * 16 + j) * 2 + 1];
      v[q] = im ? (ar * bi + ai * br) : (ar * br - ai * bi);
    }
    *(unsigned*)(Gg + (size_t)row * 256 + cp) = pack2(v[0], v[1]);
  }
}

__device__ void wqk_prep(const Params& P, char* smem) {
  float* Wt = (float*)smem;
  float* Kt = Wt + 64 * 129;
  const int tid = threadIdx.x;
  for (int item = blockIdx.x; item < 512; item += gridDim.x) {
    const int hs = item >> 5, kb = (item >> 1) & 15, kh = item & 1;
    const int cbase = (hs >> 1) * 256 + (hs & 1) * 128, k0 = kb * 64;
    __syncthreads();
    for (int i = 0; i < 32; ++i) {
      const int idx = tid + i * 256, row = idx >> 7, col = idx & 127;
      Wt[row * 129 + col] = P.wq[(size_t)(k0 + row) * 2048 + cbase + col] * P.norm2_g[k0 + row];
      const int ko = kh * 64 * 128 + idx;
      Kt[idx] = (hs & 1) ? P.k2[ko] : P.k1[ko];
    }
    __syncthreads();
    const int kk = tid & 63, q = tid >> 6;
    float acc[16];
#pragma unroll
    for (int i = 0; i < 16; ++i) acc[i] = 0.f;
    for (int d = 0; d < 128; d += 4) {
      const float w0 = Wt[kk * 129 + d], w1 = Wt[kk * 129 + d + 1], w2 = Wt[kk * 129 + d + 2], w3 = Wt[kk * 129 + d + 3];
#pragma unroll
      for (int i = 0; i < 16; ++i) {
        const float4 kv = *(const float4*)(Kt + (q * 16 + i) * 128 + d);
        acc[i] += w0 * kv.x + w1 * kv.y + w2 * kv.z + w3 * kv.w;
      }
    }
#pragma unroll
    for (int i = 0; i < 16; ++i) P.WqT[(size_t)(hs * 128 + kh * 64 + q * 16 + i) * 1024 + k0 + kk] = f2bf(acc[i]);
  }
}

__device__ void phase_prep(const Params& P, char* smem) {
  const int tid = threadIdx.x, lane = tid & 63, w = tid >> 6;
  {
    int g = (int)gridDim.x - 1 - (int)blockIdx.x;
    if (g < 32) s5_prep(P, smem, g);
  }
  for (int i = blockIdx.x * 256 + tid; i < 512; i += gridDim.x * 256) { const float lam = P.lru_lambda[i]; P.spv[i] = fmaxf(-lam, 0.f) + log1pf(expf(-fabsf(lam))); }
  for (int i = blockIdx.x * 256 + tid; i < T_TOK; i += gridDim.x * 256) { P.ssa[i] = 0.f; P.ssb[i] = 0.f; P.ss2[i] = 0.f; P.ssf[i] = 0.f; }
  const bool split = gridDim.x > 64;
  const bool bulk = !split || (int)blockIdx.x < (int)gridDim.x - 32;
  const int nbulk = split ? (int)gridDim.x - 32 : (int)gridDim.x;
  if (bulk) {
    const int gwv = blockIdx.x * 4 + w, nw = nbulk * 4;
    for (int r = gwv; r < T_TOK; r += nw) {
      const float4* src = (const float4*)(P.x + (size_t)r * 1024);
      float4 v[4];
      float ss = 0.f;
#pragma unroll
      for (int i = 0; i < 4; ++i) {
        v[i] = src[i * 64 + lane];
        ss += v[i].x * v[i].x + v[i].y * v[i].y + v[i].z * v[i].z + v[i].w * v[i].w;
      }
      ss = wsum(ss);
      if (lane == 0) P.rstd1[r] = rsqrtf(ss * (1.f / 1024.f) + EPSF);
      uint2* dst = (uint2*)(P.xb + (size_t)r * 1024);
#pragma unroll
      for (int i = 0; i < 4; ++i) dst[i * 64 + lane] = make_uint2(pack2(v[i].x, v[i].y), pack2(v[i].z, v[i].w));
    }
  }
  {
    const int gwv = blockIdx.x * 4 + w, nw = nbulk * 4;
    if (bulk)
    for (int r = gwv; r < 32768; r += nw) {
      const int isv = r >> 14, e = r & 16383;
      const float* src = (isv ? P.pv : P.pu) + (size_t)e * 1024 + lane * 16;
      float4 v[4];
      float m = 0.f;
#pragma unroll
      for (int i = 0; i < 4; ++i) {
        {
          float4 t = *(const float4*)(src + i * 4);
          const float4 g2 = *(const float4*)(P.norm2_g + lane * 16 + i * 4);
          v[i] = isv ? t : make_float4(t.x * g2.x, t.y * g2.y, t.z * g2.z, t.w * g2.w);
        }
        m = fmaxf(m, fmaxf(fmaxf(fabsf(v[i].x), fabsf(v[i].y)), fmaxf(fabsf(v[i].z), fabsf(v[i].w))));
      }
#pragma unroll
      for (int o = 32; o; o >>= 1) m = fmaxf(m, __shfl_xor(m, o));
      int ex = (int)((__float_as_uint(m) >> 23) & 255u) - 127;
      ex = ex < -100 ? -100 : (ex > 100 ? 100 : ex);
      const float sc = __uint_as_float((unsigned)(127 + 7 - ex) << 23);
      const float isc = __uint_as_float((unsigned)(127 - 7 + ex) << 23);
      unsigned pk[4];
#pragma unroll
      for (int i = 0; i < 4; ++i) {
        int t = __builtin_amdgcn_cvt_pk_fp8_f32(v[i].x * sc, v[i].y * sc, 0, false);
        t = __builtin_amdgcn_cvt_pk_fp8_f32(v[i].z * sc, v[i].w * sc, t, true);
        pk[i] = (unsigned)t;
      }
      unsigned char* dst = isv ? (P.V8 + (size_t)(lane >> 3) * (16384 * 128) + (size_t)e * 128 + (lane & 7) * 16)
                               : (P.U8 + (size_t)(lane >> 3) * (16384 * 128) + (size_t)e * 128 + (lane & 7) * 16);
      *(uint4*)dst = make_uint4(pk[0], pk[1], pk[2], pk[3]);
      if (lane == 0) { if (isv) P.sv[e] = isc; else P.su[e] = isc; }
    }
    size_t gt = (size_t)blockIdx.x * 256 + tid, nt = (size_t)gridDim.x * 256;
    for (size_t i = gt; i < 4096; i += nt) {
      float4 a = ((const float4*)P.k1)[i];
      ((uint2*)P.K1b)[i] = make_uint2(pack2(a.x, a.y), pack2(a.z, a.w));
      float4 b = ((const float4*)P.k2)[i];
      ((uint2*)P.K2b)[i] = make_uint2(pack2(b.x, b.y), pack2(b.z, b.w));
    }
  }
  transpose_fold(P.w_in, P.norm1_g, P.WinT, 1024, 1024, 1536, smem);
  transpose_fold(P.glu_w, nullptr, P.GluT, 512, 512, 512, smem);
  transpose_fold(P.w_out, P.gnorm_lru, P.WoutT, 1024, 512, 1024, smem);
  transpose_fold(P.w_out + 512 * 1024, P.gnorm_s5, P.WoutT + 512, 1024, 512, 1024, smem);
  wqk_prep(P, smem);
  for (int h = 0; h < 8; ++h) {
    transpose_fold(P.lru_wa + h * 4096, nullptr, P.WaT + h * 4096, 64, 64, 64, smem);
    transpose_fold(P.lru_wx + h * 4096, nullptr, P.WxT + h * 4096, 64, 64, 64, smem);
  }
}

__device__ __forceinline__ void ce(float& hi, float& lo) {
  float a = hi, b = lo;
  asm("v_max_f32 %0, %1, %2" : "=v"(hi) : "v"(a), "v"(b));
  asm("v_min_f32 %0, %1, %2" : "=v"(lo) : "v"(a), "v"(b));
}
__device__ __forceinline__ float vmaxf(float a, float b) {
  float r;
  asm("v_max_f32 %0, %1, %2" : "=v"(r) : "v"(a), "v"(b));
  return r;
}
__device__ __forceinline__ void sort16(float (&v)[16]) {
#pragma unroll
  for (int k = 2; k <= 16; k <<= 1)
#pragma unroll
    for (int j = k >> 1; j > 0; j >>= 1)
#pragma unroll
      for (int i = 0; i < 16; ++i) {
        int l = i ^ j;
        if (l > i) {
          if ((i & k) == 0) ce(v[i], v[l]); else ce(v[l], v[i]);
        }
      }
}
__device__ __forceinline__ void bmerge16(float (&v)[16]) {
#pragma unroll
  for (int j = 8; j > 0; j >>= 1)
#pragma unroll
    for (int i = 0; i < 16; ++i) {
      int l = i ^ j;
      if (l > i) ce(v[i], v[l]);
    }
}
__device__ __forceinline__ void merge_top16(float (&x)[16], const float (&y)[16]) {
#pragma unroll
  for (int i = 0; i < 16; ++i) x[i] = vmaxf(x[i], y[15 - i]);
  bmerge16(x);
}

enum { EPI_INPROJ = 0, EPI_GLU = 1, EPI_OUT = 2, EPI_Q = 3 };
#define LDT 64

template <int EPI>
__device__ void gemm_phase(const Params& P, char* smem, const u16* __restrict__ A, const u16* __restrict__ Bt,
                           int M, int N, int K) {
  constexpr int TE = 128 * LDT;
  u16* AsB = (u16*)smem;
  u16* BsB = AsB + 2 * TE;
  const int tid = threadIdx.x, lane = tid & 63, w = tid >> 6, wm = w >> 1, wn = w & 1;
  const int l15 = lane & 15, lq = lane >> 4;
  const int NT = N / 128, MT = M / 128, ntiles = MT * NT, nk = K / 64;
  int vb = blockIdx.x;
  if ((gridDim.x & 7) == 0) vb = (blockIdx.x & 7) * (gridDim.x >> 3) + (blockIdx.x >> 3);
  const int ldr = tid >> 3, ldc = (tid & 7) * 8;
  const int ldsw = ((tid & 7) ^ ((ldr >> 1) & 7)) * 8;
  const int rsw = (l15 >> 1) & 7;
  const int cnt = (vb < ntiles) ? (ntiles - vb + (int)gridDim.x - 1) / (int)gridDim.x : 0;
  const int total = cnt * nk;
  if (total == 0) return;
  f32x4 acc[4][4];
#pragma unroll
  for (int i = 0; i < 4; ++i)
#pragma unroll
    for (int j = 0; j < 4; ++j) acc[i][j] = (f32x4){0.f, 0.f, 0.f, 0.f};
  uint4 pa0, pa1, pa2, pa3, pb0, pb1, pb2, pb3, qa0, qa1, qa2, qa3, qb0, qb1, qb2, qb3;
  const u16 *Ag, *Bg;
#define STEP_ADDR(st) { int st_ = (st) < total ? (st) : total - 1; int ti_ = st_ / nk, kk_ = st_ - ti_ * nk; \
      int tl_ = vb + ti_ * (int)gridDim.x; int r0_ = (tl_ / NT) * 128, c0_ = (tl_ % NT) * 128; \
      { const int hm_ = (nk >> 1) - 1; kk_ = (kk_ & ~hm_) | ((kk_ + (tl_ % NT) + (tl_ / NT)) & hm_); } \
      Ag = A + (size_t)(r0_ + ldr) * K + ldc + kk_ * 64; Bg = Bt + (size_t)(c0_ + ldr) * K + ldc + kk_ * 64; }
#define GLD2(S, i) { S##a##i = *(const uint4*)(Ag + (size_t)(32 * i) * K); S##b##i = *(const uint4*)(Bg + (size_t)(32 * i) * K); }
#define GLDS(S, st) { STEP_ADDR(st) GLD2(S, 0) GLD2(S, 1) GLD2(S, 2) GLD2(S, 3) }
#define LST2(S, i, buf) { *(uint4*)(AsB + (buf) * TE + (ldr + 32 * i) * LDT + ldsw) = S##a##i; \
                          *(uint4*)(BsB + (buf) * TE + (ldr + 32 * i) * LDT + ldsw) = S##b##i; }
#define LSTS(S, buf) { LST2(S, 0, buf) LST2(S, 1, buf) LST2(S, 2, buf) LST2(S, 3, buf) }
#define COMPUTE(buf) { \
      const u16* As_ = AsB + (buf) * TE; const u16* Bs_ = BsB + (buf) * TE; \
      _Pragma("unroll") for (int ks = 0; ks < 2; ++ks) { \
        bf16x8 af[4], bfr[4]; \
        _Pragma("unroll") for (int mt = 0; mt < 4; ++mt) \
          af[mt] = *(const bf16x8*)(As_ + (wm * 64 + mt * 16 + l15) * LDT + (((ks * 4 + lq) ^ rsw) * 8)); \
        _Pragma("unroll") for (int nt = 0; nt < 4; ++nt) \
          bfr[nt] = *(const bf16x8*)(Bs_ + (wn * 64 + nt * 16 + l15) * LDT + (((ks * 4 + lq) ^ rsw) * 8)); \
        _Pragma("unroll") for (int mt = 0; mt < 4; ++mt) \
          _Pragma("unroll") for (int nt = 0; nt < 4; ++nt) acc[mt][nt] = MFMA16(bfr[nt], af[mt], acc[mt][nt]); \
      } }
#define RESCALE() { if (EPI == EPI_OUT) { \
      _Pragma("unroll") for (int mt = 0; mt < 4; ++mt) { \
        const int row = row0 + wm * 64 + mt * 16 + l15; \
        const float ra_ = rsqrtf(P.ssa[row] * (1.f / 512.f) + EPSF), rb_ = rsqrtf(P.ssb[row] * (1.f / 512.f) + EPSF); \
        const float ratio = ra_ / rb_; \
        _Pragma("unroll") for (int nt = 0; nt < 4; ++nt) acc[mt][nt] *= ratio; } } }
  __syncthreads();
  GLDS(p, 0)
  __builtin_amdgcn_sched_barrier(0);
  GLDS(q, 1)
  __builtin_amdgcn_sched_barrier(0);
  LSTS(p, 0)
  GLDS(p, 2)
  __builtin_amdgcn_sched_barrier(0);
  for (int st = 0; st < total; st += 2) {
    const int ti = st / nk, kt = st - ti * nk;
    const int tile = vb + ti * (int)gridDim.x;
    const int row0 = (tile / NT) * 128, col0 = (tile % NT) * 128;
    __syncthreads();
    LSTS(q, 1)
    GLDS(q, st + 3)
    __builtin_amdgcn_sched_barrier(0);
    if (kt == nk / 2) RESCALE()
    COMPUTE(0)
    __syncthreads();
    LSTS(p, 0)
    GLDS(p, st + 4)
    __builtin_amdgcn_sched_barrier(0);
    COMPUTE(1)
    if (kt + 2 < nk) continue;
    if (EPI == EPI_Q) {
      float* xch = (float*)(smem + 65536);
      float lst[4][16];
#pragma unroll
      for (int mt = 0; mt < 4; ++mt) {
        const int lr = wm * 64 + mt * 16 + l15;
        const float sc = rsqrtf(P.ss2[row0 + lr] * (1.f / 1024.f) + EPSF);
#pragma unroll
        for (int nt = 0; nt < 4; ++nt)
#pragma unroll
          for (int j = 0; j < 4; ++j) {
            const unsigned kidx = (unsigned)(wn * 64 + nt * 16 + lq * 4 + j);
            lst[mt][nt * 4 + j] = __uint_as_float((__float_as_uint(acc[mt][nt][j] * sc) & 0xffffff80u) | kidx);
          }
#pragma unroll
        for (int nt = 0; nt < 4; ++nt) acc[mt][nt] = (f32x4){0.f, 0.f, 0.f, 0.f};
        sort16(lst[mt]);
        float y[16];
#pragma unroll
        for (int i = 0; i < 16; ++i) y[i] = __shfl_xor(lst[mt][i], 16);
        merge_top16(lst[mt], y);
#pragma unroll
        for (int i = 0; i < 16; ++i) y[i] = __shfl_xor(lst[mt][i], 32);
        merge_top16(lst[mt], y);
      }
      if (wn == 1 && lq == 0) {
#pragma unroll
        for (int mt = 0; mt < 4; ++mt) {
          float4* d4 = (float4*)(xch + (wm * 64 + mt * 16 + l15) * 16);
#pragma unroll
          for (int i = 0; i < 4; ++i) d4[i] = make_float4(lst[mt][i * 4], lst[mt][i * 4 + 1], lst[mt][i * 4 + 2], lst[mt][i * 4 + 3]);
        }
      }
      __syncthreads();
      if (wn == 0) {
        const int hs = col0 >> 7;
#pragma unroll
        for (int mt = 0; mt < 4; ++mt) {
          const int lr = wm * 64 + mt * 16 + l15;
          const float4* s4 = (const float4*)(xch + lr * 16);
          float y[16];
#pragma unroll
          for (int i = 0; i < 4; ++i) { const float4 t = s4[i]; y[i * 4] = t.x; y[i * 4 + 1] = t.y; y[i * 4 + 2] = t.z; y[i * 4 + 3] = t.w; }
          merge_top16(lst[mt], y);
          if (lq == 0) {
            float4* d4 = (float4*)(P.t16 + ((size_t)(row0 + lr) * 16 + hs) * 16);
#pragma unroll
            for (int i = 0; i < 4; ++i) d4[i] = make_float4(lst[mt][i * 4], lst[mt][i * 4 + 1], lst[mt][i * 4 + 2], lst[mt][i * 4 + 3]);
          }
        }
      }
      continue;
    }
#pragma unroll
    for (int mt = 0; mt < 4; ++mt) {
      const int lr = wm * 64 + mt * 16 + l15;
      const size_t row = (size_t)(row0 + lr);
      float sc = 1.f;
      if (EPI == EPI_INPROJ) sc = P.rstd1[row];
      if (EPI == EPI_OUT) sc = rsqrtf(P.ssb[row] * (1.f / 512.f) + EPSF);
      if (EPI == EPI_Q) sc = rsqrtf(P.ss2[row] * (1.f / 1024.f) + EPSF);
      float sq = 0.f;
#pragma unroll
      for (int nt = 0; nt < 4; ++nt) {
        const int col = col0 + wn * 64 + nt * 16 + lq * 4;
        f32x4 v = acc[mt][nt];
        if (EPI == EPI_INPROJ) {
          *(uint2*)(P.p + row * 1536 + col) = make_uint2(pack2(v[0] * sc, v[1] * sc), pack2(v[2] * sc, v[3] * sc));
        } else if (EPI == EPI_GLU) {
          uint2 gg = *(const uint2*)(P.gs5 + row * 512 + col);
          float4 gb = *(const float4*)(P.glu_b + col);
          float g0 = bflo(gg.x), g1 = bfhi(gg.x), g2 = bflo(gg.y), g3 = bfhi(gg.y);
          float o0 = g0 * sigmoid_(v[0] + gb.x), o1 = g1 * sigmoid_(v[1] + gb.y);
          float o2 = g2 * sigmoid_(v[2] + gb.z), o3 = g3 * sigmoid_(v[3] + gb.w);
          sq += o0 * o0 + o1 * o1 + o2 * o2 + o3 * o3;
          *(uint2*)(P.ycat + row * 1024 + 512 + col) = make_uint2(pack2(o0, o1), pack2(o2, o3));
        } else {
          float4 xv = *(const float4*)(P.x + row * 1024 + col);
          float4 h = make_float4(xv.x + v[0] * sc, xv.y + v[1] * sc, xv.z + v[2] * sc, xv.w + v[3] * sc);
          sq += h.x * h.x + h.y * h.y + h.z * h.z + h.w * h.w;
          *(float4*)(P.out + row * 1024 + col) = h;
          *(uint2*)(P.hb + row * 1024 + col) = make_uint2(pack2(h.x, h.y), pack2(h.z, h.w));
        }
      }
      if (EPI == EPI_GLU || EPI == EPI_OUT) {
        sq += __shfl_xor(sq, 16);
        sq += __shfl_xor(sq, 32);
        if (lq == 0) atomicAdd((EPI == EPI_GLU ? P.ssb : P.ss2) + row, sq);
      }
#pragma unroll
      for (int nt = 0; nt < 4; ++nt) acc[mt][nt] = (f32x4){0.f, 0.f, 0.f, 0.f};
    }
  }
}

template <int EPI>
__device__ void gemm256_phase(const Params& P, char* smem, const u16* __restrict__ A, const u16* __restrict__ Bt,
                              int M, int N, int K) {
  u16* As = (u16*)smem;
  u16* Bs = As + 256 * 64;
  const int tid = threadIdx.x, lane = tid & 63, w = tid >> 6, wm = w >> 1, wn = w & 1;
  const int l15 = lane & 15, lq = lane >> 4;
  const int NT = N / 128, MT = M / 256, ntiles = MT * NT, nk = K / 64;
  int vb = blockIdx.x;
  if ((gridDim.x & 7) == 0) vb = (blockIdx.x & 7) * (gridDim.x >> 3) + (blockIdx.x >> 3);
  const int ldr = tid >> 3, ldc = (tid & 7) * 8;
  const int ldsw = ((tid & 7) ^ ((ldr >> 1) & 7)) * 8;
  const int rsw = (l15 >> 1) & 7;
  const int cnt = (vb < ntiles) ? (ntiles - vb + (int)gridDim.x - 1) / (int)gridDim.x : 0;
  const int total = cnt * nk;
  if (total == 0) return;
  f32x4 acc[8][4];
#pragma unroll
  for (int i = 0; i < 8; ++i)
#pragma unroll
    for (int j = 0; j < 4; ++j) acc[i][j] = (f32x4){0.f, 0.f, 0.f, 0.f};
  uint4 ga0, ga1, ga2, ga3, ga4, ga5, ga6, ga7, gb0, gb1, gb2, gb3;
  const u16 *Ag, *Bg;
#define G2_ADDR(st) { int st_ = (st) < total ? (st) : total - 1; int ti_ = st_ / nk, kk_ = st_ - ti_ * nk; \
      int tl_ = vb + ti_ * (int)gridDim.x; int r0_ = (tl_ / NT) * 256, c0_ = (tl_ % NT) * 128; \
      Ag = A + (size_t)(r0_ + ldr) * K + ldc + kk_ * 64; Bg = Bt + (size_t)(c0_ + ldr) * K + ldc + kk_ * 64; }
#define G2_LDA(i) ga##i = *(const uint4*)(Ag + (size_t)(32 * i) * K);
#define G2_LDB(i) gb##i = *(const uint4*)(Bg + (size_t)(32 * i) * K);
#define G2_GLD(st) { G2_ADDR(st) G2_LDA(0) G2_LDA(1) G2_LDA(2) G2_LDA(3) G2_LDA(4) G2_LDA(5) G2_LDA(6) G2_LDA(7) G2_LDB(0) G2_LDB(1) G2_LDB(2) G2_LDB(3) }
#define G2_STA(i) *(uint4*)(As + (ldr + 32 * i) * 64 + ldsw) = ga##i;
#define G2_STB(i) *(uint4*)(Bs + (ldr + 32 * i) * 64 + ldsw) = gb##i;
#define G2_LST() { G2_STA(0) G2_STA(1) G2_STA(2) G2_STA(3) G2_STA(4) G2_STA(5) G2_STA(6) G2_STA(7) G2_STB(0) G2_STB(1) G2_STB(2) G2_STB(3) }
  G2_GLD(0)
  for (int st = 0; st < total; ++st) {
    const int ti = st / nk, kt = st - ti * nk;
    const int tile = vb + ti * (int)gridDim.x;
    const int row0 = (tile / NT) * 256, col0 = (tile % NT) * 128;
    __syncthreads();
    G2_LST()
    G2_GLD(st + 1)
    __builtin_amdgcn_sched_barrier(0);
    __syncthreads();
    if (EPI == EPI_OUT && kt == nk / 2) {
#pragma unroll
      for (int mt = 0; mt < 8; ++mt) {
        const int row = row0 + wm * 128 + mt * 16 + l15;
        const float ra_ = rsqrtf(P.ssa[row] * (1.f / 512.f) + EPSF), rb_ = rsqrtf(P.ssb[row] * (1.f / 512.f) + EPSF);
        const float ratio = ra_ / rb_;
#pragma unroll
        for (int nt = 0; nt < 4; ++nt) acc[mt][nt] *= ratio;
      }
    }
#pragma unroll
    for (int ks = 0; ks < 2; ++ks) {
      bf16x8 bfr[4];
#pragma unroll
      for (int nt = 0; nt < 4; ++nt)
        bfr[nt] = *(const bf16x8*)(Bs + (wn * 64 + nt * 16 + l15) * 64 + (((ks * 4 + lq) ^ rsw) * 8));
#pragma unroll
      for (int hh = 0; hh < 2; ++hh) {
        bf16x8 af[4];
#pragma unroll
        for (int m = 0; m < 4; ++m)
          af[m] = *(const bf16x8*)(As + (wm * 128 + (hh * 4 + m) * 16 + l15) * 64 + (((ks * 4 + lq) ^ rsw) * 8));
#pragma unroll
        for (int m = 0; m < 4; ++m)
#pragma unroll
          for (int nt = 0; nt < 4; ++nt) acc[hh * 4 + m][nt] = MFMA16(bfr[nt], af[m], acc[hh * 4 + m][nt]);
      }
    }
    if (kt + 1 < nk) continue;
#pragma unroll
    for (int mt = 0; mt < 8; ++mt) {
      const int lr = wm * 128 + mt * 16 + l15;
      const size_t row = (size_t)(row0 + lr);
      float sc = 1.f;
      if (EPI == EPI_INPROJ) sc = P.rstd1[row];
      if (EPI == EPI_OUT) sc = rsqrtf(P.ssb[row] * (1.f / 512.f) + EPSF);
      float sq = 0.f;
#pragma unroll
      for (int nt = 0; nt < 4; ++nt) {
        const int col = col0 + wn * 64 + nt * 16 + lq * 4;
        f32x4 v = acc[mt][nt];
        if (EPI == EPI_INPROJ) {
          *(uint2*)(P.p + row * 1536 + col) = make_uint2(pack2(v[0] * sc, v[1] * sc), pack2(v[2] * sc, v[3] * sc));
        } else if (EPI == EPI_GLU) {
          uint2 gg = *(const uint2*)(P.gs5 + row * 512 + col);
          float4 gb = *(const float4*)(P.glu_b + col);
          float g0 = bflo(gg.x), g1 = bfhi(gg.x), g2 = bflo(gg.y), g3 = bfhi(gg.y);
          float o0 = g0 * sigmoid_(v[0] + gb.x), o1 = g1 * sigmoid_(v[1] + gb.y);
          float o2 = g2 * sigmoid_(v[2] + gb.z), o3 = g3 * sigmoid_(v[3] + gb.w);
          sq += o0 * o0 + o1 * o1 + o2 * o2 + o3 * o3;
          *(uint2*)(P.ycat + row * 1024 + 512 + col) = make_uint2(pack2(o0, o1), pack2(o2, o3));
        } else {
          float4 xv = *(const float4*)(P.x + row * 1024 + col);
          float4 h = make_float4(xv.x + v[0] * sc, xv.y + v[1] * sc, xv.z + v[2] * sc, xv.w + v[3] * sc);
          sq += h.x * h.x + h.y * h.y + h.z * h.z + h.w * h.w;
          *(float4*)(P.out + row * 1024 + col) = h;
          *(uint2*)(P.hb + row * 1024 + col) = make_uint2(pack2(h.x, h.y), pack2(h.z, h.w));
        }
        acc[mt][nt] = (f32x4){0.f, 0.f, 0.f, 0.f};
      }
      if (EPI == EPI_GLU || EPI == EPI_OUT) {
        sq += __shfl_xor(sq, 16);
        sq += __shfl_xor(sq, 32);
        if (lq == 0) atomicAdd((EPI == EPI_GLU ? P.ssb : P.ss2) + row, sq);
      }
    }
  }
}

__device__ __forceinline__ float one_minus_exp(float x) {
  const float ser = -x * (1.f + x * (0.5f + x * (0.16666667f + x * (0.041666668f + x * (0.0083333338f + x * 0.0013888889f)))));
  return (x > -0.5f) ? ser : (1.f - __expf(x));
}

template <bool FINAL>
__device__ void lru_phase(const Params& P, char* smem) {
  float* xcs = (float*)smem;
  float* a_s = xcs + 64 * 65;
  float* segA = a_s + 64 * 65;
  float* segH = segA + 256;
  const int tid = threadIdx.x, lane = tid & 63, w = tid >> 6;
  const int l15 = lane & 15, lq = lane >> 4;
  for (int item = blockIdx.x; item < 8192; item += gridDim.x) {
    const int head = item & 7, tile = (item >> 3) & 31, b = item >> 8;
    const int c0 = head * 64, t0 = tile * 64;
    __syncthreads();
    if (!FINAL) {
      bf16x8 af[2];
      {
        const int tl = w * 16 + l15;
        const int t = t0 + tl;
        const u16* prow = P.p + ((size_t)(b * 2048 + t)) * 1536 + c0;
#pragma unroll
        for (int ks = 0; ks < 2; ++ks) {
          const int ch = ks * 32 + lq * 8;
          float xc[8];
          {
            float4 b0 = *(const float4*)(P.conv_b + c0 + ch), b1 = *(const float4*)(P.conv_b + c0 + ch + 4);
            xc[0] = b0.x; xc[1] = b0.y; xc[2] = b0.z; xc[3] = b0.w; xc[4] = b1.x; xc[5] = b1.y; xc[6] = b1.z; xc[7] = b1.w;
          }
#pragma unroll
          for (int k = 0; k < 4; ++k) {
            if (t - 3 + k >= 0) {
              uint4 v = *(const uint4*)(prow + (k - 3) * 1536 + ch);
              float4 w0 = *(const float4*)(P.conv_w + k * 512 + c0 + ch), w1 = *(const float4*)(P.conv_w + k * 512 + c0 + ch + 4);
              xc[0] += w0.x * bflo(v.x); xc[1] += w0.y * bfhi(v.x); xc[2] += w0.z * bflo(v.y); xc[3] += w0.w * bfhi(v.y);
              xc[4] += w1.x * bflo(v.z); xc[5] += w1.y * bfhi(v.z); xc[6] += w1.z * bflo(v.w); xc[7] += w1.w * bfhi(v.w);
            }
          }
#pragma unroll
          for (int i = 0; i < 8; ++i) xcs[tl * 65 + ch + i] = xc[i];
          unsigned p0 = pack2(xc[0], xc[1]), p1 = pack2(xc[2], xc[3]), p2 = pack2(xc[4], xc[5]), p3 = pack2(xc[6], xc[7]);
          uint4 pk = make_uint4(p0, p1, p2, p3);
          af[ks] = *(bf16x8*)&pk;
        }
      }
      f32x4 accr[4], acci[4];
#pragma unroll
      for (int nt = 0; nt < 4; ++nt) {
        accr[nt] = (f32x4){0.f, 0.f, 0.f, 0.f};
        acci[nt] = (f32x4){0.f, 0.f, 0.f, 0.f};
#pragma unroll
        for (int ks = 0; ks < 2; ++ks) {
          bf16x8 ba = *(const bf16x8*)(P.WaT + head * 4096 + (nt * 16 + l15) * 64 + ks * 32 + lq * 8);
          bf16x8 bx = *(const bf16x8*)(P.WxT + head * 4096 + (nt * 16 + l15) * 64 + ks * 32 + lq * 8);
          accr[nt] = MFMA16(af[ks], ba, accr[nt]);
          acci[nt] = MFMA16(af[ks], bx, acci[nt]);
        }
      }
      __syncthreads();
#pragma unroll
      for (int nt = 0; nt < 4; ++nt) {
        const int ch = nt * 16 + l15;
        const float ba = P.lru_ba[c0 + ch], bx = P.lru_bx[c0 + ch], sp = P.spv[c0 + ch];
#pragma unroll
        for (int r = 0; r < 4; ++r) {
          const int tl = w * 16 + lq * 4 + r;
          float xf = xcs[tl * 65 + ch];
          float rr = sigmoid_(accr[nt][r] + ba), ig = sigmoid_(acci[nt][r] + bx);
          float la = -8.f * rr * sp;
          const float oma = one_minus_exp(la);
          const float om2 = one_minus_exp(2.f * la);
          float u = __builtin_amdgcn_sqrtf(om2) * ig * xf;
          a_s[tl * 65 + ch] = __uint_as_float((unsigned)f2bf(oma) | ((unsigned)f2bf(u) << 16));
        }
      }
      __syncthreads();
    }
    {
      const int ch = tid & 63, seg = tid >> 6;
      const size_t tok0 = (size_t)(b * 2048 + t0 + seg * 16);
      unsigned pk[16];
#pragma unroll
      for (int s = 0; s < 16; ++s) {
        if (!FINAL) {
          pk[s] = __float_as_uint(a_s[(seg * 16 + s) * 65 + ch]);
          P.au[(tok0 + s) * 512 + c0 + ch] = pk[s];
        } else {
          pk[s] = P.au[(tok0 + s) * 512 + c0 + ch];
        }
      }
      float Ap = 1.f, Hl = 0.f;
#pragma unroll
      for (int s = 0; s < 16; ++s) {
        const float a = 1.f - bflo(pk[s]), u = bfhi(pk[s]);
        Hl = a * Hl + u;
        Ap *= a;
      }
      segA[seg * 64 + ch] = Ap;
      segH[seg * 64 + ch] = Hl;
      __syncthreads();
      if (!FINAL) {
        if (seg == 0) {
          float Aa = 1.f, Hh = 0.f;
#pragma unroll
          for (int s = 0; s < 4; ++s) {
            Hh = segA[s * 64 + ch] * Hh + segH[s * 64 + ch];
            Aa *= segA[s * 64 + ch];
          }
          P.Acar[(b * 32 + tile) * 512 + c0 + ch] = Aa;
          P.Hcar[(b * 32 + tile) * 512 + c0 + ch] = Hh;
        }
      } else {
        float gate[16];
#pragma unroll
        for (int s = 0; s < 16; ++s) gate[s] = bf2f(P.p[(tok0 + s) * 1536 + 512 + c0 + ch]);
        float h = P.Hin[(b * 32 + tile) * 512 + c0 + ch];
#pragma unroll
        for (int s = 0; s < 3; ++s)
          if (s < seg) h = segA[s * 64 + ch] * h + segH[s * 64 + ch];
        float sqv[16];
#pragma unroll
        for (int s = 0; s < 16; ++s) {
          h = (1.f - bflo(pk[s])) * h + bfhi(pk[s]);
          const float yv = h * gelu_(gate[s]);
          sqv[s] = yv * yv;
          P.ycat[(tok0 + s) * 1024 + c0 + ch] = f2bf(yv);
        }
        {
          const bool hb = (lane & 32) != 0, b4 = (lane & 16) != 0, b3 = (lane & 8) != 0, b2 = (lane & 4) != 0;
#pragma unroll
          for (int i = 0; i < 8; ++i) { float sd = hb ? sqv[i] : sqv[i + 8], kp = hb ? sqv[i + 8] : sqv[i]; sqv[i] = kp + __shfl_xor(sd, 32); }
#pragma unroll
          for (int i = 0; i < 4; ++i) { float sd = b4 ? sqv[i] : sqv[i + 4], kp = b4 ? sqv[i + 4] : sqv[i]; sqv[i] = kp + __shfl_xor(sd, 16); }
#pragma unroll
          for (int i = 0; i < 2; ++i) { float sd = b3 ? sqv[i] : sqv[i + 2], kp = b3 ? sqv[i + 2] : sqv[i]; sqv[i] = kp + __shfl_xor(sd, 8); }
          { float sd = b2 ? sqv[0] : sqv[1], kp = b2 ? sqv[1] : sqv[0]; sqv[0] = kp + __shfl_xor(sd, 4); }
          sqv[0] += __shfl_xor(sqv[0], 2);
          sqv[0] += __shfl_xor(sqv[0], 1);
          if ((lane & 3) == 0) atomicAdd(P.ssa + tok0 + (lane >> 2), sqv[0]);
        }
      }
    }
  }
}

__device__ void carry_phase(const Params& P) {
  const int gt = blockIdx.x * 256 + threadIdx.x, nth = gridDim.x * 256;
  for (int i = gt; i < 16384 + 65536; i += nth) {
    if (i < 16384) {
      const int b = i >> 9, ch = i & 511;
      float h = 0.f;
      for (int t0 = 0; t0 < 32; t0 += 8) {
        float a[8], hh[8];
#pragma unroll
        for (int j = 0; j < 8; ++j) {
          a[j] = P.Acar[(b * 32 + t0 + j) * 512 + ch];
          hh[j] = P.Hcar[(b * 32 + t0 + j) * 512 + ch];
        }
#pragma unroll
        for (int j = 0; j < 8; ++j) {
          P.Hin[(b * 32 + t0 + j) * 512 + ch] = h;
          h = a[j] * h + hh[j];
        }
      }
    } else {
      const int k = i - 16384;
      const int pp = k & 63, g = (k >> 6) & 31, b = k >> 11;
      const float ar = P.A16[(g * 64 + pp) * 2], ai = P.A16[(g * 64 + pp) * 2 + 1];
      float hr = 0.f, hi = 0.f;
      for (int c0 = 0; c0 < 128; c0 += 8) {
        float er[8], ei[8];
#pragma unroll
        for (int j = 0; j < 8; ++j) {
          size_t base = ((size_t)(b * 128 + c0 + j) * 32 + g) * 128;
          er[j] = P.E[base + pp];
          ei[j] = P.E[base + 64 + pp];
        }
#pragma unroll
        for (int j = 0; j < 8; ++j) {
          size_t base = ((size_t)(b * 128 + c0 + j) * 32 + g) * 128;
          P.Hs[base + pp] = f2bf(hr);
          P.Hs[base + 64 + pp] = f2bf(hi);
          float nr = ar * hr - ai * hi + er[j], ni = ar * hi + ai * hr + ei[j];
          hr = nr; hi = ni;
        }
      }
    }
  }
}

template <bool YPH>
__device__ void s5_phase(const Params& P) {
  constexpr int MTW = YPH ? 4 : 2;
  const int tid = threadIdx.x, lane = tid & 63, w = tid >> 6;
  const int l15 = lane & 15, lq = lane >> 4;
  for (int item = blockIdx.x; item < 2048; item += gridDim.x) {
    const int g = ((item & 7) << 2) | ((item >> 3) & 3), cb = item >> 5;
    f32x4 acc[MTW][4];
#pragma unroll
    for (int i = 0; i < MTW; ++i)
#pragma unroll
      for (int j = 0; j < 4; ++j) acc[i][j] = (f32x4){0.f, 0.f, 0.f, 0.f};
    const u16* Am = YPH ? (P.MF + (size_t)g * 256 * 384) : (P.G + (size_t)g * 128 * 256);
    constexpr int LD = YPH ? 384 : 256;
    for (int ks = 0; ks < 8; ++ks) {
      bf16x8 bu[4];
#pragma unroll
      for (int nt = 0; nt < 4; ++nt) {
        const int Ncol = cb * 64 + nt * 16 + l15;
        const int b = Ncol >> 7, c = Ncol & 127;
        const int tau = ks * 2 + (lq >> 1), j0 = (lq & 1) * 8;
        bu[nt] = *(const bf16x8*)(P.p + ((size_t)(b * 2048 + c * 16 + tau)) * 1536 + 1024 + g * 16 + j0);
      }
#pragma unroll
      for (int mt = 0; mt < MTW; ++mt) {
        const int m = (w * MTW + mt) * 16 + l15;
        bf16x8 a = *(const bf16x8*)(Am + (size_t)m * LD + ks * 32 + lq * 8);
#pragma unroll
        for (int nt = 0; nt < 4; ++nt) acc[mt][nt] = MFMA16(a, bu[nt], acc[mt][nt]);
      }
    }
    if (YPH) {
      for (int ks = 0; ks < 4; ++ks) {
        bf16x8 bh[4];
#pragma unroll
        for (int nt = 0; nt < 4; ++nt) {
          const int Ncol = cb * 64 + nt * 16 + l15;
          bh[nt] = *(const bf16x8*)(P.Hs + ((size_t)Ncol * 32 + g) * 128 + ks * 32 + lq * 8);
        }
#pragma unroll
        for (int mt = 0; mt < MTW; ++mt) {
          const int m = (w * MTW + mt) * 16 + l15;
          bf16x8 a = *(const bf16x8*)(Am + (size_t)m * LD + 256 + ks * 32 + lq * 8);
#pragma unroll
          for (int nt = 0; nt < 4; ++nt) acc[mt][nt] = MFMA16(a, bh[nt], acc[mt][nt]);
        }
      }
    }
#pragma unroll
    for (int mt = 0; mt < MTW; ++mt)
#pragma unroll
      for (int nt = 0; nt < 4; ++nt) {
        const int Ncol = cb * 64 + nt * 16 + l15;
        f32x4 v = acc[mt][nt];
        if (!YPH) {
          const int m0 = (w * MTW + mt) * 16 + lq * 4;
          *(float4*)(P.E + ((size_t)Ncol * 32 + g) * 128 + m0) = make_float4(v[0], v[1], v[2], v[3]);
        } else {
          const int b = Ncol >> 7, c = Ncol & 127;
          const int tloc = w * MTW + mt;
          const size_t tok = (size_t)(b * 2048 + c * 16 + tloc);
          *(uint2*)(P.gs5 + tok * 512 + g * 16 + lq * 4) =
              make_uint2(pack2(gelu_(v[0]), gelu_(v[1])), pack2(gelu_(v[2]), gelu_(v[3])));
        }
      }
  }
}

__device__ __forceinline__ void top16_of_64(f32x16 (&acc)[4], int half, float (&res)[16]) {
  float g[4][16];
#pragma unroll
  for (int mt = 0; mt < 4; ++mt) {
#pragma unroll
    for (int i = 0; i < 16; ++i) {
      unsigned idx = mt * 32 + (i >> 2) * 8 + (i & 3);
      unsigned bits = (__float_as_uint(acc[mt][i]) & 0xffffff80u) | idx | (unsigned)(half * 4);
      g[mt][i] = __uint_as_float(bits);
    }
    sort16(g[mt]);
  }
  merge_top16(g[0], g[1]);
  merge_top16(g[2], g[3]);
  merge_top16(g[0], g[2]);
  float y[16];
#pragma unroll
  for (int i = 0; i < 16; ++i) y[i] = __shfl_xor(g[0][i], 32);
  merge_top16(g[0], y);
#pragma unroll
  for (int i = 0; i < 16; ++i) res[i] = g[0][i];
}
__host__ __device__ constexpr int cand_off(int i) {
  int s = 0;
  for (int q = 0; q < i; ++q) s += 16 / (q + 1);
  return s;
}

__device__ void cand_phase(const Params& P, char* smem) {
  const int tid = threadIdx.x;
  unsigned char* lut = (unsigned char*)smem + tid * 36;
  for (int gi = blockIdx.x * 256 + tid; gi < T_TOK * 8; gi += gridDim.x * 256) {
    const size_t tok = (size_t)(gi >> 3);
    const int head = gi & 7;
    float a[16], bl[16];
    {
      const float4* src = (const float4*)(P.t16 + (size_t)gi * 32);
#pragma unroll
      for (int i = 0; i < 4; ++i) {
        const float4 t = src[i], u = src[4 + i];
        a[i * 4] = t.x; a[i * 4 + 1] = t.y; a[i * 4 + 2] = t.z; a[i * 4 + 3] = t.w;
        bl[i * 4] = u.x; bl[i * 4 + 1] = u.y; bl[i * 4 + 2] = u.z; bl[i * 4 + 3] = u.w;
      }
    }
    float va[16], vb[16];
#pragma unroll
    for (int i = 0; i < 16; ++i) {
      va[i] = __uint_as_float(__float_as_uint(a[i]) & 0xffffff80u);
      vb[i] = __uint_as_float(__float_as_uint(bl[i]) & 0xffffff80u);
    }
    float cg4[4][16];
#pragma unroll
    for (int i = 0; i < 4; ++i)
#pragma unroll
      for (int j = 0; j < 16; ++j) cg4[i][j] = __uint_as_float(0xff800000u);
#pragma unroll
    for (int i = 0; i < 16; ++i)
#pragma unroll
      for (int j = 0; j < 16; ++j)
        if ((i + 1) * (j + 1) <= 16) {
          const int pos = cand_off(i) + j;
          float sm = va[i] + vb[j];
          cg4[pos >> 4][pos & 15] = __uint_as_float((__float_as_uint(sm) & 0xffffff00u) | (unsigned)(i * 16 + j));
        }
#pragma unroll
    for (int i = 0; i < 4; ++i) sort16(cg4[i]);
    merge_top16(cg4[0], cg4[1]);
    merge_top16(cg4[2], cg4[3]);
    merge_top16(cg4[0], cg4[2]);
    {
      unsigned* lw = (unsigned*)lut;
#pragma unroll
      for (int i = 0; i < 4; ++i) {
        lw[i] = (__float_as_uint(a[i * 4]) & 127u) | ((__float_as_uint(a[i * 4 + 1]) & 127u) << 8) |
                ((__float_as_uint(a[i * 4 + 2]) & 127u) << 16) | ((__float_as_uint(a[i * 4 + 3]) & 127u) << 24);
        lw[4 + i] = (__float_as_uint(bl[i * 4]) & 127u) | ((__float_as_uint(bl[i * 4 + 1]) & 127u) << 8) |
                    ((__float_as_uint(bl[i * 4 + 2]) & 127u) << 16) | ((__float_as_uint(bl[i * 4 + 3]) & 127u) << 24);
      }
    }
    float sc[16];
    int ee[16];
    const float mx = __uint_as_float(__float_as_uint(cg4[0][0]) & 0xffffff00u);
    float ssum = 0.f;
#pragma unroll
    for (int k = 0; k < 16; ++k) {
      unsigned bits = __float_as_uint(cg4[0][k]);
      unsigned code = bits & 255u;
      float v = __uint_as_float(bits & 0xffffff00u);
      sc[k] = __expf(v - mx);
      ssum += sc[k];
      int i1 = lut[code >> 4], i2 = lut[16 + (code & 15u)];
      ee[k] = i1 * 128 + i2;
    }
    const float inv = 1.f / ssum;
    int4* de = (int4*)(P.eidx + tok * 128 + head * 16);
    float4* ds = (float4*)(P.suv + tok * 128 + head * 16);
    float4* dg = (float4*)(P.gw + tok * 128 + head * 16);
#pragma unroll
    for (int i = 0; i < 4; ++i) {
      de[i] = make_int4(ee[i * 4], ee[i * 4 + 1], ee[i * 4 + 2], ee[i * 4 + 3]);
      ds[i] = make_float4(P.su[ee[i * 4]], P.su[ee[i * 4 + 1]], P.su[ee[i * 4 + 2]], P.su[ee[i * 4 + 3]]);
      dg[i] = make_float4(sc[i * 4] * inv * P.sv[ee[i * 4]], sc[i * 4 + 1] * inv * P.sv[ee[i * 4 + 1]],
                          sc[i * 4 + 2] * inv * P.sv[ee[i * 4 + 2]], sc[i * 4 + 3] * inv * P.sv[ee[i * 4 + 3]]);
    }
  }
}

typedef float f2v __attribute__((ext_vector_type(2)));
__device__ __forceinline__ float dot16_fp8(uint4 u, const f2v* x) {
  f2v acc = {0.f, 0.f};
  acc = __builtin_amdgcn_cvt_pk_f32_fp8(u.x, false) * x[0] + acc;
  acc = __builtin_amdgcn_cvt_pk_f32_fp8(u.x, true) * x[1] + acc;
  acc = __builtin_amdgcn_cvt_pk_f32_fp8(u.y, false) * x[2] + acc;
  acc = __builtin_amdgcn_cvt_pk_f32_fp8(u.y, true) * x[3] + acc;
  acc = __builtin_amdgcn_cvt_pk_f32_fp8(u.z, false) * x[4] + acc;
  acc = __builtin_amdgcn_cvt_pk_f32_fp8(u.z, true) * x[5] + acc;
  acc = __builtin_amdgcn_cvt_pk_f32_fp8(u.w, false) * x[6] + acc;
  acc = __builtin_amdgcn_cvt_pk_f32_fp8(u.w, true) * x[7] + acc;
  return acc.x + acc.y;
}
__device__ __forceinline__ void axpy16_fp8(f2v* o, float wgt, uint4 v) {
  const f2v ww = {wgt, wgt};
  o[0] = __builtin_amdgcn_cvt_pk_f32_fp8(v.x, false) * ww + o[0];
  o[1] = __builtin_amdgcn_cvt_pk_f32_fp8(v.x, true) * ww + o[1];
  o[2] = __builtin_amdgcn_cvt_pk_f32_fp8(v.y, false) * ww + o[2];
  o[3] = __builtin_amdgcn_cvt_pk_f32_fp8(v.y, true) * ww + o[3];
  o[4] = __builtin_amdgcn_cvt_pk_f32_fp8(v.z, false) * ww + o[4];
  o[5] = __builtin_amdgcn_cvt_pk_f32_fp8(v.z, true) * ww + o[5];
  o[6] = __builtin_amdgcn_cvt_pk_f32_fp8(v.w, false) * ww + o[6];
  o[7] = __builtin_amdgcn_cvt_pk_f32_fp8(v.w, true) * ww + o[7];
}

__device__ void peer_phase(const Params& P) {
  const int lane = threadIdx.x & 63;
  const int w = __builtin_amdgcn_readfirstlane(threadIdx.x >> 6);
  const int gwv = blockIdx.x * 4 + w, nw = gridDim.x * 4;
  const bool hb = (lane & 32) != 0, b4 = (lane & 16) != 0, b3 = (lane & 8) != 0;
  float4 g2v[4];
#pragma unroll
  for (int c = 0; c < 4; ++c) g2v[c] = *(const float4*)(P.norm2_g + lane * 16 + c * 4);
  float4 hn[4];
  if (gwv < T_TOK) {
#pragma unroll
    for (int c = 0; c < 4; ++c) hn[c] = *(const float4*)(P.out + (size_t)gwv * 1024 + lane * 16 + c * 4);
  }
  for (int tok = gwv; tok < T_TOK; tok += nw) {
    float4 hc[4];
#pragma unroll
    for (int c = 0; c < 4; ++c) hc[c] = hn[c];
    {
      const int ntok = (tok + nw < T_TOK) ? tok + nw : tok;
#pragma unroll
      for (int c = 0; c < 4; ++c) hn[c] = *(const float4*)(P.out + (size_t)ntok * 1024 + lane * 16 + c * 4);
    }
    const int* ep = P.eidx + (size_t)tok * 128;
    const float* gp = P.gw + (size_t)tok * 128;
    const float* sp = P.suv + (size_t)tok * 128;
    uint4 uA[8], uB[8];
    float suA, gA, suB, gB;
    int elA, elB;
#define LOADU(U, SU, G, EL, kb) { _Pragma("unroll") for (int j = 0; j < 8; ++j) { const int e = ep[(kb) + j]; \
        U[j] = *(const uint4*)(P.U8 + (size_t)e * 1024 + lane * 16); } \
      SU = sp[(kb) + (lane >> 3)]; G = gp[(kb) + (lane >> 3)]; EL = ep[(kb) + (lane >> 3)]; }
    LOADU(uA, suA, gA, elA, 0)
    __builtin_amdgcn_sched_barrier(0);
    float ss = 0.f;
#pragma unroll
    for (int c = 0; c < 4; ++c) ss += hc[c].x * hc[c].x + hc[c].y * hc[c].y + hc[c].z * hc[c].z + hc[c].w * hc[c].w;
    ss = wsum(ss);
    const float rstd2 = rsqrtf(ss * (1.f / 1024.f) + EPSF);
    f2v xn[8];
#pragma unroll
    for (int c = 0; c < 4; ++c) {
      xn[c * 2 + 0] = (f2v){hc[c].x * rstd2 * g2v[c].x, hc[c].y * rstd2 * g2v[c].y};
      xn[c * 2 + 1] = (f2v){hc[c].z * rstd2 * g2v[c].z, hc[c].w * rstd2 * g2v[c].w};
    }
#define PROCU(U, SU, G, EL, kb) { float d[8]; \
      _Pragma("unroll") for (int j = 0; j < 8; ++j) d[j] = dot16_fp8(U[j], xn); \
      _Pragma("unroll") for (int i = 0; i < 4; ++i) { float send = hb ? d[i] : d[i + 4], keep = hb ? d[i + 4] : d[i]; d[i] = keep + __shfl_xor(send, 32); } \
      _Pragma("unroll") for (int i = 0; i < 2; ++i) { float send = b4 ? d[i] : d[i + 2], keep = b4 ? d[i + 2] : d[i]; d[i] = keep + __shfl_xor(send, 16); } \
      { float send = b3 ? d[0] : d[1], keep = b3 ? d[1] : d[0]; d[0] = keep + __shfl_xor(send, 8); } \
      d[0] += __shfl_xor(d[0], 4); d[0] += __shfl_xor(d[0], 2); d[0] += __shfl_xor(d[0], 1); \
      const float act = gelu_(d[0] * SU) * G; \
      if ((lane & 7) == 0) ((unsigned*)P.wact)[(size_t)tok * 128 + (kb) + (lane >> 3)] = ((unsigned)f2bf(act) << 16) | (unsigned)EL; }
    for (int k0 = 0; k0 < 128; k0 += 16) {
      LOADU(uB, suB, gB, elB, k0 + 8)
      __builtin_amdgcn_sched_barrier(0);
      PROCU(uA, suA, gA, elA, k0)
      { const int kn = (k0 + 16 < 128) ? k0 + 16 : 112; LOADU(uA, suA, gA, elA, kn) }
      __builtin_amdgcn_sched_barrier(0);
      PROCU(uB, suB, gB, elB, k0 + 8)
    }
  }
}

__device__ void udot_phase(const Params& P) {
  const int my_xcc = (int)((unsigned)__builtin_amdgcn_s_getreg((3 << 11) | 20) & 7u), my_rank = P.rank[blockIdx.x];
  const int lane = threadIdx.x & 63, w = threadIdx.x >> 6;
  const int r = lane >> 3, c = lane & 7;
  const bool b2 = (lane & 4) != 0, b1 = (lane & 2) != 0, b0 = (lane & 1) != 0;
  int cen_ok = 1, cen_sum = 0, cen_mine = 0;
#pragma unroll
  for (int x = 0; x < 8; ++x) {
    const int cx = (int)__hip_atomic_load(P.bar + 15 * 512 + x * 32, __ATOMIC_RELAXED, __HIP_MEMORY_SCOPE_AGENT);
    cen_ok &= (cx > 0); cen_sum += cx; if (x == my_xcc) cen_mine = cx;
  }
  const bool fast = cen_ok && cen_sum == (int)gridDim.x;
  const int nwt = fast ? cen_mine * 4 : (int)gridDim.x * 4;
  const int wv = fast ? my_rank * 4 + w : (int)blockIdx.x * 4 + w;
  const int total = fast ? T_TOK : T_TOK * 8;
  const int cnt = (wv < total) ? (total - wv + nwt - 1) / nwt : 0;
  if (cnt == 0) return;
  const int slf = my_xcc;
#define UTOK(n, SL, TK) { int it_ = wv + ((n) < cnt ? (n) : cnt - 1) * nwt; SL = fast ? slf : (it_ & 7); TK = fast ? it_ : (it_ >> 3); }
#define ULOADE(E, n) { int sl_, tk_; UTOK(n, sl_, tk_) (void)sl_; const uint4* ep_ = (const uint4*)(P.eidx + (size_t)tk_ * 128 + r * 16); \
      _Pragma("unroll") for (int i = 0; i < 4; ++i) E[i] = ep_[i]; }
#define UGATHER(V, E, n) { int sl_, tk_; UTOK(n, sl_, tk_) (void)tk_; const unsigned char* ub_ = P.U8 + (size_t)sl_ * (16384 * 128) + c * 16; \
      _Pragma("unroll") for (int i = 0; i < 4; ++i) { \
        V[i * 4 + 0] = *(const uint4*)(ub_ + (size_t)E[i].x * 128); V[i * 4 + 1] = *(const uint4*)(ub_ + (size_t)E[i].y * 128); \
        V[i * 4 + 2] = *(const uint4*)(ub_ + (size_t)E[i].z * 128); V[i * 4 + 3] = *(const uint4*)(ub_ + (size_t)E[i].w * 128); } }
#define UHLOAD(H, S2, n) { int sl_, tk_; UTOK(n, sl_, tk_) const u16* hp_ = P.hb + (size_t)tk_ * 1024 + sl_ * 128 + c * 16; \
      H[0] = *(const float4*)hp_; H[1] = *(const float4*)(hp_ + 8);     (void)S2; }
#define UPROC(V, H, S2, n) { int sl_, tk_; UTOK(n, sl_, tk_) \
      f2v xn_[8]; \
      _Pragma("unroll") for (int i = 0; i < 2; ++i) { \
        const unsigned u0_ = __float_as_uint(H[i].x), u1_ = __float_as_uint(H[i].y), u2_ = __float_as_uint(H[i].z), u3_ = __float_as_uint(H[i].w); \
        xn_[i * 4] = (f2v){bflo(u0_), bfhi(u0_)}; xn_[i * 4 + 1] = (f2v){bflo(u1_), bfhi(u1_)}; \
        xn_[i * 4 + 2] = (f2v){bflo(u2_), bfhi(u2_)}; xn_[i * 4 + 3] = (f2v){bflo(u3_), bfhi(u3_)}; } \
      float d[16]; _Pragma("unroll") for (int i = 0; i < 16; ++i) d[i] = dot16_fp8(V[i], xn_); \
      _Pragma("unroll") for (int i = 0; i < 8; ++i) { float sd = b2 ? d[i] : d[i + 8], kp = b2 ? d[i + 8] : d[i]; d[i] = kp + __shfl_xor(sd, 4); } \
      _Pragma("unroll") for (int i = 0; i < 4; ++i) { float sd = b1 ? d[i] : d[i + 4], kp = b1 ? d[i + 4] : d[i]; d[i] = kp + __shfl_xor(sd, 2); } \
      _Pragma("unroll") for (int i = 0; i < 2; ++i) { float sd = b0 ? d[i] : d[i + 2], kp = b0 ? d[i + 2] : d[i]; d[i] = kp + __shfl_xor(sd, 1); } \
      nt_st_f2(make_float2(d[0], d[1]), P.part + ((size_t)sl_ * T_TOK + tk_) * 128 + lane * 2); }
  uint4 eA[4], eB[4];
  uint4 vA[16], vB[16];
  ULOADE(eA, 0)
  ULOADE(eB, 1)
  UGATHER(vA, eA, 0)
  __builtin_amdgcn_sched_barrier(0);
  for (int n = 0; n < cnt; n += 2) {
    { float4 h_[4]; float s2_ = 0.f; UHLOAD(h_, s2_, n) UGATHER(vB, eB, n + 1) ULOADE(eA, n + 2)
      __builtin_amdgcn_sched_barrier(0); UPROC(vA, h_, s2_, n) }
    if (n + 1 < cnt) {
      float4 h_[4]; float s2_ = 0.f; UHLOAD(h_, s2_, n + 1) UGATHER(vA, eA, n + 2) ULOADE(eB, n + 3)
      __builtin_amdgcn_sched_barrier(0); UPROC(vB, h_, s2_, n + 1)
    }
  }
}

__device__ void ucomb_phase(const Params& P) {
  const size_t gt = (size_t)blockIdx.x * 256 + threadIdx.x, nt = (size_t)gridDim.x * 256;
  for (size_t i = gt; i < (size_t)T_TOK * 32; i += nt) {
    float4 a = ((const float4*)P.part)[i];
#pragma unroll
    for (int sl = 1; sl < 8; ++sl) {
      const float4 b = ((const float4*)P.part)[(size_t)sl * T_TOK * 32 + i];
      a.x += b.x; a.y += b.y; a.z += b.z; a.w += b.w;
    }
    float4 su = ((const float4*)P.suv)[i]; const float4 g = ((const float4*)P.gw)[i];
    { const float r2 = rsqrtf(P.ss2[i >> 5] * (1.f / 1024.f) + EPSF); su.x *= r2; su.y *= r2; su.z *= r2; su.w *= r2; }
    const int4 e = ((const int4*)P.eidx)[i];
    uint4 o;
    o.x = ((unsigned)f2bf(gelu_(a.x * su.x) * g.x) << 16) | (unsigned)e.x;
    o.y = ((unsigned)f2bf(gelu_(a.y * su.y) * g.y) << 16) | (unsigned)e.y;
    o.z = ((unsigned)f2bf(gelu_(a.z * su.z) * g.z) << 16) | (unsigned)e.z;
    o.w = ((unsigned)f2bf(gelu_(a.w * su.w) * g.w) << 16) | (unsigned)e.w;
    ((uint4*)P.wact)[i] = o;
  }
}

__device__ void vacc_phase(const Params& P) {
  const int my_xcc = (int)((unsigned)__builtin_amdgcn_s_getreg((3 << 11) | 20) & 7u), my_rank = P.rank[blockIdx.x];
  const int lane = threadIdx.x & 63, w = threadIdx.x >> 6;
  const int r = lane >> 3, c = lane & 7;
  const bool hb = (lane & 32) != 0, b4 = (lane & 16) != 0, b3 = (lane & 8) != 0;
  int cen_ok = 1, cen_sum = 0, cen_mine = 0;
#pragma unroll
  for (int x = 0; x < 8; ++x) {
    const int cx = (int)__hip_atomic_load(P.bar + 15 * 512 + x * 32, __ATOMIC_RELAXED, __HIP_MEMORY_SCOPE_AGENT);
    cen_ok &= (cx > 0); cen_sum += cx; if (x == my_xcc) cen_mine = cx;
  }
  const bool fast = cen_ok && cen_sum == (int)gridDim.x;
  const int nwt = fast ? cen_mine * 4 : (int)gridDim.x * 4;
  const int wv = fast ? my_rank * 4 + w : (int)blockIdx.x * 4 + w;
  const int total = fast ? T_TOK : T_TOK * 8;
  const int cnt = (wv < total) ? (total - wv + nwt - 1) / nwt : 0;
  if (cnt == 0) return;
  const int slf = my_xcc;
#define VTOK(n, SL, TK) { int it_ = wv + ((n) < cnt ? (n) : cnt - 1) * nwt; SL = fast ? slf : (it_ & 7); TK = fast ? it_ : (it_ >> 3); }
#define VLOADEW(E, W, n) { int sl_, tk_; VTOK(n, sl_, tk_) (void)sl_; \
      const uint4* ep_ = (const uint4*)(P.wact + (size_t)tk_ * 128 + r * 16); \
      _Pragma("unroll") for (int i = 0; i < 4; ++i) { E[i] = ep_[i]; } }
#define VGATHER(V, E, n) { int sl_, tk_; VTOK(n, sl_, tk_) (void)tk_; const unsigned char* vb_ = P.V8 + (size_t)sl_ * (16384 * 128) + c * 16; \
      _Pragma("unroll") for (int i = 0; i < 4; ++i) { \
        V[i * 4 + 0] = *(const uint4*)(vb_ + (size_t)(E[i].x & 0xffffu) * 128); V[i * 4 + 1] = *(const uint4*)(vb_ + (size_t)(E[i].y & 0xffffu) * 128); \
        V[i * 4 + 2] = *(const uint4*)(vb_ + (size_t)(E[i].z & 0xffffu) * 128); V[i * 4 + 3] = *(const uint4*)(vb_ + (size_t)(E[i].w & 0xffffu) * 128); } }
#define VPROC(V, W, HV, n) { int sl_, tk_; VTOK(n, sl_, tk_) \
      f2v o[8]; _Pragma("unroll") for (int i = 0; i < 8; ++i) o[i] = (f2v){0.f, 0.f}; \
      _Pragma("unroll") for (int i = 0; i < 4; ++i) { axpy16_fp8(o, bfhi(W[i].x), V[i * 4 + 0]); axpy16_fp8(o, bfhi(W[i].y), V[i * 4 + 1]); \
        axpy16_fp8(o, bfhi(W[i].z), V[i * 4 + 2]); axpy16_fp8(o, bfhi(W[i].w), V[i * 4 + 3]); } \
      float f[16]; _Pragma("unroll") for (int i = 0; i < 8; ++i) { f[i * 2] = o[i].x; f[i * 2 + 1] = o[i].y; } \
      _Pragma("unroll") for (int i = 0; i < 8; ++i) { float sd = hb ? f[i] : f[i + 8], kp = hb ? f[i + 8] : f[i]; f[i] = kp + __shfl_xor(sd, 32); } \
      _Pragma("unroll") for (int i = 0; i < 4; ++i) { float sd = b4 ? f[i] : f[i + 4], kp = b4 ? f[i + 4] : f[i]; f[i] = kp + __shfl_xor(sd, 16); } \
      _Pragma("unroll") for (int i = 0; i < 2; ++i) { float sd = b3 ? f[i] : f[i + 2], kp = b3 ? f[i + 2] : f[i]; f[i] = kp + __shfl_xor(sd, 8); } \
      (void)HV; *(unsigned*)(P.hb + (size_t)tk_ * 1024 + sl_ * 128 + c * 16 + r * 2) = pack2(f[0], f[1]); }
#define VHLOAD(HV, n) { HV = make_float2(0.f, 0.f); }
#define IT2(VC, EC, VN, EN, n) { float2 hv0_; VHLOAD(hv0_, n) VGATHER(VN, EN, (n) + 1) VLOADEW(eC, eC, (n) + 2) \
      __builtin_amdgcn_sched_barrier(0); VPROC(VC, EC, hv0_, n) \
      _Pragma("unroll") for (int i = 0; i < 4; ++i) EC[i] = eC[i]; }
  uint4 eA[4], eB[4], eC[4];
  uint4 vA[16], vB[16];
  VLOADEW(eA, eA, 0)
  VLOADEW(eB, eB, 1)
  VGATHER(vA, eA, 0)
  __builtin_amdgcn_sched_barrier(0);
  for (int n = 0; n < cnt; n += 2) {
    IT2(vA, eA, vB, eB, n)
    if (n + 1 < cnt) IT2(vB, eB, vA, eA, n + 1)
  }
}

__device__ void final_phase(const Params& P) {
  const int lane = threadIdx.x & 63, w = threadIdx.x >> 6;
  const int gwv = blockIdx.x * 4 + w, nw = gridDim.x * 4;
  float4 g[4];
#pragma unroll
  for (int c = 0; c < 4; ++c) g[c] = *(const float4*)(P.normf_g + lane * 16 + c * 4);
  for (int tok = gwv; tok < T_TOK; tok += nw) {
    float* hrow = P.out + (size_t)tok * 1024 + lane * 16;
    const u16* orow = P.hb + (size_t)tok * 1024 + lane * 16;
    float4 v[4];
#pragma unroll
    for (int c = 0; c < 4; ++c) v[c] = *(const float4*)(hrow + c * 4);
    const uint4 o0 = *(const uint4*)orow, o1 = *(const uint4*)(orow + 8);
    v[0].x += bflo(o0.x); v[0].y += bfhi(o0.x); v[0].z += bflo(o0.y); v[0].w += bfhi(o0.y);
    v[1].x += bflo(o0.z); v[1].y += bfhi(o0.z); v[1].z += bflo(o0.w); v[1].w += bfhi(o0.w);
    v[2].x += bflo(o1.x); v[2].y += bfhi(o1.x); v[2].z += bflo(o1.y); v[2].w += bfhi(o1.y);
    v[3].x += bflo(o1.z); v[3].y += bfhi(o1.z); v[3].z += bflo(o1.w); v[3].w += bfhi(o1.w);
    float ss = 0.f;
#pragma unroll
    for (int c = 0; c < 4; ++c) ss += v[c].x * v[c].x + v[c].y * v[c].y + v[c].z * v[c].z + v[c].w * v[c].w;
    ss = wsum(ss);
    const float rf = rsqrtf(ss * (1.f / 1024.f) + EPSF);
#pragma unroll
    for (int c = 0; c < 4; ++c)
      *(float4*)(hrow + c * 4) = make_float4(v[c].x * rf * g[c].x, v[c].y * rf * g[c].y, v[c].z * rf * g[c].z, v[c].w * rf * g[c].w);
  }
}

__device__ __forceinline__ void gbar(unsigned* bar, int k) {
  asm volatile("s_waitcnt vmcnt(0)" ::: "memory");
  __syncthreads();
  if (threadIdx.x == 0) {
    unsigned* base = bar + k * 512;
    const unsigned g = blockIdx.x & 7u;
    const unsigned gsz = (gridDim.x - g + 7u) >> 3;
    const unsigned ngroups = gridDim.x < 8u ? gridDim.x : 8u;
    __builtin_amdgcn_fence(__ATOMIC_RELEASE, "agent");
    asm volatile("s_waitcnt vmcnt(0)" ::: "memory");
    const unsigned old = __hip_atomic_fetch_add(base + g * 32, 1u, __ATOMIC_RELAXED, __HIP_MEMORY_SCOPE_AGENT);
    if (old == gsz - 1u) __hip_atomic_fetch_add(base + 256, 1u, __ATOMIC_RELAXED, __HIP_MEMORY_SCOPE_AGENT);
    unsigned spins = 0;
    while (__hip_atomic_load(base + 256, __ATOMIC_RELAXED, __HIP_MEMORY_SCOPE_AGENT) < ngroups && spins < (1u << 22)) {
      __builtin_amdgcn_s_sleep(1);
      ++spins;
    }
    __builtin_amdgcn_fence(__ATOMIC_ACQUIRE, "agent");
    asm volatile("s_waitcnt vmcnt(0)" ::: "memory");
  }
  __syncthreads();
}

#define SMEM_BYTES 74752

template <int PH>
__device__ __forceinline__ void run_phase(const Params& P, char* smem) {
  if (PH == 0) phase_prep(P, smem);
  if (PH == 1) gemm256_phase<EPI_INPROJ>(P, smem, P.xb, P.WinT, T_TOK, 1536, 1024);
  if (PH == 2) { lru_phase<false>(P, smem); s5_phase<false>(P); }
  if (PH == 3) carry_phase(P);
  if (PH == 4) { lru_phase<true>(P, smem); s5_phase<true>(P); }
  if (PH == 5) gemm_phase<EPI_GLU>(P, smem, P.gs5, P.GluT, T_TOK, 512, 512);
  if (PH == 6) gemm256_phase<EPI_OUT>(P, smem, P.ycat, P.WoutT, T_TOK, 1024, 1024);
  if (PH == 7) gemm_phase<EPI_Q>(P, smem, P.hb, P.WqT, T_TOK, 2048, 1024);
  if (PH == 8) cand_phase(P, smem);
  if (PH == 9) udot_phase(P);
  if (PH == 10) ucomb_phase(P);
  if (PH == 11) vacc_phase(P);
  if (PH == 12) final_phase(P);
}

template <int LO, int HI>
__global__ void __launch_bounds__(256, 2) mk(Params P) {
  __shared__ __attribute__((aligned(16))) char smem[SMEM_BYTES];
  cg::grid_group grid = cg::this_grid();
#ifndef REPEAT_MASK
#define REPEAT_MASK 0
#endif
#define PHASE(n) if (LO <= n && n <= HI) { if ((REPEAT_MASK >> n) & 1) { run_phase<n>(P, smem); grid.sync(); } run_phase<n>(P, smem); if (n < HI) gbar(P.bar, n); }
  if (threadIdx.x == 0) {
    const unsigned xcc = (unsigned)__builtin_amdgcn_s_getreg((3 << 11) | 20) & 7u;
    const unsigned rk = __hip_atomic_fetch_add(P.bar + 15 * 512 + xcc * 32, 1u, __ATOMIC_RELAXED, __HIP_MEMORY_SCOPE_AGENT);
    P.rank[blockIdx.x] = (int)rk;
  }
  if (P.bar == nullptr) grid.sync();
  PHASE(0) PHASE(1) PHASE(2) PHASE(3) PHASE(4) PHASE(5) PHASE(6) PHASE(7) PHASE(8) PHASE(9) PHASE(10) PHASE(11) PHASE(12)
}

extern "C" void kernel_launch(void* const* d_in, const int* in_sizes, int n_in, void* d_out, int out_size,
                              void* d_ws, size_t ws_size, hipStream_t stream) {
  Params P{};
  const float** pin = (const float**)&P;
  for (int i = 0; i < 30; ++i) pin[i] = (const float*)d_in[i];
  P.out = (float*)d_out;
  char* ws = (char*)d_ws;
  size_t off = 0;
  auto take = [&](size_t bytes) { char* r = ws + off; off += (bytes + 255) & ~(size_t)255; return r; };
  const size_t MB = 1024 * 1024;
  char* RA = take(128 * MB);
  char* RB = take(256 * MB);
  char* RC = take(128 * MB);
  char* RD = take(96 * MB);
  P.xb = (u16*)RA; P.ycat = (u16*)RA;
  P.p = (u16*)RB; P.q = (u16*)RB;
  P.E = (float*)RC; P.Hs = (u16*)(RC + 64 * MB); P.hb = (u16*)RC;
  P.gs5 = (u16*)RD; P.eidx = (int*)RD; P.gw = (float*)(RD + 32 * MB); P.suv = (float*)(RD + 64 * MB);
  P.U8 = (unsigned char*)take(16 * MB); P.V8 = (unsigned char*)take(16 * MB);
  P.su = (float*)take(16384 * 4); P.sv = (float*)take(16384 * 4);
  P.WinT = (u16*)take(1536 * 1024 * 2); P.GluT = (u16*)take(512 * 512 * 2);
  P.WoutT = (u16*)take(1024 * 1024 * 2); P.WqT = (u16*)take(2048 * 1024 * 2);
  P.K1b = (u16*)take(128 * 128 * 2); P.K2b = (u16*)take(128 * 128 * 2);
  P.WaT = (u16*)take(8 * 4096 * 2); P.WxT = (u16*)take(8 * 4096 * 2);
  P.MF = (u16*)take(32 * 256 * 384 * 2); P.G = (u16*)take(32 * 128 * 256 * 2);
  P.spv = (float*)take(512 * 4);
  P.ssf = (float*)take(T_TOK * 4); P.wact = (float*)RA; P.part = (float*)RB; P.t16 = (float*)RB;
  P.ssa = (float*)take(T_TOK * 4); P.ssb = (float*)take(T_TOK * 4); P.ss2 = (float*)take(T_TOK * 4);
  P.rstd1 = (float*)take(T_TOK * 4); P.A16 = (float*)take(32 * 64 * 2 * 4);
  P.Acar = (float*)take(32 * 32 * 512 * 4); P.Hcar = (float*)take(32 * 32 * 512 * 4); P.Hin = (float*)take(32 * 32 * 512 * 4);

  P.bar = (unsigned*)take(16 * 2048);
  P.au = (unsigned*)take((size_t)T_TOK * 512 * 4);
  P.rank = (int*)take(4096 * 4);
  static int grid_blocks = 0;
#if ONE_LAUNCH
  (void)hipMemsetAsync(P.bar, 0, 16 * 2048, stream);
  if (!grid_blocks) {
    int dev = 0, cus = 0, per_cu = 0;
    (void)hipGetDevice(&dev);
    (void)hipDeviceGetAttribute(&cus, hipDeviceAttributeMultiprocessorCount, dev);
    (void)hipOccupancyMaxActiveBlocksPerMultiprocessor(&per_cu, mk<0, NPHASE - 1>, 256, 0);
    if (per_cu > 2) per_cu = 2;
    if (per_cu < 1) per_cu = 1;
    grid_blocks = cus * per_cu;
  }
  void* args[] = {&P};
  hipError_t e = hipLaunchCooperativeKernel((void*)mk<0, NPHASE - 1>, dim3(grid_blocks), dim3(256), args, 0, stream);
  if (e != hipSuccess) fprintf(stderr, "cooperative launch failed: %s (grid %d)\n", hipGetErrorString(e), grid_blocks);
#else
  if (!grid_blocks) {
    int dev = 0, cus = 0;
    (void)hipGetDevice(&dev);
    (void)hipDeviceGetAttribute(&cus, hipDeviceAttributeMultiprocessorCount, dev);
    grid_blocks = cus * 2;
  }
  mk<0, 0><<<grid_blocks, 256, 0, stream>>>(P);
  mk<1, 1><<<grid_blocks, 256, 0, stream>>>(P);
  mk<2, 2><<<grid_blocks, 256, 0, stream>>>(P);
  mk<3, 3><<<grid_blocks, 256, 0, stream>>>(P);
  mk<4, 4><<<grid_blocks, 256, 0, stream>>>(P);
  mk<5, 5><<<grid_blocks, 256, 0, stream>>>(P);
  mk<6, 6><<<grid_blocks, 256, 0, stream>>>(P);
  mk<7, 7><<<grid_blocks, 256, 0, stream>>>(P);
  mk<8, 8><<<grid_blocks, 256, 0, stream>>>(P);
  mk<9, 9><<<grid_blocks, 256, 0, stream>>>(P);
#endif
}
```

```cpp
#include <hip/hip_runtime.h>
#include <hip/hip_cooperative_groups.h>
#include <cstdio>
namespace cg = cooperative_groups;

typedef unsigned short u16;
using bf16x8 = __attribute__((ext_vector_type(8))) short;
using f32x4 = __attribute__((ext_vector_type(4))) float;
using f32x16 = __attribute__((ext_vector_type(16))) float;

#ifndef ONE_LAUNCH
#define ONE_LAUNCH 1
#endif

#define T_TOK 65536
#define EPSF 1e-6f
#define NPHASE 13

struct Params {
  const float *x, *norm1_g, *w_in, *conv_w, *conv_b, *lru_wa, *lru_ba, *lru_wx, *lru_bx, *lru_lambda;
  const float *s5_lre, *s5_lim, *s5_logdt, *s5_bre, *s5_bim, *s5_cre, *s5_cim, *s5_d, *glu_w, *glu_b;
  const float *gnorm_lru, *gnorm_s5, *w_out, *norm2_g, *wq, *k1, *k2, *pu, *pv, *normf_g;
  float* out;
  u16 *xb, *WinT, *GluT, *WoutT, *WqT, *K1b, *K2b, *Ub, *Vb, *WaT, *WxT, *MF, *G, *p, *Hs, *ycat, *gs5, *hb, *q;
  float *rstd1, *A16, *Acar, *Hcar, *Hin, *E, *gw, *suv, *su, *sv, *ssa, *ssb, *ss2, *ssf, *wact, *part, *spv, *t16;
  int* eidx;
  unsigned char *U8, *V8;
  unsigned* bar;
  unsigned* au;
  int* rank;
};

__device__ __forceinline__ u16 f2bf(float f) {
  unsigned u = __float_as_uint(f);
  u += 0x7fffu + ((u >> 16) & 1u);
  return (u16)(u >> 16);
}
__device__ __forceinline__ float bf2f(u16 h) { return __uint_as_float(((unsigned)h) << 16); }
__device__ __forceinline__ unsigned pack2(float a, float b) { return (unsigned)f2bf(a) | (((unsigned)f2bf(b)) << 16); }
__device__ __forceinline__ float bflo(unsigned u) { return __uint_as_float(u << 16); }
__device__ __forceinline__ float bfhi(unsigned u) { return __uint_as_float(u & 0xffff0000u); }
__device__ __forceinline__ float sigmoid_(float x) { return __builtin_amdgcn_rcpf(1.f + __expf(-x)); }
__device__ __forceinline__ float gelu_(float x) {
  float z = 0.7978845608028654f * (x + 0.044715f * x * x * x);
  return x * __builtin_amdgcn_rcpf(1.f + __expf(-2.f * z));
}
__device__ __forceinline__ float wsum(float v) {
#pragma unroll
  for (int o = 32; o; o >>= 1) v += __shfl_xor(v, o);
  return v;
}
__device__ __forceinline__ float sq8(uint4 v) {
  float s = 0.f, t;
  t = bflo(v.x); s += t * t; t = bfhi(v.x); s += t * t;
  t = bflo(v.y); s += t * t; t = bfhi(v.y); s += t * t;
  t = bflo(v.z); s += t * t; t = bfhi(v.z); s += t * t;
  t = bflo(v.w); s += t * t; t = bfhi(v.w); s += t * t;
  return s;
}
typedef unsigned u32x4e __attribute__((ext_vector_type(4)));
typedef float f32x2e __attribute__((ext_vector_type(2)));
__device__ __forceinline__ uint4 nt_ld_u4(const void* p) { u32x4e v = __builtin_nontemporal_load((const u32x4e*)p); return make_uint4(v.x, v.y, v.z, v.w); }
__device__ __forceinline__ float4 nt_ld_f4(const void* p) { f32x4 v = __builtin_nontemporal_load((const f32x4*)p); return make_float4(v.x, v.y, v.z, v.w); }
__device__ __forceinline__ float2 nt_ld_f2(const void* p) { f32x2e v = __builtin_nontemporal_load((const f32x2e*)p); return make_float2(v.x, v.y); }
__device__ __forceinline__ void nt_st_f2(float2 v, void* p) { f32x2e t = {v.x, v.y}; __builtin_nontemporal_store(t, (f32x2e*)p); }
#define MFMA16(a, b, c) __builtin_amdgcn_mfma_f32_16x16x32_bf16(a, b, c, 0, 0, 0)
#define MFMA32(a, b, c) __builtin_amdgcn_mfma_f32_32x32x16_bf16(a, b, c, 0, 0, 0)

__device__ void transpose_fold(const float* src, const float* g, u16* dst, int ldd, int K, int N, char* smem) {
  float* tl = (float*)smem;
  const int tid = threadIdx.x;
  const int tk = K / 64, tn = N / 64;
  for (int t = blockIdx.x; t < tk * tn; t += gridDim.x) {
    int k0 = (t / tn) * 64, n0 = (t % tn) * 64;
    __syncthreads();
    for (int i = 0; i < 16; ++i) {
      int k = (tid >> 6) + i * 4, n = tid & 63;
      float v = src[(size_t)(k0 + k) * N + n0 + n];
      if (g) v *= g[k0 + k];
      tl[k * 65 + n] = v;
    }
    __syncthreads();
    for (int i = 0; i < 16; ++i) {
      int n = (tid >> 6) + i * 4, k = tid & 63;
      dst[(size_t)(n0 + n) * ldd + k0 + k] = f2bf(tl[k * 65 + n]);
    }
  }
}

__device__ void s5_prep(const Params& P, char* smem, int g) {
  float* apw = (float*)smem;
  float* bb = apw + 17 * 64 * 2;
  float* kk = bb + 64 * 16 * 2;
  const int tid = threadIdx.x;
  __syncthreads();
  if (tid < 64) {
    int pp = tid;
    float lr = P.s5_lre[g * 64 + pp], li = P.s5_lim[g * 64 + pp];
    float dt = expf(P.s5_logdt[g]);
    float mag = expf(lr * dt);
    double ang = (double)li * (double)dt;
    double kq = rint(ang * 0.15915494309189535);
    float r = (float)(ang - kq * 6.283185307179586);
    float sn = __sinf(r), cs = __cosf(r);
    {
      sn = sinf(r); cs = cosf(r);
    }
    float are = mag * cs, aim = mag * sn;
    float den = lr * lr + li * li;
    float nre = are - 1.f, nim = aim;
    float zre = (nre * lr + nim * li) / den, zim = (nim * lr - nre * li) / den;
    float pr = 1.f, pi = 0.f;
    for (int d = 0; d <= 16; ++d) {
      apw[(d * 64 + pp) * 2] = pr; apw[(d * 64 + pp) * 2 + 1] = pi;
      float nr = pr * are - pi * aim, ni = pr * aim + pi * are;
      pr = nr; pi = ni;
    }
    P.A16[(g * 64 + pp) * 2] = apw[(16 * 64 + pp) * 2];
    P.A16[(g * 64 + pp) * 2 + 1] = apw[(16 * 64 + pp) * 2 + 1];
    for (int j = 0; j < 16; ++j) {
      float br = P.s5_bre[(g * 64 + pp) * 16 + j], bi = P.s5_bim[(g * 64 + pp) * 16 + j];
      bb[(pp * 16 + j) * 2] = zre * br - zim * bi;
      bb[(pp * 16 + j) * 2 + 1] = zre * bi + zim * br;
    }
  }
  __syncthreads();
  for (int rr = 0; rr < 16; ++rr) {
    int e = tid + rr * 256;
    int d = e >> 8, i = (e >> 4) & 15, j = e & 15;
    float s = 0.f;
    for (int pp = 0; pp < 64; ++pp) {
      float cr = P.s5_cre[(g * 16 + i) * 64 + pp], ci = P.s5_cim[(g * 16 + i) * 64 + pp];
      float ar = apw[(d * 64 + pp) * 2], ai = apw[(d * 64 + pp) * 2 + 1];
      float xr = cr * ar - ci * ai, xi = cr * ai + ci * ar;
      s += xr * bb[(pp * 16 + j) * 2] - xi * bb[(pp * 16 + j) * 2 + 1];
    }
    kk[e] = s;
  }
  __syncthreads();
  u16* MFg = P.MF + (size_t)g * 256 * 384;
  for (int it = 0; it < 192; ++it) {
    int e = tid + it * 256;
    int m = e / 192, cp = (e % 192) * 2;
    int t = m >> 4, i = m & 15;
    float v[2];
    for (int q = 0; q < 2; ++q) {
      int col = cp + q;
      float val;
      if (col < 256) {
        int sg = col >> 4, j = col & 15;
        val = (sg <= t) ? kk[((t - sg) * 16 + i) * 16 + j] : 0.f;
        if (sg == t && i == j) val += P.s5_d[g * 16 + i];
      } else {
        int pc = col - 256, pp = pc & 63, im = pc >> 6;
        float cr = P.s5_cre[(g * 16 + i) * 64 + pp], ci = P.s5_cim[(g * 16 + i) * 64 + pp];
        float ar = apw[((t + 1) * 64 + pp) * 2], ai = apw[((t + 1) * 64 + pp) * 2 + 1];
        float xr = cr * ar - ci * ai, xi = cr * ai + ci * ar;
        val = im ? -xi : xr;
      }
      v[q] = val;
    }
    *(unsigned*)(MFg + (size_t)m * 384 + cp) = pack2(v[0], v[1]);
  }
  u16* Gg = P.G + (size_t)g * 128 * 256;
  for (int it = 0; it < 64; ++it) {
    int e = tid + it * 256;
    int row = e >> 7, cp = (e & 127) * 2;
    int im = row >> 6, pp = row & 63;
    float v[2];
    for (int q = 0; q < 2; ++q) {
      int col = cp + q, sg = col >> 4, j = col & 15;
      float ar = apw[((15 - sg) * 64 + pp) * 2], ai = apw[((15 - sg) * 64 + pp) * 2 + 1];
      float br = bb[(pp * 16 + j) * 2], bi = bb[(pp * 16 + j) * 2 + 1];
      v[q] = im ? (ar * bi + ai * br) : (ar * br - ai * bi);
    }
    *(unsigned*)(Gg + (size_t)row * 256 + cp) = pack2(v[0], v[1]);
  }
}

__device__ void wqk_prep(const Params& P, char* smem) {
  float* Wt = (float*)smem;
  float* Kt = Wt + 64 * 129;
  const int tid = threadIdx.x;
  for (int item = blockIdx.x; item < 512; item += gridDim.x) {
    const int hs = item >> 5, kb = (item >> 1) & 15, kh = item & 1;
    const int cbase = (hs >> 1) * 256 + (hs & 1) * 128, k0 = kb * 64;
    __syncthreads();
    for (int i = 0; i < 32; ++i) {
      const int idx = tid + i * 256, row = idx >> 7, col = idx & 127;
      Wt[row * 129 + col] = P.wq[(size_t)(k0 + row) * 2048 + cbase + col] * P.norm2_g[k0 + row];
      const int ko = kh * 64 * 128 + idx;
      Kt[idx] = (hs & 1) ? P.k2[ko] : P.k1[ko];
    }
    __syncthreads();
    const int kk = tid & 63, q = tid >> 6;
    float acc[16];
#pragma unroll
    for (int i = 0; i < 16; ++i) acc[i] = 0.f;
    for (int d = 0; d < 128; d += 4) {
      const float w0 = Wt[kk * 129 + d], w1 = Wt[kk * 129 + d + 1], w2 = Wt[kk * 129 + d + 2], w3 = Wt[kk * 129 + d + 3];
#pragma unroll
      for (int i = 0; i < 16; ++i) {
        const float4 kv = *(const float4*)(Kt + (q * 16 + i) * 128 + d);
        acc[i] += w0 * kv.x + w1 * kv.y + w2 * kv.z + w3 * kv.w;
      }
    }
#pragma unroll
    for (int i = 0; i < 16; ++i) P.WqT[(size_t)(hs * 128 + kh * 64 + q * 16 + i) * 1024 + k0 + kk] = f2bf(acc[i]);
  }
}

__device__ void phase_prep(const Params& P, char* smem) {
  const int tid = threadIdx.x, lane = tid & 63, w = tid >> 6;
  {
    int g = (int)gridDim.x - 1 - (int)blockIdx.x;
    if (g < 32) s5_prep(P, smem, g);
  }
  for (int i = blockIdx.x * 256 + tid; i < 512; i += gridDim.x * 256) { const float lam = P.lru_lambda[i]; P.spv[i] = fmaxf(-lam, 0.f) + log1pf(expf(-fabsf(lam))); }
  for (int i = blockIdx.x * 256 + tid; i < T_TOK; i += gridDim.x * 256) { P.ssa[i] = 0.f; P.ssb[i] = 0.f; P.ss2[i] = 0.f; P.ssf[i] = 0.f; }
  const bool split = gridDim.x > 64;
  const bool bulk = !split || (int)blockIdx.x < (int)gridDim.x - 32;
  const int nbulk = split ? (int)gridDim.x - 32 : (int)gridDim.x;
  if (bulk) {
    const int gwv = blockIdx.x * 4 + w, nw = nbulk * 4;
    for (int r = gwv; r < T_TOK; r += nw) {
      const float4* src = (const float4*)(P.x + (size_t)r * 1024);
      float4 v[4];
      float ss = 0.f;
#pragma unroll
      for (int i = 0; i < 4; ++i) {
        v[i] = src[i * 64 + lane];
        ss += v[i].x * v[i].x + v[i].y * v[i].y + v[i].z * v[i].z + v[i].w * v[i].w;
      }
      ss = wsum(ss);
      if (lane == 0) P.rstd1[r] = rsqrtf(ss * (1.f / 1024.f) + EPSF);
      uint2* dst = (uint2*)(P.xb + (size_t)r * 1024);
#pragma unroll
      for (int i = 0; i < 4; ++i) dst[i * 64 + lane] = make_uint2(pack2(v[i].x, v[i].y), pack2(v[i].z, v[i].w));
    }
  }
  {
    const int gwv = blockIdx.x * 4 + w, nw = nbulk * 4;
    if (bulk)
    for (int r = gwv; r < 32768; r += nw) {
      const int isv = r >> 14, e = r & 16383;
      const float* src = (isv ? P.pv : P.pu) + (size_t)e * 1024 + lane * 16;
      float4 v[4];
      float m = 0.f;
#pragma unroll
      for (int i = 0; i < 4; ++i) {
        {
          float4 t = *(const float4*)(src + i * 4);
          const float4 g2 = *(const float4*)(P.norm2_g + lane * 16 + i * 4);
          v[i] = isv ? t : make_float4(t.x * g2.x, t.y * g2.y, t.z * g2.z, t.w * g2.w);
        }
        m = fmaxf(m, fmaxf(fmaxf(fabsf(v[i].x), fabsf(v[i].y)), fmaxf(fabsf(v[i].z), fabsf(v[i].w))));
      }
#pragma unroll
      for (int o = 32; o; o >>= 1) m = fmaxf(m, __shfl_xor(m, o));
      int ex = (int)((__float_as_uint(m) >> 23) & 255u) - 127;
      ex = ex < -100 ? -100 : (ex > 100 ? 100 : ex);
      const float sc = __uint_as_float((unsigned)(127 + 7 - ex) << 23);
      const float isc = __uint_as_float((unsigned)(127 - 7 + ex) << 23);
      unsigned pk[4];
#pragma unroll
      for (int i = 0; i < 4; ++i) {
        int t = __builtin_amdgcn_cvt_pk_fp8_f32(v[i].x * sc, v[i].y * sc, 0, false);
        t = __builtin_amdgcn_cvt_pk_fp8_f32(v[i].z * sc, v[i].w * sc, t, true);
        pk[i] = (unsigned)t;
      }
      unsigned char* dst = isv ? (P.V8 + (size_t)(lane >> 3) * (16384 * 128) + (size_t)e * 128 + (lane & 7) * 16)
                               : (P.U8 + (size_t)(lane >> 3) * (16384 * 128) + (size_t)e * 128 + (lane & 7) * 16);
      *(uint4*)dst = make_uint4(pk[0], pk[1], pk[2], pk[3]);
      if (lane == 0) { if (isv) P.sv[e] = isc; else P.su[e] = isc; }
    }
    size_t gt = (size_t)blockIdx.x * 256 + tid, nt = (size_t)gridDim.x * 256;
    for (size_t i = gt; i < 4096; i += nt) {
      float4 a = ((const float4*)P.k1)[i];
      ((uint2*)P.K1b)[i] = make_uint2(pack2(a.x, a.y), pack2(a.z, a.w));
      float4 b = ((const float4*)P.k2)[i];
      ((uint2*)P.K2b)[i] = make_uint2(pack2(b.x, b.y), pack2(b.z, b.w));
    }
  }
  transpose_fold(P.w_in, P.norm1_g, P.WinT, 1024, 1024, 1536, smem);
  transpose_fold(P.glu_w, nullptr, P.GluT, 512, 512, 512, smem);
  transpose_fold(P.w_out, P.gnorm_lru, P.WoutT, 1024, 512, 1024, smem);
  transpose_fold(P.w_out + 512 * 1024, P.gnorm_s5, P.WoutT + 512, 1024, 512, 1024, smem);
  wqk_prep(P, smem);
  for (int h = 0; h < 8; ++h) {
    transpose_fold(P.lru_wa + h * 4096, nullptr, P.WaT + h * 4096, 64, 64, 64, smem);
    transpose_fold(P.lru_wx + h * 4096, nullptr, P.WxT + h * 4096, 64, 64, 64, smem);
  }
}

__device__ __forceinline__ void ce(float& hi, float& lo) {
  float a = hi, b = lo;
  asm("v_max_f32 %0, %1, %2" : "=v"(hi) : "v"(a), "v"(b));
  asm("v_min_f32 %0, %1, %2" : "=v"(lo) : "v"(a), "v"(b));
}
__device__ __forceinline__ float vmaxf(float a, float b) {
  float r;
  asm("v_max_f32 %0, %1, %2" : "=v"(r) : "v"(a), "v"(b));
  return r;
}
__device__ __forceinline__ void sort16(float (&v)[16]) {
#pragma unroll
  for (int k = 2; k <= 16; k <<= 1)
#pragma unroll
    for (int j = k >> 1; j > 0; j >>= 1)
#pragma unroll
      for (int i = 0; i < 16; ++i) {
        int l = i ^ j;
        if (l > i) {
          if ((i & k) == 0) ce(v[i], v[l]); else ce(v[l], v[i]);
        }
      }
}
__device__ __forceinline__ void bmerge16(float (&v)[16]) {
#pragma unroll
  for (int j = 8; j > 0; j >>= 1)
#pragma unroll
    for (int i = 0; i < 16; ++i) {
      int l = i ^ j;
      if (l > i) ce(v[i], v[l]);
    }
}
__device__ __forceinline__ void merge_top16(float (&x)[16], const float (&y)[16]) {
#pragma unroll
  for (int i = 0; i < 16; ++i) x[i] = vmaxf(x[i], y[15 - i]);
  bmerge16(x);
}

enum { EPI_INPROJ = 0, EPI_GLU = 1, EPI_OUT = 2, EPI_Q = 3 };
#define LDT 64

template <int EPI>
__device__ void gemm_phase(const Params& P, char* smem, const u16* __restrict__ A, const u16* __restrict__ Bt,
                           int M, int N, int K) {
  constexpr int TE = 128 * LDT;
  u16* AsB = (u16*)smem;
  u16* BsB = AsB + 2 * TE;
  const int tid = threadIdx.x, lane = tid & 63, w = tid >> 6, wm = w >> 1, wn = w & 1;
  const int l15 = lane & 15, lq = lane >> 4;
  const int NT = N / 128, MT = M / 128, ntiles = MT * NT, nk = K / 64;
  int vb = blockIdx.x;
  if ((gridDim.x & 7) == 0) vb = (blockIdx.x & 7) * (gridDim.x >> 3) + (blockIdx.x >> 3);
  const int ldr = tid >> 3, ldc = (tid & 7) * 8;
  const int ldsw = ((tid & 7) ^ ((ldr >> 1) & 7)) * 8;
  const int rsw = (l15 >> 1) & 7;
  const int cnt = (vb < ntiles) ? (ntiles - vb + (int)gridDim.x - 1) / (int)gridDim.x : 0;
  const int total = cnt * nk;
  if (total == 0) return;
  f32x4 acc[4][4];
#pragma unroll
  for (int i = 0; i < 4; ++i)
#pragma unroll
    for (int j = 0; j < 4; ++j) acc[i][j] = (f32x4){0.f, 0.f, 0.f, 0.f};
  uint4 pa0, pa1, pa2, pa3, pb0, pb1, pb2, pb3, qa0, qa1, qa2, qa3, qb0, qb1, qb2, qb3;
  const u16 *Ag, *Bg;
#define STEP_ADDR(st) { int st_ = (st) < total ? (st) : total - 1; int ti_ = st_ / nk, kk_ = st_ - ti_ * nk; \
      int tl_ = vb + ti_ * (int)gridDim.x; int r0_ = (tl_ / NT) * 128, c0_ = (tl_ % NT) * 128; \
      { const int hm_ = (nk >> 1) - 1; kk_ = (kk_ & ~hm_) | ((kk_ + (tl_ % NT) + (tl_ / NT)) & hm_); } \
      Ag = A + (size_t)(r0_ + ldr) * K + ldc + kk_ * 64; Bg = Bt + (size_t)(c0_ + ldr) * K + ldc + kk_ * 64; }
#define GLD2(S, i) { S##a##i = *(const uint4*)(Ag + (size_t)(32 * i) * K); S##b##i = *(const uint4*)(Bg + (size_t)(32 * i) * K); }
#define GLDS(S, st) { STEP_ADDR(st) GLD2(S, 0) GLD2(S, 1) GLD2(S, 2) GLD2(S, 3) }
#define LST2(S, i, buf) { *(uint4*)(AsB + (buf) * TE + (ldr + 32 * i) * LDT + ldsw) = S##a##i; \
                          *(uint4*)(BsB + (buf) * TE + (ldr + 32 * i) * LDT + ldsw) = S##b##i; }
#define LSTS(S, buf) { LST2(S, 0, buf) LST2(S, 1, buf) LST2(S, 2, buf) LST2(S, 3, buf) }
#define COMPUTE(buf) { \
      const u16* As_ = AsB + (buf) * TE; const u16* Bs_ = BsB + (buf) * TE; \
      _Pragma("unroll") for (int ks = 0; ks < 2; ++ks) { \
        bf16x8 af[4], bfr[4]; \
        _Pragma("unroll") for (int mt = 0; mt < 4; ++mt) \
          af[mt] = *(const bf16x8*)(As_ + (wm * 64 + mt * 16 + l15) * LDT + (((ks * 4 + lq) ^ rsw) * 8)); \
        _Pragma("unroll") for (int nt = 0; nt < 4; ++nt) \
          bfr[nt] = *(const bf16x8*)(Bs_ + (wn * 64 + nt * 16 + l15) * LDT + (((ks * 4 + lq) ^ rsw) * 8)); \
        _Pragma("unroll") for (int mt = 0; mt < 4; ++mt) \
          _Pragma("unroll") for (int nt = 0; nt < 4; ++nt) acc[mt][nt] = MFMA16(bfr[nt], af[mt], acc[mt][nt]); \
      } }
#define RESCALE() { if (EPI == EPI_OUT) { \
      _Pragma("unroll") for (int mt = 0; mt < 4; ++mt) { \
        const int row = row0 + wm * 64 + mt * 16 + l15; \
        const float ra_ = rsqrtf(P.ssa[row] * (1.f / 512.f) + EPSF), rb_ = rsqrtf(P.ssb[row] * (1.f / 512.f) + EPSF); \
        const float ratio = ra_ / rb_; \
        _Pragma("unroll") for (int nt = 0; nt < 4; ++nt) acc[mt][nt] *= ratio; } } }
  __syncthreads();
  GLDS(p, 0)
  __builtin_amdgcn_sched_barrier(0);
  GLDS(q, 1)
  __builtin_amdgcn_sched_barrier(0);
  LSTS(p, 0)
  GLDS(p, 2)
  __builtin_amdgcn_sched_barrier(0);
  for (int st = 0; st < total; st += 2) {
    const int ti = st / nk, kt = st - ti * nk;
    const int tile = vb + ti * (int)gridDim.x;
    const int row0 = (tile / NT) * 128, col0 = (tile % NT) * 128;
    __syncthreads();
    LSTS(q, 1)
    GLDS(q, st + 3)
    __builtin_amdgcn_sched_barrier(0);
    if (kt == nk / 2) RESCALE()
    COMPUTE(0)
    __syncthreads();
    LSTS(p, 0)
    GLDS(p, st + 4)
    __builtin_amdgcn_sched_barrier(0);
    COMPUTE(1)
    if (kt + 2 < nk) continue;
    if (EPI == EPI_Q) {
      float* xch = (float*)(smem + 65536);
      float lst[4][16];
#pragma unroll
      for (int mt = 0; mt < 4; ++mt) {
        const int lr = wm * 64 + mt * 16 + l15;
        const float sc = rsqrtf(P.ss2[row0 + lr] * (1.f / 1024.f) + EPSF);
#pragma unroll
        for (int nt = 0; nt < 4; ++nt)
#pragma unroll
          for (int j = 0; j < 4; ++j) {
            const unsigned kidx = (unsigned)(wn * 64 + nt * 16 + lq * 4 + j);
            lst[mt][nt * 4 + j] = __uint_as_float((__float_as_uint(acc[mt][nt][j] * sc) & 0xffffff80u) | kidx);
          }
#pragma unroll
        for (int nt = 0; nt < 4; ++nt) acc[mt][nt] = (f32x4){0.f, 0.f, 0.f, 0.f};
        sort16(lst[mt]);
        float y[16];
#pragma unroll
        for (int i = 0; i < 16; ++i) y[i] = __shfl_xor(lst[mt][i], 16);
        merge_top16(lst[mt], y);
#pragma unroll
        for (int i = 0; i < 16; ++i) y[i] = __shfl_xor(lst[mt][i], 32);
        merge_top16(lst[mt], y);
      }
      if (wn == 1 && lq == 0) {
#pragma unroll
        for (int mt = 0; mt < 4; ++mt) {
          float4* d4 = (float4*)(xch + (wm * 64 + mt * 16 + l15) * 16);
#pragma unroll
          for (int i = 0; i < 4; ++i) d4[i] = make_float4(lst[mt][i * 4], lst[mt][i * 4 + 1], lst[mt][i * 4 + 2], lst[mt][i * 4 + 3]);
        }
      }
      __syncthreads();
      if (wn == 0) {
        const int hs = col0 >> 7;
#pragma unroll
        for (int mt = 0; mt < 4; ++mt) {
          const int lr = wm * 64 + mt * 16 + l15;
          const float4* s4 = (const float4*)(xch + lr * 16);
          float y[16];
#pragma unroll
          for (int i = 0; i < 4; ++i) { const float4 t = s4[i]; y[i * 4] = t.x; y[i * 4 + 1] = t.y; y[i * 4 + 2] = t.z; y[i * 4 + 3] = t.w; }
          merge_top16(lst[mt], y);
          if (lq == 0) {
            float4* d4 = (float4*)(P.t16 + ((size_t)(row0 + lr) * 16 + hs) * 16);
#pragma unroll
            for (int i = 0; i < 4; ++i) d4[i] = make_float4(lst[mt][i * 4], lst[mt][i * 4 + 1], lst[mt][i * 4 + 2], lst[mt][i * 4 + 3]);
          }
        }
      }
      continue;
    }
#pragma unroll
    for (int mt = 0; mt < 4; ++mt) {
      const int lr = wm * 64 + mt * 16 + l15;
      const size_t row = (size_t)(row0 + lr);
      float sc = 1.f;
      if (EPI == EPI_INPROJ) sc = P.rstd1[row];
      if (EPI == EPI_OUT) sc = rsqrtf(P.ssb[row] * (1.f / 512.f) + EPSF);
      if (EPI == EPI_Q) sc = rsqrtf(P.ss2[row] * (1.f / 1024.f) + EPSF);
      float sq = 0.f;
#pragma unroll
      for (int nt = 0; nt < 4; ++nt) {
        const int col = col0 + wn * 64 + nt * 16 + lq * 4;
        f32x4 v = acc[mt][nt];
        if (EPI == EPI_INPROJ) {
          *(uint2*)(P.p + row * 1536 + col) = make_uint2(pack2(v[0] * sc, v[1] * sc), pack2(v[2] * sc, v[3] * sc));
        } else if (EPI == EPI_GLU) {
          uint2 gg = *(const uint2*)(P.gs5 + row * 512 + col);
          float4 gb = *(const float4*)(P.glu_b + col);
          float g0 = bflo(gg.x), g1 = bfhi(gg.x), g2 = bflo(gg.y), g3 = bfhi(gg.y);
          float o0 = g0 * sigmoid_(v[0] + gb.x), o1 = g1 * sigmoid_(v[1] + gb.y);
          float o2 = g2 * sigmoid_(v[2] + gb.z), o3 = g3 * sigmoid_(v[3] + gb.w);
          sq += o0 * o0 + o1 * o1 + o2 * o2 + o3 * o3;
          *(uint2*)(P.ycat + row * 1024 + 512 + col) = make_uint2(pack2(o0, o1), pack2(o2, o3));
        } else {
          float4 xv = *(const float4*)(P.x + row * 1024 + col);
          float4 h = make_float4(xv.x + v[0] * sc, xv.y + v[1] * sc, xv.z + v[2] * sc, xv.w + v[3] * sc);
          sq += h.x * h.x + h.y * h.y + h.z * h.z + h.w * h.w;
          *(float4*)(P.out + row * 1024 + col) = h;
          *(uint2*)(P.hb + row * 1024 + col) = make_uint2(pack2(h.x, h.y), pack2(h.z, h.w));
        }
      }
      if (EPI == EPI_GLU || EPI == EPI_OUT) {
        sq += __shfl_xor(sq, 16);
        sq += __shfl_xor(sq, 32);
        if (lq == 0) atomicAdd((EPI == EPI_GLU ? P.ssb : P.ss2) + row, sq);
      }
#pragma unroll
      for (int nt = 0; nt < 4; ++nt) acc[mt][nt] = (f32x4){0.f, 0.f, 0.f, 0.f};
    }
  }
}

template <int EPI>
__device__ void gemm256_phase(const Params& P, char* smem, const u16* __restrict__ A, const u16* __restrict__ Bt,
                              int M, int N, int K) {
  u16* As = (u16*)smem;
  u16* Bs = As + 256 * 64;
  const int tid = threadIdx.x, lane = tid & 63, w = tid >> 6, wm = w >> 1, wn = w & 1;
  const int l15 = lane & 15, lq = lane >> 4;
  const int NT = N / 128, MT = M / 256, ntiles = MT * NT, nk = K / 64;
  int vb = blockIdx.x;
  if ((gridDim.x & 7) == 0) vb = (blockIdx.x & 7) * (gridDim.x >> 3) + (blockIdx.x >> 3);
  const int ldr = tid >> 3, ldc = (tid & 7) * 8;
  const int ldsw = ((tid & 7) ^ ((ldr >> 1) & 7)) * 8;
  const int rsw = (l15 >> 1) & 7;
  const int cnt = (vb < ntiles) ? (ntiles - vb + (int)gridDim.x - 1) / (int)gridDim.x : 0;
  const int total = cnt * nk;
  if (total == 0) return;
  f32x4 acc[8][4];
#pragma unroll
  for (int i = 0; i < 8; ++i)
#pragma unroll
    for (int j = 0; j < 4; ++j) acc[i][j] = (f32x4){0.f, 0.f, 0.f, 0.f};
  uint4 ga0, ga1, ga2, ga3, ga4, ga5, ga6, ga7, gb0, gb1, gb2, gb3;
  const u16 *Ag, *Bg;
#define G2_ADDR(st) { int st_ = (st) < total ? (st) : total - 1; int ti_ = st_ / nk, kk_ = st_ - ti_ * nk; \
      int tl_ = vb + ti_ * (int)gridDim.x; int r0_ = (tl_ / NT) * 256, c0_ = (tl_ % NT) * 128; \
      Ag = A + (size_t)(r0_ + ldr) * K + ldc + kk_ * 64; Bg = Bt + (size_t)(c0_ + ldr) * K + ldc + kk_ * 64; }
#define G2_LDA(i) ga##i = *(const uint4*)(Ag + (size_t)(32 * i) * K);
#define G2_LDB(i) gb##i = *(const uint4*)(Bg + (size_t)(32 * i) * K);
#define G2_GLD(st) { G2_ADDR(st) G2_LDA(0) G2_LDA(1) G2_LDA(2) G2_LDA(3) G2_LDA(4) G2_LDA(5) G2_LDA(6) G2_LDA(7) G2_LDB(0) G2_LDB(1) G2_LDB(2) G2_LDB(3) }
#define G2_STA(i) *(uint4*)(As + (ldr + 32 * i) * 64 + ldsw) = ga##i;
#define G2_STB(i) *(uint4*)(Bs + (ldr + 32 * i) * 64 + ldsw) = gb##i;
#define G2_LST() { G2_STA(0) G2_STA(1) G2_STA(2) G2_STA(3) G2_STA(4) G2_STA(5) G2_STA(6) G2_STA(7) G2_STB(0) G2_STB(1) G2_STB(2) G2_STB(3) }
  G2_GLD(0)
  for (int st = 0; st < total; ++st) {
    const int ti = st / nk, kt = st - ti * nk;
    const int tile = vb + ti * (int)gridDim.x;
    const int row0 = (tile / NT) * 256, col0 = (tile % NT) * 128;
    __syncthreads();
    G2_LST()
    G2_GLD(st + 1)
    __builtin_amdgcn_sched_barrier(0);
    __syncthreads();
    if (EPI == EPI_OUT && kt == nk / 2) {
#pragma unroll
      for (int mt = 0; mt < 8; ++mt) {
        const int row = row0 + wm * 128 + mt * 16 + l15;
        const float ra_ = rsqrtf(P.ssa[row] * (1.f / 512.f) + EPSF), rb_ = rsqrtf(P.ssb[row] * (1.f / 512.f) + EPSF);
        const float ratio = ra_ / rb_;
#pragma unroll
        for (int nt = 0; nt < 4; ++nt) acc[mt][nt] *= ratio;
      }
    }
#pragma unroll
    for (int ks = 0; ks < 2; ++ks) {
      bf16x8 bfr[4];
#pragma unroll
      for (int nt = 0; nt < 4; ++nt)
        bfr[nt] = *(const bf16x8*)(Bs + (wn * 64 + nt * 16 + l15) * 64 + (((ks * 4 + lq) ^ rsw) * 8));
#pragma unroll
      for (int hh = 0; hh < 2; ++hh) {
        bf16x8 af[4];
#pragma unroll
        for (int m = 0; m < 4; ++m)
          af[m] = *(const bf16x8*)(As + (wm * 128 + (hh * 4 + m) * 16 + l15) * 64 + (((ks * 4 + lq) ^ rsw) * 8));
#pragma unroll
        for (int m = 0; m < 4; ++m)
#pragma unroll
          for (int nt = 0; nt < 4; ++nt) acc[hh * 4 + m][nt] = MFMA16(bfr[nt], af[m], acc[hh * 4 + m][nt]);
      }
    }
    if (kt + 1 < nk) continue;
#pragma unroll
    for (int mt = 0; mt < 8; ++mt) {
      const int lr = wm * 128 + mt * 16 + l15;
      const size_t row = (size_t)(row0 + lr);
      float sc = 1.f;
      if (EPI == EPI_INPROJ) sc = P.rstd1[row];
      if (EPI == EPI_OUT) sc = rsqrtf(P.ssb[row] * (1.f / 512.f) + EPSF);
      float sq = 0.f;
#pragma unroll
      for (int nt = 0; nt < 4; ++nt) {
        const int col = col0 + wn * 64 + nt * 16 + lq * 4;
        f32x4 v = acc[mt][nt];
        if (EPI == EPI_INPROJ) {
          *(uint2*)(P.p + row * 1536 + col) = make_uint2(pack2(v[0] * sc, v[1] * sc), pack2(v[2] * sc, v[3] * sc));
        } else if (EPI == EPI_GLU) {
          uint2 gg = *(const uint2*)(P.gs5 + row * 512 + col);
          float4 gb = *(const float4*)(P.glu_b + col);
          float g0 = bflo(gg.x), g1 = bfhi(gg.x), g2 = bflo(gg.y), g3 = bfhi(gg.y);
          float o0 = g0 * sigmoid_(v[0] + gb.x), o1 = g1 * sigmoid_(v[1] + gb.y);
          float o2 = g2 * sigmoid_(v[2] + gb.z), o3 = g3 * sigmoid_(v[3] + gb.w);
          sq += o0 * o0 + o1 * o1 + o2 * o2 + o3 * o3;
          *(uint2*)(P.ycat + row * 1024 + 512 + col) = make_uint2(pack2(o0, o1), pack2(o2, o3));
        } else {
          float4 xv = *(const float4*)(P.x + row * 1024 + col);
          float4 h = make_float4(xv.x + v[0] * sc, xv.y + v[1] * sc, xv.z + v[2] * sc, xv.w + v[3] * sc);
          sq += h.x * h.x + h.y * h.y + h.z * h.z + h.w * h.w;
          *(float4*)(P.out + row * 1024 + col) = h;
          *(uint2*)(P.hb + row * 1024 + col) = make_uint2(pack2(h.x, h.y), pack2(h.z, h.w));
        }
        acc[mt][nt] = (f32x4){0.f, 0.f, 0.f, 0.f};
      }
      if (EPI == EPI_GLU || EPI == EPI_OUT) {
        sq += __shfl_xor(sq, 16);
        sq += __shfl_xor(sq, 32);
        if (lq == 0) atomicAdd((EPI == EPI_GLU ? P.ssb : P.ss2) + row, sq);
      }
    }
  }
}

__device__ __forceinline__ float one_minus_exp(float x) {
  const float ser = -x * (1.f + x * (0.5f + x * (0.16666667f + x * (0.041666668f + x * (0.0083333338f + x * 0.0013888889f)))));
  return (x > -0.5f) ? ser : (1.f - __expf(x));
}

template <bool FINAL>
__device__ void lru_phase(const Params& P, char* smem) {
  float* xcs = (float*)smem;
  float* a_s = xcs + 64 * 65;
  float* segA = a_s + 64 * 65;
  float* segH = segA + 256;
  const int tid = threadIdx.x, lane = tid & 63, w = tid >> 6;
  const int l15 = lane & 15, lq = lane >> 4;
  for (int item = blockIdx.x; item < 8192; item += gridDim.x) {
    const int head = item & 7, tile = (item >> 3) & 31, b = item >> 8;
    const int c0 = head * 64, t0 = tile * 64;
    __syncthreads();
    if (!FINAL) {
      bf16x8 af[2];
      {
        const int tl = w * 16 + l15;
        const int t = t0 + tl;
        const u16* prow = P.p + ((size_t)(b * 2048 + t)) * 1536 + c0;
#pragma unroll
        for (int ks = 0; ks < 2; ++ks) {
          const int ch = ks * 32 + lq * 8;
          float xc[8];
          {
            float4 b0 = *(const float4*)(P.conv_b + c0 + ch), b1 = *(const float4*)(P.conv_b + c0 + ch + 4);
            xc[0] = b0.x; xc[1] = b0.y; xc[2] = b0.z; xc[3] = b0.w; xc[4] = b1.x; xc[5] = b1.y; xc[6] = b1.z; xc[7] = b1.w;
          }
#pragma unroll
          for (int k = 0; k < 4; ++k) {
            if (t - 3 + k >= 0) {
              uint4 v = *(const uint4*)(prow + (k - 3) * 1536 + ch);
              float4 w0 = *(const float4*)(P.conv_w + k * 512 + c0 + ch), w1 = *(const float4*)(P.conv_w + k * 512 + c0 + ch + 4);
              xc[0] += w0.x * bflo(v.x); xc[1] += w0.y * bfhi(v.x); xc[2] += w0.z * bflo(v.y); xc[3] += w0.w * bfhi(v.y);
              xc[4] += w1.x * bflo(v.z); xc[5] += w1.y * bfhi(v.z); xc[6] += w1.z * bflo(v.w); xc[7] += w1.w * bfhi(v.w);
            }
          }
#pragma unroll
          for (int i = 0; i < 8; ++i) xcs[tl * 65 + ch + i] = xc[i];
          unsigned p0 = pack2(xc[0], xc[1]), p1 = pack2(xc[2], xc[3]), p2 = pack2(xc[4], xc[5]), p3 = pack2(xc[6], xc[7]);
          uint4 pk = make_uint4(p0, p1, p2, p3);
          af[ks] = *(bf16x8*)&pk;
        }
      }
      f32x4 accr[4], acci[4];
#pragma unroll
      for (int nt = 0; nt < 4; ++nt) {
        accr[nt] = (f32x4){0.f, 0.f, 0.f, 0.f};
        acci[nt] = (f32x4){0.f, 0.f, 0.f, 0.f};
#pragma unroll
        for (int ks = 0; ks < 2; ++ks) {
          bf16x8 ba = *(const bf16x8*)(P.WaT + head * 4096 + (nt * 16 + l15) * 64 + ks * 32 + lq * 8);
          bf16x8 bx = *(const bf16x8*)(P.WxT + head * 4096 + (nt * 16 + l15) * 64 + ks * 32 + lq * 8);
          accr[nt] = MFMA16(af[ks], ba, accr[nt]);
          acci[nt] = MFMA16(af[ks], bx, acci[nt]);
        }
      }
      __syncthreads();
#pragma unroll
      for (int nt = 0; nt < 4; ++nt) {
        const int ch = nt * 16 + l15;
        const float ba = P.lru_ba[c0 + ch], bx = P.lru_bx[c0 + ch], sp = P.spv[c0 + ch];
#pragma unroll
        for (int r = 0; r < 4; ++r) {
          const int tl = w * 16 + lq * 4 + r;
          float xf = xcs[tl * 65 + ch];
          float rr = sigmoid_(accr[nt][r] + ba), ig = sigmoid_(acci[nt][r] + bx);
          float la = -8.f * rr * sp;
          const float oma = one_minus_exp(la);
          const float om2 = one_minus_exp(2.f * la);
          float u = __builtin_amdgcn_sqrtf(om2) * ig * xf;
          a_s[tl * 65 + ch] = __uint_as_float((unsigned)f2bf(oma) | ((unsigned)f2bf(u) << 16));
        }
      }
      __syncthreads();
    }
    {
      const int ch = tid & 63, seg = tid >> 6;
      const size_t tok0 = (size_t)(b * 2048 + t0 + seg * 16);
      unsigned pk[16];
#pragma unroll
      for (int s = 0; s < 16; ++s) {
        if (!FINAL) {
          pk[s] = __float_as_uint(a_s[(seg * 16 + s) * 65 + ch]);
          P.au[(tok0 + s) * 512 + c0 + ch] = pk[s];
        } else {
          pk[s] = P.au[(tok0 + s) * 512 + c0 + ch];
        }
      }
      float Ap = 1.f, Hl = 0.f;
#pragma unroll
      for (int s = 0; s < 16; ++s) {
        const float a = 1.f - bflo(pk[s]), u = bfhi(pk[s]);
        Hl = a * Hl + u;
        Ap *= a;
      }
      segA[seg * 64 + ch] = Ap;
      segH[seg * 64 + ch] = Hl;
      __syncthreads();
      if (!FINAL) {
        if (seg == 0) {
          float Aa = 1.f, Hh = 0.f;
#pragma unroll
          for (int s = 0; s < 4; ++s) {
            Hh = segA[s * 64 + ch] * Hh + segH[s * 64 + ch];
            Aa *= segA[s * 64 + ch];
          }
          P.Acar[(b * 32 + tile) * 512 + c0 + ch] = Aa;
          P.Hcar[(b * 32 + tile) * 512 + c0 + ch] = Hh;
        }
      } else {
        float gate[16];
#pragma unroll
        for (int s = 0; s < 16; ++s) gate[s] = bf2f(P.p[(tok0 + s) * 1536 + 512 + c0 + ch]);
        float h = P.Hin[(b * 32 + tile) * 512 + c0 + ch];
#pragma unroll
        for (int s = 0; s < 3; ++s)
          if (s < seg) h = segA[s * 64 + ch] * h + segH[s * 64 + ch];
        float sqv[16];
#pragma unroll
        for (int s = 0; s < 16; ++s) {
          h = (1.f - bflo(pk[s])) * h + bfhi(pk[s]);
          const float yv = h * gelu_(gate[s]);
          sqv[s] = yv * yv;
          P.ycat[(tok0 + s) * 1024 + c0 + ch] = f2bf(yv);
        }
        {
          const bool hb = (lane & 32) != 0, b4 = (lane & 16) != 0, b3 = (lane & 8) != 0, b2 = (lane & 4) != 0;
#pragma unroll
          for (int i = 0; i < 8; ++i) { float sd = hb ? sqv[i] : sqv[i + 8], kp = hb ? sqv[i + 8] : sqv[i]; sqv[i] = kp + __shfl_xor(sd, 32); }
#pragma unroll
          for (int i = 0; i < 4; ++i) { float sd = b4 ? sqv[i] : sqv[i + 4], kp = b4 ? sqv[i + 4] : sqv[i]; sqv[i] = kp + __shfl_xor(sd, 16); }
#pragma unroll
          for (int i = 0; i < 2; ++i) { float sd = b3 ? sqv[i] : sqv[i + 2], kp = b3 ? sqv[i + 2] : sqv[i]; sqv[i] = kp + __shfl_xor(sd, 8); }
          { float sd = b2 ? sqv[0] : sqv[1], kp = b2 ? sqv[1] : sqv[0]; sqv[0] = kp + __shfl_xor(sd, 4); }
          sqv[0] += __shfl_xor(sqv[0], 2);
          sqv[0] += __shfl_xor(sqv[0], 1);
          if ((lane & 3) == 0) atomicAdd(P.ssa + tok0 + (lane >> 2), sqv[0]);
        }
      }
    }
  }
}

__device__ void carry_phase(const Params& P) {
  const int gt = blockIdx.x * 256 + threadIdx.x, nth = gridDim.x * 256;
  for (int i = gt; i < 16384 + 65536; i += nth) {
    if (i < 16384) {
      const int b = i >> 9, ch = i & 511;
      float h = 0.f;
      for (int t0 = 0; t0 < 32; t0 += 8) {
        float a[8], hh[8];
#pragma unroll
        for (int j = 0; j < 8; ++j) {
          a[j] = P.Acar[(b * 32 + t0 + j) * 512 + ch];
          hh[j] = P.Hcar[(b * 32 + t0 + j) * 512 + ch];
        }
#pragma unroll
        for (int j = 0; j < 8; ++j) {
          P.Hin[(b * 32 + t0 + j) * 512 + ch] = h;
          h = a[j] * h + hh[j];
        }
      }
    } else {
      const int k = i - 16384;
      const int pp = k & 63, g = (k >> 6) & 31, b = k >> 11;
      const float ar = P.A16[(g * 64 + pp) * 2], ai = P.A16[(g * 64 + pp) * 2 + 1];
      float hr = 0.f, hi = 0.f;
      for (int c0 = 0; c0 < 128; c0 += 8) {
        float er[8], ei[8];
#pragma unroll
        for (int j = 0; j < 8; ++j) {
          size_t base = ((size_t)(b * 128 + c0 + j) * 32 + g) * 128;
          er[j] = P.E[base + pp];
          ei[j] = P.E[base + 64 + pp];
        }
#pragma unroll
        for (int j = 0; j < 8; ++j) {
          size_t base = ((size_t)(b * 128 + c0 + j) * 32 + g) * 128;
          P.Hs[base + pp] = f2bf(hr);
          P.Hs[base + 64 + pp] = f2bf(hi);
          float nr = ar * hr - ai * hi + er[j], ni = ar * hi + ai * hr + ei[j];
          hr = nr; hi = ni;
        }
      }
    }
  }
}

template <bool YPH>
__device__ void s5_phase(const Params& P) {
  constexpr int MTW = YPH ? 4 : 2;
  const int tid = threadIdx.x, lane = tid & 63, w = tid >> 6;
  const int l15 = lane & 15, lq = lane >> 4;
  for (int item = blockIdx.x; item < 2048; item += gridDim.x) {
    const int g = ((item & 7) << 2) | ((item >> 3) & 3), cb = item >> 5;
    f32x4 acc[MTW][4];
#pragma unroll
    for (int i = 0; i < MTW; ++i)
#pragma unroll
      for (int j = 0; j < 4; ++j) acc[i][j] = (f32x4){0.f, 0.f, 0.f, 0.f};
    const u16* Am = YPH ? (P.MF + (size_t)g * 256 * 384) : (P.G + (size_t)g * 128 * 256);
    constexpr int LD = YPH ? 384 : 256;
    for (int ks = 0; ks < 8; ++ks) {
      bf16x8 bu[4];
#pragma unroll
      for (int nt = 0; nt < 4; ++nt) {
        const int Ncol = cb * 64 + nt * 16 + l15;
        const int b = Ncol >> 7, c = Ncol & 127;
        const int tau = ks * 2 + (lq >> 1), j0 = (lq & 1) * 8;
        bu[nt] = *(const bf16x8*)(P.p + ((size_t)(b * 2048 + c * 16 + tau)) * 1536 + 1024 + g * 16 + j0);
      }
#pragma unroll
      for (int mt = 0; mt < MTW; ++mt) {
        const int m = (w * MTW + mt) * 16 + l15;
        bf16x8 a = *(const bf16x8*)(Am + (size_t)m * LD + ks * 32 + lq * 8);
#pragma unroll
        for (int nt = 0; nt < 4; ++nt) acc[mt][nt] = MFMA16(a, bu[nt], acc[mt][nt]);
      }
    }
    if (YPH) {
      for (int ks = 0; ks < 4; ++ks) {
        bf16x8 bh[4];
#pragma unroll
        for (int nt = 0; nt < 4; ++nt) {
          const int Ncol = cb * 64 + nt * 16 + l15;
          bh[nt] = *(const bf16x8*)(P.Hs + ((size_t)Ncol * 32 + g) * 128 + ks * 32 + lq * 8);
        }
#pragma unroll
        for (int mt = 0; mt < MTW; ++mt) {
          const int m = (w * MTW + mt) * 16 + l15;
          bf16x8 a = *(const bf16x8*)(Am + (size_t)m * LD + 256 + ks * 32 + lq * 8);
#pragma unroll
          for (int nt = 0; nt < 4; ++nt) acc[mt][nt] = MFMA16(a, bh[nt], acc[mt][nt]);
        }
      }
    }
#pragma unroll
    for (int mt = 0; mt < MTW; ++mt)
#pragma unroll
      for (int nt = 0; nt < 4; ++nt) {
        const int Ncol = cb * 64 + nt * 16 + l15;
        f32x4 v = acc[mt][nt];
        if (!YPH) {
          const int m0 = (w * MTW + mt) * 16 + lq * 4;
          *(float4*)(P.E + ((size_t)Ncol * 32 + g) * 128 + m0) = make_float4(v[0], v[1], v[2], v[3]);
        } else {
          const int b = Ncol >> 7, c = Ncol & 127;
          const int tloc = w * MTW + mt;
          const size_t tok = (size_t)(b * 2048 + c * 16 + tloc);
          *(uint2*)(P.gs5 + tok * 512 + g * 16 + lq * 4) =
              make_uint2(pack2(gelu_(v[0]), gelu_(v[1])), pack2(gelu_(v[2]), gelu_(v[3])));
        }
      }
  }
}

__device__ __forceinline__ void top16_of_64(f32x16 (&acc)[4], int half, float (&res)[16]) {
  float g[4][16];
#pragma unroll
  for (int mt = 0; mt < 4; ++mt) {
#pragma unroll
    for (int i = 0; i < 16; ++i) {
      unsigned idx = mt * 32 + (i >> 2) * 8 + (i & 3);
      unsigned bits = (__float_as_uint(acc[mt][i]) & 0xffffff80u) | idx | (unsigned)(half * 4);
      g[mt][i] = __uint_as_float(bits);
    }
    sort16(g[mt]);
  }
  merge_top16(g[0], g[1]);
  merge_top16(g[2], g[3]);
  merge_top16(g[0], g[2]);
  float y[16];
#pragma unroll
  for (int i = 0; i < 16; ++i) y[i] = __shfl_xor(g[0][i], 32);
  merge_top16(g[0], y);
#pragma unroll
  for (int i = 0; i < 16; ++i) res[i] = g[0][i];
}
__host__ __device__ constexpr int cand_off(int i) {
  int s = 0;
  for (int q = 0; q < i; ++q) s += 16 / (q + 1);
  return s;
}

__device__ void cand_phase(const Params& P, char* smem) {
  const int tid = threadIdx.x;
  unsigned char* lut = (unsigned char*)smem + tid * 36;
  for (int gi = blockIdx.x * 256 + tid; gi < T_TOK * 8; gi += gridDim.x * 256) {
    const size_t tok = (size_t)(gi >> 3);
    const int head = gi & 7;
    float a[16], bl[16];
    {
      const float4* src = (const float4*)(P.t16 + (size_t)gi * 32);
#pragma unroll
      for (int i = 0; i < 4; ++i) {
        const float4 t = src[i], u = src[4 + i];
        a[i * 4] = t.x; a[i * 4 + 1] = t.y; a[i * 4 + 2] = t.z; a[i * 4 + 3] = t.w;
        bl[i * 4] = u.x; bl[i * 4 + 1] = u.y; bl[i * 4 + 2] = u.z; bl[i * 4 + 3] = u.w;
      }
    }
    float va[16], vb[16];
#pragma unroll
    for (int i = 0; i < 16; ++i) {
      va[i] = __uint_as_float(__float_as_uint(a[i]) & 0xffffff80u);
      vb[i] = __uint_as_float(__float_as_uint(bl[i]) & 0xffffff80u);
    }
    float cg4[4][16];
#pragma unroll
    for (int i = 0; i < 4; ++i)
#pragma unroll
      for (int j = 0; j < 16; ++j) cg4[i][j] = __uint_as_float(0xff800000u);
#pragma unroll
    for (int i = 0; i < 16; ++i)
#pragma unroll
      for (int j = 0; j < 16; ++j)
        if ((i + 1) * (j + 1) <= 16) {
          const int pos = cand_off(i) + j;
          float sm = va[i] + vb[j];
          cg4[pos >> 4][pos & 15] = __uint_as_float((__float_as_uint(sm) & 0xffffff00u) | (unsigned)(i * 16 + j));
        }
#pragma unroll
    for (int i = 0; i < 4; ++i) sort16(cg4[i]);
    merge_top16(cg4[0], cg4[1]);
    merge_top16(cg4[2], cg4[3]);
    merge_top16(cg4[0], cg4[2]);
    {
      unsigned* lw = (unsigned*)lut;
#pragma unroll
      for (int i = 0; i < 4; ++i) {
        lw[i] = (__float_as_uint(a[i * 4]) & 127u) | ((__float_as_uint(a[i * 4 + 1]) & 127u) << 8) |
                ((__float_as_uint(a[i * 4 + 2]) & 127u) << 16) | ((__float_as_uint(a[i * 4 + 3]) & 127u) << 24);
        lw[4 + i] = (__float_as_uint(bl[i * 4]) & 127u) | ((__float_as_uint(bl[i * 4 + 1]) & 127u) << 8) |
                    ((__float_as_uint(bl[i * 4 + 2]) & 127u) << 16) | ((__float_as_uint(bl[i * 4 + 3]) & 127u) << 24);
      }
    }
    float sc[16];
    int ee[16];
    const float mx = __uint_as_float(__float_as_uint(cg4[0][0]) & 0xffffff00u);
    float ssum = 0.f;
#pragma unroll
    for (int k = 0; k < 16; ++k) {
      unsigned bits = __float_as_uint(cg4[0][k]);
      unsigned code = bits & 255u;
      float v = __uint_as_float(bits & 0xffffff00u);
      sc[k] = __expf(v - mx);
      ssum += sc[k];
      int i1 = lut[code >> 4], i2 = lut[16 + (code & 15u)];
      ee[k] = i1 * 128 + i2;
    }
    const float inv = 1.f / ssum;
    int4* de = (int4*)(P.eidx + tok * 128 + head * 16);
    float4* ds = (float4*)(P.suv + tok * 128 + head * 16);
    float4* dg = (float4*)(P.gw + tok * 128 + head * 16);
#pragma unroll
    for (int i = 0; i < 4; ++i) {
      de[i] = make_int4(ee[i * 4], ee[i * 4 + 1], ee[i * 4 + 2], ee[i * 4 + 3]);
      ds[i] = make_float4(P.su[ee[i * 4]], P.su[ee[i * 4 + 1]], P.su[ee[i * 4 + 2]], P.su[ee[i * 4 + 3]]);
      dg[i] = make_float4(sc[i * 4] * inv * P.sv[ee[i * 4]], sc[i * 4 + 1] * inv * P.sv[ee[i * 4 + 1]],
                          sc[i * 4 + 2] * inv * P.sv[ee[i * 4 + 2]], sc[i * 4 + 3] * inv * P.sv[ee[i * 4 + 3]]);
    }
  }
}

typedef float f2v __attribute__((ext_vector_type(2)));
__device__ __forceinline__ float dot16_fp8(uint4 u, const f2v* x) {
  f2v acc = {0.f, 0.f};
  acc = __builtin_amdgcn_cvt_pk_f32_fp8(u.x, false) * x[0] + acc;
  acc = __builtin_amdgcn_cvt_pk_f32_fp8(u.x, true) * x[1] + acc;
  acc = __builtin_amdgcn_cvt_pk_f32_fp8(u.y, false) * x[2] + acc;
  acc = __builtin_amdgcn_cvt_pk_f32_fp8(u.y, true) * x[3] + acc;
  acc = __builtin_amdgcn_cvt_pk_f32_fp8(u.z, false) * x[4] + acc;
  acc = __builtin_amdgcn_cvt_pk_f32_fp8(u.z, true) * x[5] + acc;
  acc = __builtin_amdgcn_cvt_pk_f32_fp8(u.w, false) * x[6] + acc;
  acc = __builtin_amdgcn_cvt_pk_f32_fp8(u.w, true) * x[7] + acc;
  return acc.x + acc.y;
}
__device__ __forceinline__ void axpy16_fp8(f2v* o, float wgt, uint4 v) {
  const f2v ww = {wgt, wgt};
  o[0] = __builtin_amdgcn_cvt_pk_f32_fp8(v.x, false) * ww + o[0];
  o[1] = __builtin_amdgcn_cvt_pk_f32_fp8(v.x, true) * ww + o[1];
  o[2] = __builtin_amdgcn_cvt_pk_f32_fp8(v.y, false) * ww + o[2];
  o[3] = __builtin_amdgcn_cvt_pk_f32_fp8(v.y, true) * ww + o[3];
  o[4] = __builtin_amdgcn_cvt_pk_f32_fp8(v.z, false) * ww + o[4];
  o[5] = __builtin_amdgcn_cvt_pk_f32_fp8(v.z, true) * ww + o[5];
  o[6] = __builtin_amdgcn_cvt_pk_f32_fp8(v.w, false) * ww + o[6];
  o[7] = __builtin_amdgcn_cvt_pk_f32_fp8(v.w, true) * ww + o[7];
}

__device__ void peer_phase(const Params& P) {
  const int lane = threadIdx.x & 63;
  const int w = __builtin_amdgcn_readfirstlane(threadIdx.x >> 6);
  const int gwv = blockIdx.x * 4 + w, nw = gridDim.x * 4;
  const bool hb = (lane & 32) != 0, b4 = (lane & 16) != 0, b3 = (lane & 8) != 0;
  float4 g2v[4];
#pragma unroll
  for (int c = 0; c < 4; ++c) g2v[c] = *(const float4*)(P.norm2_g + lane * 16 + c * 4);
  float4 hn[4];
  if (gwv < T_TOK) {
#pragma unroll
    for (int c = 0; c < 4; ++c) hn[c] = *(const float4*)(P.out + (size_t)gwv * 1024 + lane * 16 + c * 4);
  }
  for (int tok = gwv; tok < T_TOK; tok += nw) {
    float4 hc[4];
#pragma unroll
    for (int c = 0; c < 4; ++c) hc[c] = hn[c];
    {
      const int ntok = (tok + nw < T_TOK) ? tok + nw : tok;
#pragma unroll
      for (int c = 0; c < 4; ++c) hn[c] = *(const float4*)(P.out + (size_t)ntok * 1024 + lane * 16 + c * 4);
    }
    const int* ep = P.eidx + (size_t)tok * 128;
    const float* gp = P.gw + (size_t)tok * 128;
    const float* sp = P.suv + (size_t)tok * 128;
    uint4 uA[8], uB[8];
    float suA, gA, suB, gB;
    int elA, elB;
#define LOADU(U, SU, G, EL, kb) { _Pragma("unroll") for (int j = 0; j < 8; ++j) { const int e = ep[(kb) + j]; \
        U[j] = *(const uint4*)(P.U8 + (size_t)e * 1024 + lane * 16); } \
      SU = sp[(kb) + (lane >> 3)]; G = gp[(kb) + (lane >> 3)]; EL = ep[(kb) + (lane >> 3)]; }
    LOADU(uA, suA, gA, elA, 0)
    __builtin_amdgcn_sched_barrier(0);
    float ss = 0.f;
#pragma unroll
    for (int c = 0; c < 4; ++c) ss += hc[c].x * hc[c].x + hc[c].y * hc[c].y + hc[c].z * hc[c].z + hc[c].w * hc[c].w;
    ss = wsum(ss);
    const float rstd2 = rsqrtf(ss * (1.f / 1024.f) + EPSF);
    f2v xn[8];
#pragma unroll
    for (int c = 0; c < 4; ++c) {
      xn[c * 2 + 0] = (f2v){hc[c].x * rstd2 * g2v[c].x, hc[c].y * rstd2 * g2v[c].y};
      xn[c * 2 + 1] = (f2v){hc[c].z * rstd2 * g2v[c].z, hc[c].w * rstd2 * g2v[c].w};
    }
#define PROCU(U, SU, G, EL, kb) { float d[8]; \
      _Pragma("unroll") for (int j = 0; j < 8; ++j) d[j] = dot16_fp8(U[j], xn); \
      _Pragma("unroll") for (int i = 0; i < 4; ++i) { float send = hb ? d[i] : d[i + 4], keep = hb ? d[i + 4] : d[i]; d[i] = keep + __shfl_xor(send, 32); } \
      _Pragma("unroll") for (int i = 0; i < 2; ++i) { float send = b4 ? d[i] : d[i + 2], keep = b4 ? d[i + 2] : d[i]; d[i] = keep + __shfl_xor(send, 16); } \
      { float send = b3 ? d[0] : d[1], keep = b3 ? d[1] : d[0]; d[0] = keep + __shfl_xor(send, 8); } \
      d[0] += __shfl_xor(d[0], 4); d[0] += __shfl_xor(d[0], 2); d[0] += __shfl_xor(d[0], 1); \
      const float act = gelu_(d[0] * SU) * G; \
      if ((lane & 7) == 0) ((unsigned*)P.wact)[(size_t)tok * 128 + (kb) + (lane >> 3)] = ((unsigned)f2bf(act) << 16) | (unsigned)EL; }
    for (int k0 = 0; k0 < 128; k0 += 16) {
      LOADU(uB, suB, gB, elB, k0 + 8)
      __builtin_amdgcn_sched_barrier(0);
      PROCU(uA, suA, gA, elA, k0)
      { const int kn = (k0 + 16 < 128) ? k0 + 16 : 112; LOADU(uA, suA, gA, elA, kn) }
      __builtin_amdgcn_sched_barrier(0);
      PROCU(uB, suB, gB, elB, k0 + 8)
    }
  }
}

__device__ void udot_phase(const Params& P) {
  const int my_xcc = (int)((unsigned)__builtin_amdgcn_s_getreg((3 << 11) | 20) & 7u), my_rank = P.rank[blockIdx.x];
  const int lane = threadIdx.x & 63, w = threadIdx.x >> 6;
  const int r = lane >> 3, c = lane & 7;
  const bool b2 = (lane & 4) != 0, b1 = (lane & 2) != 0, b0 = (lane & 1) != 0;
  int cen_ok = 1, cen_sum = 0, cen_mine = 0;
#pragma unroll
  for (int x = 0; x < 8; ++x) {
    const int cx = (int)__hip_atomic_load(P.bar + 15 * 512 + x * 32, __ATOMIC_RELAXED, __HIP_MEMORY_SCOPE_AGENT);
    cen_ok &= (cx > 0); cen_sum += cx; if (x == my_xcc) cen_mine = cx;
  }
  const bool fast = cen_ok && cen_sum == (int)gridDim.x;
  const int nwt = fast ? cen_mine * 4 : (int)gridDim.x * 4;
  const int wv = fast ? my_rank * 4 + w : (int)blockIdx.x * 4 + w;
  const int total = fast ? T_TOK : T_TOK * 8;
  const int cnt = (wv < total) ? (total - wv + nwt - 1) / nwt : 0;
  if (cnt == 0) return;
  const int slf = my_xcc;
#define UTOK(n, SL, TK) { int it_ = wv + ((n) < cnt ? (n) : cnt - 1) * nwt; SL = fast ? slf : (it_ & 7); TK = fast ? it_ : (it_ >> 3); }
#define ULOADE(E, n) { int sl_, tk_; UTOK(n, sl_, tk_) (void)sl_; const uint4* ep_ = (const uint4*)(P.eidx + (size_t)tk_ * 128 + r * 16); \
      _Pragma("unroll") for (int i = 0; i < 4; ++i) E[i] = ep_[i]; }
#define UGATHER(V, E, n) { int sl_, tk_; UTOK(n, sl_, tk_) (void)tk_; const unsigned char* ub_ = P.U8 + (size_t)sl_ * (16384 * 128) + c * 16; \
      _Pragma("unroll") for (int i = 0; i < 4; ++i) { \
        V[i * 4 + 0] = *(const uint4*)(ub_ + (size_t)E[i].x * 128); V[i * 4 + 1] = *(const uint4*)(ub_ + (size_t)E[i].y * 128); \
        V[i * 4 + 2] = *(const uint4*)(ub_ + (size_t)E[i].z * 128); V[i * 4 + 3] = *(const uint4*)(ub_ + (size_t)E[i].w * 128); } }
#define UHLOAD(H, S2, n) { int sl_, tk_; UTOK(n, sl_, tk_) const u16* hp_ = P.hb + (size_t)tk_ * 1024 + sl_ * 128 + c * 16; \
      H[0] = *(const float4*)hp_; H[1] = *(const float4*)(hp_ + 8);     (void)S2; }
#define UPROC(V, H, S2, n) { int sl_, tk_; UTOK(n, sl_, tk_) \
      f2v xn_[8]; \
      _Pragma("unroll") for (int i = 0; i < 2; ++i) { \
        const unsigned u0_ = __float_as_uint(H[i].x), u1_ = __float_as_uint(H[i].y), u2_ = __float_as_uint(H[i].z), u3_ = __float_as_uint(H[i].w); \
        xn_[i * 4] = (f2v){bflo(u0_), bfhi(u0_)}; xn_[i * 4 + 1] = (f2v){bflo(u1_), bfhi(u1_)}; \
        xn_[i * 4 + 2] = (f2v){bflo(u2_), bfhi(u2_)}; xn_[i * 4 + 3] = (f2v){bflo(u3_), bfhi(u3_)}; } \
      float d[16]; _Pragma("unroll") for (int i = 0; i < 16; ++i) d[i] = dot16_fp8(V[i], xn_); \
      _Pragma("unroll") for (int i = 0; i < 8; ++i) { float sd = b2 ? d[i] : d[i + 8], kp = b2 ? d[i + 8] : d[i]; d[i] = kp + __shfl_xor(sd, 4); } \
      _Pragma("unroll") for (int i = 0; i < 4; ++i) { float sd = b1 ? d[i] : d[i + 4], kp = b1 ? d[i + 4] : d[i]; d[i] = kp + __shfl_xor(sd, 2); } \
      _Pragma("unroll") for (int i = 0; i < 2; ++i) { float sd = b0 ? d[i] : d[i + 2], kp = b0 ? d[i + 2] : d[i]; d[i] = kp + __shfl_xor(sd, 1); } \
      __builtin_nontemporal_store(pack2(d[0], d[1]), (unsigned*)P.part + ((size_t)sl_ * T_TOK + tk_) * 64 + lane); }
  uint4 eA[4], eB[4];
  uint4 vA[16], vB[16];
  ULOADE(eA, 0)
  ULOADE(eB, 1)
  UGATHER(vA, eA, 0)
  __builtin_amdgcn_sched_barrier(0);
  for (int n = 0; n < cnt; n += 2) {
    { float4 h_[4]; float s2_ = 0.f; UHLOAD(h_, s2_, n) UGATHER(vB, eB, n + 1) ULOADE(eA, n + 2)
      __builtin_amdgcn_sched_barrier(0); UPROC(vA, h_, s2_, n) }
    if (n + 1 < cnt) {
      float4 h_[4]; float s2_ = 0.f; UHLOAD(h_, s2_, n + 1) UGATHER(vA, eA, n + 2) ULOADE(eB, n + 3)
      __builtin_amdgcn_sched_barrier(0); UPROC(vB, h_, s2_, n + 1)
    }
  }
}

__device__ void ucomb_phase(const Params& P) {
  const size_t gt = (size_t)blockIdx.x * 256 + threadIdx.x, nt = (size_t)gridDim.x * 256;
  for (size_t i = gt; i < (size_t)T_TOK * 32; i += nt) {
    float4 a = make_float4(0.f, 0.f, 0.f, 0.f);
#pragma unroll
    for (int sl = 0; sl < 8; ++sl) {
      const uint2 b = ((const uint2*)P.part)[(size_t)sl * T_TOK * 32 + i];
      a.x += bflo(b.x); a.y += bfhi(b.x); a.z += bflo(b.y); a.w += bfhi(b.y);
    }
    float4 su = ((const float4*)P.suv)[i]; const float4 g = ((const float4*)P.gw)[i];
    { const float r2 = rsqrtf(P.ss2[i >> 5] * (1.f / 1024.f) + EPSF); su.x *= r2; su.y *= r2; su.z *= r2; su.w *= r2; }
    const int4 e = ((const int4*)P.eidx)[i];
    uint4 o;
    o.x = ((unsigned)f2bf(gelu_(a.x * su.x) * g.x) << 16) | (unsigned)e.x;
    o.y = ((unsigned)f2bf(gelu_(a.y * su.y) * g.y) << 16) | (unsigned)e.y;
    o.z = ((unsigned)f2bf(gelu_(a.z * su.z) * g.z) << 16) | (unsigned)e.z;
    o.w = ((unsigned)f2bf(gelu_(a.w * su.w) * g.w) << 16) | (unsigned)e.w;
    ((uint4*)P.wact)[i] = o;
  }
}

__device__ void vacc_phase(const Params& P) {
  const int my_xcc = (int)((unsigned)__builtin_amdgcn_s_getreg((3 << 11) | 20) & 7u), my_rank = P.rank[blockIdx.x];
  const int lane = threadIdx.x & 63, w = threadIdx.x >> 6;
  const int r = lane >> 3, c = lane & 7;
  const bool hb = (lane & 32) != 0, b4 = (lane & 16) != 0, b3 = (lane & 8) != 0;
  int cen_ok = 1, cen_sum = 0, cen_mine = 0;
#pragma unroll
  for (int x = 0; x < 8; ++x) {
    const int cx = (int)__hip_atomic_load(P.bar + 15 * 512 + x * 32, __ATOMIC_RELAXED, __HIP_MEMORY_SCOPE_AGENT);
    cen_ok &= (cx > 0); cen_sum += cx; if (x == my_xcc) cen_mine = cx;
  }
  const bool fast = cen_ok && cen_sum == (int)gridDim.x;
  const int nwt = fast ? cen_mine * 4 : (int)gridDim.x * 4;
  const int wv = fast ? my_rank * 4 + w : (int)blockIdx.x * 4 + w;
  const int total = fast ? T_TOK : T_TOK * 8;
  const int cnt = (wv < total) ? (total - wv + nwt - 1) / nwt : 0;
  if (cnt == 0) return;
  const int slf = my_xcc;
#define VTOK(n, SL, TK) { int it_ = wv + ((n) < cnt ? (n) : cnt - 1) * nwt; SL = fast ? slf : (it_ & 7); TK = fast ? it_ : (it_ >> 3); }
#define VLOADEW(E, W, n) { int sl_, tk_; VTOK(n, sl_, tk_) (void)sl_; \
      const uint4* ep_ = (const uint4*)(P.wact + (size_t)tk_ * 128 + r * 16); \
      _Pragma("unroll") for (int i = 0; i < 4; ++i) { E[i] = ep_[i]; } }
#define VGATHER(V, E, n) { int sl_, tk_; VTOK(n, sl_, tk_) (void)tk_; const unsigned char* vb_ = P.V8 + (size_t)sl_ * (16384 * 128) + c * 16; \
      _Pragma("unroll") for (int i = 0; i < 4; ++i) { \
        V[i * 4 + 0] = *(const uint4*)(vb_ + (size_t)(E[i].x & 0xffffu) * 128); V[i * 4 + 1] = *(const uint4*)(vb_ + (size_t)(E[i].y & 0xffffu) * 128); \
        V[i * 4 + 2] = *(const uint4*)(vb_ + (size_t)(E[i].z & 0xffffu) * 128); V[i * 4 + 3] = *(const uint4*)(vb_ + (size_t)(E[i].w & 0xffffu) * 128); } }
#define VPROC(V, W, HV, n) { int sl_, tk_; VTOK(n, sl_, tk_) \
      f2v o[8]; _Pragma("unroll") for (int i = 0; i < 8; ++i) o[i] = (f2v){0.f, 0.f}; \
      _Pragma("unroll") for (int i = 0; i < 4; ++i) { axpy16_fp8(o, bfhi(W[i].x), V[i * 4 + 0]); axpy16_fp8(o, bfhi(W[i].y), V[i * 4 + 1]); \
        axpy16_fp8(o, bfhi(W[i].z), V[i * 4 + 2]); axpy16_fp8(o, bfhi(W[i].w), V[i * 4 + 3]); } \
      float f[16]; _Pragma("unroll") for (int i = 0; i < 8; ++i) { f[i * 2] = o[i].x; f[i * 2 + 1] = o[i].y; } \
      _Pragma("unroll") for (int i = 0; i < 8; ++i) { float sd = hb ? f[i] : f[i + 8], kp = hb ? f[i + 8] : f[i]; f[i] = kp + __shfl_xor(sd, 32); } \
      _Pragma("unroll") for (int i = 0; i < 4; ++i) { float sd = b4 ? f[i] : f[i + 4], kp = b4 ? f[i + 4] : f[i]; f[i] = kp + __shfl_xor(sd, 16); } \
      _Pragma("unroll") for (int i = 0; i < 2; ++i) { float sd = b3 ? f[i] : f[i + 2], kp = b3 ? f[i + 2] : f[i]; f[i] = kp + __shfl_xor(sd, 8); } \
      (void)HV; *(unsigned*)(P.hb + (size_t)tk_ * 1024 + sl_ * 128 + c * 16 + r * 2) = pack2(f[0], f[1]); }
#define VHLOAD(HV, n) { HV = make_float2(0.f, 0.f); }
#define IT2(VC, EC, VN, EN, n) { float2 hv0_; VHLOAD(hv0_, n) VGATHER(VN, EN, (n) + 1) VLOADEW(eC, eC, (n) + 2) \
      __builtin_amdgcn_sched_barrier(0); VPROC(VC, EC, hv0_, n) \
      _Pragma("unroll") for (int i = 0; i < 4; ++i) EC[i] = eC[i]; }
  uint4 eA[4], eB[4], eC[4];
  uint4 vA[16], vB[16];
  VLOADEW(eA, eA, 0)
  VLOADEW(eB, eB, 1)
  VGATHER(vA, eA, 0)
  __builtin_amdgcn_sched_barrier(0);
  for (int n = 0; n < cnt; n += 2) {
    IT2(vA, eA, vB, eB, n)
    if (n + 1 < cnt) IT2(vB, eB, vA, eA, n + 1)
  }
}

__device__ void final_phase(const Params& P) {
  const int lane = threadIdx.x & 63, w = threadIdx.x >> 6;
  const int gwv = blockIdx.x * 4 + w, nw = gridDim.x * 4;
  float4 g[4];
#pragma unroll
  for (int c = 0; c < 4; ++c) g[c] = *(const float4*)(P.normf_g + lane * 16 + c * 4);
  for (int tok = gwv; tok < T_TOK; tok += nw) {
    float* hrow = P.out + (size_t)tok * 1024 + lane * 16;
    const u16* orow = P.hb + (size_t)tok * 1024 + lane * 16;
    float4 v[4];
#pragma unroll
    for (int c = 0; c < 4; ++c) v[c] = *(const float4*)(hrow + c * 4);
    const uint4 o0 = *(const uint4*)orow, o1 = *(const uint4*)(orow + 8);
    v[0].x += bflo(o0.x); v[0].y += bfhi(o0.x); v[0].z += bflo(o0.y); v[0].w += bfhi(o0.y);
    v[1].x += bflo(o0.z); v[1].y += bfhi(o0.z); v[1].z += bflo(o0.w); v[1].w += bfhi(o0.w);
    v[2].x += bflo(o1.x); v[2].y += bfhi(o1.x); v[2].z += bflo(o1.y); v[2].w += bfhi(o1.y);
    v[3].x += bflo(o1.z); v[3].y += bfhi(o1.z); v[3].z += bflo(o1.w); v[3].w += bfhi(o1.w);
    float ss = 0.f;
#pragma unroll
    for (int c = 0; c < 4; ++c) ss += v[c].x * v[c].x + v[c].y * v[c].y + v[c].z * v[c].z + v[c].w * v[c].w;
    ss = wsum(ss);
    const float rf = rsqrtf(ss * (1.f / 1024.f) + EPSF);
#pragma unroll
    for (int c = 0; c < 4; ++c)
      *(float4*)(hrow + c * 4) = make_float4(v[c].x * rf * g[c].x, v[c].y * rf * g[c].y, v[c].z * rf * g[c].z, v[c].w * rf * g[c].w);
  }
}

__device__ __forceinline__ void gbar(unsigned* bar, int k) {
  asm volatile("s_waitcnt vmcnt(0)" ::: "memory");
  __syncthreads();
  if (threadIdx.x == 0) {
    unsigned* base = bar + k * 512;
    const unsigned g = blockIdx.x & 7u;
    const unsigned gsz = (gridDim.x - g + 7u) >> 3;
    const unsigned ngroups = gridDim.x < 8u ? gridDim.x : 8u;
    __builtin_amdgcn_fence(__ATOMIC_RELEASE, "agent");
    asm volatile("s_waitcnt vmcnt(0)" ::: "memory");
    const unsigned old = __hip_atomic_fetch_add(base + g * 32, 1u, __ATOMIC_RELAXED, __HIP_MEMORY_SCOPE_AGENT);
    if (old == gsz - 1u) __hip_atomic_fetch_add(base + 256, 1u, __ATOMIC_RELAXED, __HIP_MEMORY_SCOPE_AGENT);
    unsigned spins = 0;
    while (__hip_atomic_load(base + 256, __ATOMIC_RELAXED, __HIP_MEMORY_SCOPE_AGENT) < ngroups && spins < (1u << 22)) {
      __builtin_amdgcn_s_sleep(1);
      ++spins;
    }
    __builtin_amdgcn_fence(__ATOMIC_ACQUIRE, "agent");
    asm volatile("s_waitcnt vmcnt(0)" ::: "memory");
  }
  __syncthreads();
}

#define SMEM_BYTES 74752

template <int PH>
__device__ __forceinline__ void run_phase(const Params& P, char* smem) {
  if (PH == 0) phase_prep(P, smem);
  if (PH == 1) gemm256_phase<EPI_INPROJ>(P, smem, P.xb, P.WinT, T_TOK, 1536, 1024);
  if (PH == 2) { lru_phase<false>(P, smem); s5_phase<false>(P); }
  if (PH == 3) carry_phase(P);
  if (PH == 4) { lru_phase<true>(P, smem); s5_phase<true>(P); }
  if (PH == 5) gemm_phase<EPI_GLU>(P, smem, P.gs5, P.GluT, T_TOK, 512, 512);
  if (PH == 6) gemm256_phase<EPI_OUT>(P, smem, P.ycat, P.WoutT, T_TOK, 1024, 1024);
  if (PH == 7) gemm_phase<EPI_Q>(P, smem, P.hb, P.WqT, T_TOK, 2048, 1024);
  if (PH == 8) cand_phase(P, smem);
  if (PH == 9) udot_phase(P);
  if (PH == 10) ucomb_phase(P);
  if (PH == 11) vacc_phase(P);
  if (PH == 12) final_phase(P);
}

template <int LO, int HI>
__global__ void __launch_bounds__(256, 2) mk(Params P) {
  __shared__ __attribute__((aligned(16))) char smem[SMEM_BYTES];
  cg::grid_group grid = cg::this_grid();
#ifndef REPEAT_MASK
#define REPEAT_MASK 0
#endif
#define PHASE(n) if (LO <= n && n <= HI) { if ((REPEAT_MASK >> n) & 1) { run_phase<n>(P, smem); grid.sync(); } run_phase<n>(P, smem); if (n < HI) gbar(P.bar, n); }
  if (threadIdx.x == 0) {
    const unsigned xcc = (unsigned)__builtin_amdgcn_s_getreg((3 << 11) | 20) & 7u;
    const unsigned rk = __hip_atomic_fetch_add(P.bar + 15 * 512 + xcc * 32, 1u, __ATOMIC_RELAXED, __HIP_MEMORY_SCOPE_AGENT);
    P.rank[blockIdx.x] = (int)rk;
  }
  if (P.bar == nullptr) grid.sync();
  PHASE(0) PHASE(1) PHASE(2) PHASE(3) PHASE(4) PHASE(5) PHASE(6) PHASE(7) PHASE(8) PHASE(9) PHASE(10) PHASE(11) PHASE(12)
}

extern "C" void kernel_launch(void* const* d_in, const int* in_sizes, int n_in, void* d_out, int out_size,
                              void* d_ws, size_t ws_size, hipStream_t stream) {
  Params P{};
  const float** pin = (const float**)&P;
  for (int i = 0; i < 30; ++i) pin[i] = (const float*)d_in[i];
  P.out = (float*)d_out;
  char* ws = (char*)d_ws;
  size_t off = 0;
  auto take = [&](size_t bytes) { char* r = ws + off; off += (bytes + 255) & ~(size_t)255; return r; };
  const size_t MB = 1024 * 1024;
  char* RA = take(128 * MB);
  char* RB = take(256 * MB);
  char* RC = take(128 * MB);
  char* RD = take(96 * MB);
  P.xb = (u16*)RA; P.ycat = (u16*)RA;
  P.p = (u16*)RB; P.q = (u16*)RB;
  P.E = (float*)RC; P.Hs = (u16*)(RC + 64 * MB); P.hb = (u16*)RC;
  P.gs5 = (u16*)RD; P.eidx = (int*)RD; P.gw = (float*)(RD + 32 * MB); P.suv = (float*)(RD + 64 * MB);
  P.U8 = (unsigned char*)take(16 * MB); P.V8 = (unsigned char*)take(16 * MB);
  P.su = (float*)take(16384 * 4); P.sv = (float*)take(16384 * 4);
  P.WinT = (u16*)take(1536 * 1024 * 2); P.GluT = (u16*)take(512 * 512 * 2);
  P.WoutT = (u16*)take(1024 * 1024 * 2); P.WqT = (u16*)take(2048 * 1024 * 2);
  P.K1b = (u16*)take(128 * 128 * 2); P.K2b = (u16*)take(128 * 128 * 2);
  P.WaT = (u16*)take(8 * 4096 * 2); P.WxT = (u16*)take(8 * 4096 * 2);
  P.MF = (u16*)take(32 * 256 * 384 * 2); P.G = (u16*)take(32 * 128 * 256 * 2);
  P.spv = (float*)take(512 * 4);
  P.ssf = (float*)take(T_TOK * 4); P.wact = (float*)RA; P.part = (float*)RB; P.t16 = (float*)RB;
  P.ssa = (float*)take(T_TOK * 4); P.ssb = (float*)take(T_TOK * 4); P.ss2 = (float*)take(T_TOK * 4);
  P.rstd1 = (float*)take(T_TOK * 4); P.A16 = (float*)take(32 * 64 * 2 * 4);
  P.Acar = (float*)take(32 * 32 * 512 * 4); P.Hcar = (float*)take(32 * 32 * 512 * 4); P.Hin = (float*)take(32 * 32 * 512 * 4);

  P.bar = (unsigned*)take(16 * 2048);
  P.au = (unsigned*)take((size_t)T_TOK * 512 * 4);
  P.rank = (int*)take(4096 * 4);
  static int grid_blocks = 0;
#if ONE_LAUNCH
  (void)hipMemsetAsync(P.bar, 0, 16 * 2048, stream);
  if (!grid_blocks) {
    int dev = 0, cus = 0, per_cu = 0;
    (void)hipGetDevice(&dev);
    (void)hipDeviceGetAttribute(&cus, hipDeviceAttributeMultiprocessorCount, dev);
    (void)hipOccupancyMaxActiveBlocksPerMultiprocessor(&per_cu, mk<0, NPHASE - 1>, 256, 0);
    if (per_cu > 2) per_cu = 2;
    if (per_cu < 1) per_cu = 1;
    grid_blocks = cus * per_cu;
  }
  void* args[] = {&P};
  hipError_t e = hipLaunchCooperativeKernel((void*)mk<0, NPHASE - 1>, dim3(grid_blocks), dim3(256), args, 0, stream);
  if (e != hipSuccess) fprintf(stderr, "cooperative launch failed: %s (grid %d)\n", hipGetErrorString(e), grid_blocks);
#else
  if (!grid_blocks) {
    int dev = 0, cus = 0;
    (void)hipGetDevice(&dev);
    (void)hipDeviceGetAttribute(&cus, hipDeviceAttributeMultiprocessorCount, dev);
    grid_blocks = cus * 2;
  }
  mk<0, 0><<<grid_blocks, 256, 0, stream>>>(P);
  mk<1, 1><<<grid_blocks, 256, 0, stream>>>(P);
  mk<2, 2><<<grid_blocks, 256, 0, stream>>>(P);
  mk<3, 3><<<grid_blocks, 256, 0, stream>>>(P);
  mk<4, 4><<<grid_blocks, 256, 0, stream>>>(P);
  mk<5, 5><<<grid_blocks, 256, 0, stream>>>(P);
  mk<6, 6><<<grid_blocks, 256, 0, stream>>>(P);
  mk<7, 7><<<grid_blocks, 256, 0, stream>>>(P);
  mk<8, 8><<<grid_blocks, 256, 0, stream>>>(P);
  mk<9, 9><<<grid_blocks, 256, 0, stream>>>(P);
#endif
}
```

```cpp
#include <hip/hip_runtime.h>
#include <hip/hip_cooperative_groups.h>
#include <cstdio>
namespace cg = cooperative_groups;

typedef unsigned short u16;
using bf16x8 = __attribute__((ext_vector_type(8))) short;
using f32x4 = __attribute__((ext_vector_type(4))) float;
using f32x16 = __attribute__((ext_vector_type(16))) float;

#ifndef ONE_LAUNCH
#define ONE_LAUNCH 1
#endif

#define T_TOK 65536
#define EPSF 1e-6f
#define NPHASE 13

struct Params {
  const float *x, *norm1_g, *w_in, *conv_w, *conv_b, *lru_wa, *lru_ba, *lru_wx, *lru_bx, *lru_lambda;
  const float *s5_lre, *s5_lim, *s5_logdt, *s5_bre, *s5_bim, *s5_cre, *s5_cim, *s5_d, *glu_w, *glu_b;
  const float *gnorm_lru, *gnorm_s5, *w_out, *norm2_g, *wq, *k1, *k2, *pu, *pv, *normf_g;
  float* out;
  u16 *xb, *WinT, *GluT, *WoutT, *WqT, *K1b, *K2b, *Ub, *Vb, *WaT, *WxT, *MF, *G, *p, *Hs, *ycat, *gs5, *hb, *q;
  float *rstd1, *A16, *Acar, *Hcar, *Hin, *E, *gw, *suv, *su, *sv, *ssa, *ssb, *ss2, *ssf, *wact, *part, *spv, *t16;
  int* eidx;
  unsigned char *U8, *V8;
  unsigned* bar;
  unsigned* au;
  int* rank;
};

__device__ __forceinline__ u16 f2bf(float f) {
  unsigned u = __float_as_uint(f);
  u += 0x7fffu + ((u >> 16) & 1u);
  return (u16)(u >> 16);
}
__device__ __forceinline__ float bf2f(u16 h) { return __uint_as_float(((unsigned)h) << 16); }
__device__ __forceinline__ unsigned pack2(float a, float b) { return (unsigned)f2bf(a) | (((unsigned)f2bf(b)) << 16); }
__device__ __forceinline__ float bflo(unsigned u) { return __uint_as_float(u << 16); }
__device__ __forceinline__ float bfhi(unsigned u) { return __uint_as_float(u & 0xffff0000u); }
__device__ __forceinline__ float sigmoid_(float x) { return __builtin_amdgcn_rcpf(1.f + __expf(-x)); }
__device__ __forceinline__ float gelu_(float x) {
  float z = 0.7978845608028654f * (x + 0.044715f * x * x * x);
  return x * __builtin_amdgcn_rcpf(1.f + __expf(-2.f * z));
}
__device__ __forceinline__ float wsum(float v) {
#pragma unroll
  for (int o = 32; o; o >>= 1) v += __shfl_xor(v, o);
  return v;
}
__device__ __forceinline__ float sq8(uint4 v) {
  float s = 0.f, t;
  t = bflo(v.x); s += t * t; t = bfhi(v.x); s += t * t;
  t = bflo(v.y); s += t * t; t = bfhi(v.y); s += t * t;
  t = bflo(v.z); s += t * t; t = bfhi(v.z); s += t * t;
  t = bflo(v.w); s += t * t; t = bfhi(v.w); s += t * t;
  return s;
}
typedef unsigned u32x4e __attribute__((ext_vector_type(4)));
typedef float f32x2e __attribute__((ext_vector_type(2)));
__device__ __forceinline__ uint4 nt_ld_u4(const void* p) { u32x4e v = __builtin_nontemporal_load((const u32x4e*)p); return make_uint4(v.x, v.y, v.z, v.w); }
__device__ __forceinline__ float4 nt_ld_f4(const void* p) { f32x4 v = __builtin_nontemporal_load((const f32x4*)p); return make_float4(v.x, v.y, v.z, v.w); }
__device__ __forceinline__ float2 nt_ld_f2(const void* p) { f32x2e v = __builtin_nontemporal_load((const f32x2e*)p); return make_float2(v.x, v.y); }
__device__ __forceinline__ void nt_st_f2(float2 v, void* p) { f32x2e t = {v.x, v.y}; __builtin_nontemporal_store(t, (f32x2e*)p); }
#define MFMA16(a, b, c) __builtin_amdgcn_mfma_f32_16x16x32_bf16(a, b, c, 0, 0, 0)
#define MFMA32(a, b, c) __builtin_amdgcn_mfma_f32_32x32x16_bf16(a, b, c, 0, 0, 0)

__device__ void transpose_fold(const float* src, const float* g, u16* dst, int ldd, int K, int N, char* smem) {
  float* tl = (float*)smem;
  const int tid = threadIdx.x;
  const int tk = K / 64, tn = N / 64;
  for (int t = blockIdx.x; t < tk * tn; t += gridDim.x) {
    int k0 = (t / tn) * 64, n0 = (t % tn) * 64;
    __syncthreads();
    for (int i = 0; i < 16; ++i) {
      int k = (tid >> 6) + i * 4, n = tid & 63;
      float v = src[(size_t)(k0 + k) * N + n0 + n];
      if (g) v *= g[k0 + k];
      tl[k * 65 + n] = v;
    }
    __syncthreads();
    for (int i = 0; i < 16; ++i) {
      int n = (tid >> 6) + i * 4, k = tid & 63;
      dst[(size_t)(n0 + n) * ldd + k0 + k] = f2bf(tl[k * 65 + n]);
    }
  }
}

__device__ void s5_prep(const Params& P, char* smem, int g) {
  float* apw = (float*)smem;
  float* bb = apw + 17 * 64 * 2;
  float* kk = bb + 64 * 16 * 2;
  const int tid = threadIdx.x;
  __syncthreads();
  if (tid < 64) {
    int pp = tid;
    float lr = P.s5_lre[g * 64 + pp], li = P.s5_lim[g * 64 + pp];
    float dt = expf(P.s5_logdt[g]);
    float mag = expf(lr * dt);
    double ang = (double)li * (double)dt;
    double kq = rint(ang * 0.15915494309189535);
    float r = (float)(ang - kq * 6.283185307179586);
    float sn = __sinf(r), cs = __cosf(r);
    {
      sn = sinf(r); cs = cosf(r);
    }
    float are = mag * cs, aim = mag * sn;
    float den = lr * lr + li * li;
    float nre = are - 1.f, nim = aim;
    float zre = (nre * lr + nim * li) / den, zim = (nim * lr - nre * li) / den;
    float pr = 1.f, pi = 0.f;
    for (int d = 0; d <= 16; ++d) {
      apw[(d * 64 + pp) * 2] = pr; apw[(d * 64 + pp) * 2 + 1] = pi;
      float nr = pr * are - pi * aim, ni = pr * aim + pi * are;
      pr = nr; pi = ni;
    }
    P.A16[(g * 64 + pp) * 2] = apw[(16 * 64 + pp) * 2];
    P.A16[(g * 64 + pp) * 2 + 1] = apw[(16 * 64 + pp) * 2 + 1];
    for (int j = 0; j < 16; ++j) {
      float br = P.s5_bre[(g * 64 + pp) * 16 + j], bi = P.s5_bim[(g * 64 + pp) * 16 + j];
      bb[(pp * 16 + j) * 2] = zre * br - zim * bi;
      bb[(pp * 16 + j) * 2 + 1] = zre * bi + zim * br;
    }
  }
  __syncthreads();
  for (int rr = 0; rr < 16; ++rr) {
    int e = tid + rr * 256;
    int d = e >> 8, i = (e >> 4) & 15, j = e & 15;
    float s = 0.f;
    for (int pp = 0; pp < 64; ++pp) {
      float cr = P.s5_cre[(g * 16 + i) * 64 + pp], ci = P.s5_cim[(g * 16 + i) * 64 + pp];
      float ar = apw[(d * 64 + pp) * 2], ai = apw[(d * 64 + pp) * 2 + 1];
      float xr = cr * ar - ci * ai, xi = cr * ai + ci * ar;
      s += xr * bb[(pp * 16 + j) * 2] - xi * bb[(pp * 16 + j) * 2 + 1];
    }
    kk[e] = s;
  }
  __syncthreads();
  u16* MFg = P.MF + (size_t)g * 256 * 384;
  for (int it = 0; it < 192; ++it) {
    int e = tid + it * 256;
    int m = e / 192, cp = (e % 192) * 2;
    int t = m >> 4, i = m & 15;
    float v[2];
    for (int q = 0; q < 2; ++q) {
      int col = cp + q;
      float val;
      if (col < 256) {
        int sg = col >> 4, j = col & 15;
        val = (sg <= t) ? kk[((t - sg) * 16 + i) * 16 + j] : 0.f;
        if (sg == t && i == j) val += P.s5_d[g * 16 + i];
      } else {
        int pc = col - 256, pp = pc & 63, im = pc >> 6;
        float cr = P.s5_cre[(g * 16 + i) * 64 + pp], ci = P.s5_cim[(g * 16 + i) * 64 + pp];
        float ar = apw[((t + 1) * 64 + pp) * 2], ai = apw[((t + 1) * 64 + pp) * 2 + 1];
        float xr = cr * ar - ci * ai, xi = cr * ai + ci * ar;
        val = im ? -xi : xr;
      }
      v[q] = val;
    }
    *(unsigned*)(MFg + (size_t)m * 384 + cp) = pack2(v[0], v[1]);
  }
  u16* Gg = P.G + (size_t)g * 128 * 256;
  for (int it = 0; it < 64; ++it) {
    int e = tid + it * 256;
    int row = e >> 7, cp = (e & 127) * 2;
    int im = row >> 6, pp = row & 63;
    float v[2];
    for (int q = 0; q < 2; ++q) {
      int col = cp + q, sg = col >> 4, j = col & 15;
      float ar = apw[((15 - sg) * 64 + pp) * 2], ai = apw[((15 - sg) * 64 + pp) * 2 + 1];
      float br = bb[(pp * 16 + j) * 2], bi = bb[(pp * 16 + j) * 2 + 1];
      v[q] = im ? (ar * bi + ai * br) : (ar * br - ai * bi);
    }
    *(unsigned*)(Gg + (size_t)row * 256 + cp) = pack2(v[0], v[1]);
  }
}

__device__ void wqk_prep(const Params& P, char* smem) {
  float* Wt = (float*)smem;
  float* Kt = Wt + 64 * 129;
  const int tid = threadIdx.x;
  for (int item = blockIdx.x; item < 512; item += gridDim.x) {
    const int hs = item >> 5, kb = (item >> 1) & 15, kh = item & 1;
    const int cbase = (hs >> 1) * 256 + (hs & 1) * 128, k0 = kb * 64;
    __syncthreads();
    for (int i = 0; i < 32; ++i) {
      const int idx = tid + i * 256, row = idx >> 7, col = idx & 127;
      Wt[row * 129 + col] = P.wq[(size_t)(k0 + row) * 2048 + cbase + col] * P.norm2_g[k0 + row];
      const int ko = kh * 64 * 128 + idx;
      Kt[idx] = (hs & 1) ? P.k2[ko] : P.k1[ko];
    }
    __syncthreads();
    const int kk = tid & 63, q = tid >> 6;
    float acc[16];
#pragma unroll
    for (int i = 0; i < 16; ++i) acc[i] = 0.f;
    for (int d = 0; d < 128; d += 4) {
      const float w0 = Wt[kk * 129 + d], w1 = Wt[kk * 129 + d + 1], w2 = Wt[kk * 129 + d + 2], w3 = Wt[kk * 129 + d + 3];
#pragma unroll
      for (int i = 0; i < 16; ++i) {
        const float4 kv = *(const float4*)(Kt + (q * 16 + i) * 128 + d);
        acc[i] += w0 * kv.x + w1 * kv.y + w2 * kv.z + w3 * kv.w;
      }
    }
#pragma unroll
    for (int i = 0; i < 16; ++i) P.WqT[(size_t)(hs * 128 + kh * 64 + q * 16 + i) * 1024 + k0 + kk] = f2bf(acc[i]);
  }
}

__device__ void phase_prep(const Params& P, char* smem) {
  const int tid = threadIdx.x, lane = tid & 63, w = tid >> 6;
  {
    int g = (int)gridDim.x - 1 - (int)blockIdx.x;
    if (g < 32) s5_prep(P, smem, g);
  }
  for (int i = blockIdx.x * 256 + tid; i < 512; i += gridDim.x * 256) { const float lam = P.lru_lambda[i]; P.spv[i] = fmaxf(-lam, 0.f) + log1pf(expf(-fabsf(lam))); }
  for (int i = blockIdx.x * 256 + tid; i < T_TOK; i += gridDim.x * 256) { P.ssa[i] = 0.f; P.ssb[i] = 0.f; P.ss2[i] = 0.f; P.ssf[i] = 0.f; }
  const bool split = gridDim.x > 64;
  const bool bulk = !split || (int)blockIdx.x < (int)gridDim.x - 32;
  const int nbulk = split ? (int)gridDim.x - 32 : (int)gridDim.x;
  if (bulk) {
    const int gwv = blockIdx.x * 4 + w, nw = nbulk * 4;
    for (int r = gwv; r < T_TOK; r += nw) {
      const float4* src = (const float4*)(P.x + (size_t)r * 1024);
      float4 v[4];
      float ss = 0.f;
#pragma unroll
      for (int i = 0; i < 4; ++i) {
        v[i] = src[i * 64 + lane];
        ss += v[i].x * v[i].x + v[i].y * v[i].y + v[i].z * v[i].z + v[i].w * v[i].w;
      }
      ss = wsum(ss);
      if (lane == 0) P.rstd1[r] = rsqrtf(ss * (1.f / 1024.f) + EPSF);
      uint2* dst = (uint2*)(P.xb + (size_t)r * 1024);
#pragma unroll
      for (int i = 0; i < 4; ++i) dst[i * 64 + lane] = make_uint2(pack2(v[i].x, v[i].y), pack2(v[i].z, v[i].w));
    }
  }
  {
    const int gwv = blockIdx.x * 4 + w, nw = nbulk * 4;
    if (bulk)
    for (int r = gwv; r < 32768; r += nw) {
      const int isv = r >> 14, e = r & 16383;
      const float* src = (isv ? P.pv : P.pu) + (size_t)e * 1024 + lane * 16;
      float4 v[4];
      float m = 0.f;
#pragma unroll
      for (int i = 0; i < 4; ++i) {
        {
          float4 t = *(const float4*)(src + i * 4);
          const float4 g2 = *(const float4*)(P.norm2_g + lane * 16 + i * 4);
          v[i] = isv ? t : make_float4(t.x * g2.x, t.y * g2.y, t.z * g2.z, t.w * g2.w);
        }
        m = fmaxf(m, fmaxf(fmaxf(fabsf(v[i].x), fabsf(v[i].y)), fmaxf(fabsf(v[i].z), fabsf(v[i].w))));
      }
#pragma unroll
      for (int o = 32; o; o >>= 1) m = fmaxf(m, __shfl_xor(m, o));
      int ex = (int)((__float_as_uint(m) >> 23) & 255u) - 127;
      ex = ex < -100 ? -100 : (ex > 100 ? 100 : ex);
      const float sc = __uint_as_float((unsigned)(127 + 7 - ex) << 23);
      const float isc = __uint_as_float((unsigned)(127 - 7 + ex) << 23);
      unsigned pk[4];
#pragma unroll
      for (int i = 0; i < 4; ++i) {
        int t = __builtin_amdgcn_cvt_pk_fp8_f32(v[i].x * sc, v[i].y * sc, 0, false);
        t = __builtin_amdgcn_cvt_pk_fp8_f32(v[i].z * sc, v[i].w * sc, t, true);
        pk[i] = (unsigned)t;
      }
      unsigned char* dst = isv ? (P.V8 + (size_t)(lane >> 3) * (16384 * 128) + (size_t)e * 128 + (lane & 7) * 16)
                               : (P.U8 + (size_t)(lane >> 3) * (16384 * 128) + (size_t)e * 128 + (lane & 7) * 16);
      *(uint4*)dst = make_uint4(pk[0], pk[1], pk[2], pk[3]);
      if (lane == 0) { if (isv) P.sv[e] = isc; else P.su[e] = isc; }
    }
    size_t gt = (size_t)blockIdx.x * 256 + tid, nt = (size_t)gridDim.x * 256;
    for (size_t i = gt; i < 4096; i += nt) {
      float4 a = ((const float4*)P.k1)[i];
      ((uint2*)P.K1b)[i] = make_uint2(pack2(a.x, a.y), pack2(a.z, a.w));
      float4 b = ((const float4*)P.k2)[i];
      ((uint2*)P.K2b)[i] = make_uint2(pack2(b.x, b.y), pack2(b.z, b.w));
    }
  }
  transpose_fold(P.w_in, P.norm1_g, P.WinT, 1024, 1024, 1536, smem);
  transpose_fold(P.glu_w, nullptr, P.GluT, 512, 512, 512, smem);
  transpose_fold(P.w_out, P.gnorm_lru, P.WoutT, 1024, 512, 1024, smem);
  transpose_fold(P.w_out + 512 * 1024, P.gnorm_s5, P.WoutT + 512, 1024, 512, 1024, smem);
  wqk_prep(P, smem);
  for (int h = 0; h < 8; ++h) {
    transpose_fold(P.lru_wa + h * 4096, nullptr, P.WaT + h * 4096, 64, 64, 64, smem);
    transpose_fold(P.lru_wx + h * 4096, nullptr, P.WxT + h * 4096, 64, 64, 64, smem);
  }
}

__device__ __forceinline__ void ce(float& hi, float& lo) {
  float a = hi, b = lo;
  asm("v_max_f32 %0, %1, %2" : "=v"(hi) : "v"(a), "v"(b));
  asm("v_min_f32 %0, %1, %2" : "=v"(lo) : "v"(a), "v"(b));
}
__device__ __forceinline__ float vmaxf(float a, float b) {
  float r;
  asm("v_max_f32 %0, %1, %2" : "=v"(r) : "v"(a), "v"(b));
  return r;
}
__device__ __forceinline__ void sort16(float (&v)[16]) {
#pragma unroll
  for (int k = 2; k <= 16; k <<= 1)
#pragma unroll
    for (int j = k >> 1; j > 0; j >>= 1)
#pragma unroll
      for (int i = 0; i < 16; ++i) {
        int l = i ^ j;
        if (l > i) {
          if ((i & k) == 0) ce(v[i], v[l]); else ce(v[l], v[i]);
        }
      }
}
__device__ __forceinline__ void bmerge16(float (&v)[16]) {
#pragma unroll
  for (int j = 8; j > 0; j >>= 1)
#pragma unroll
    for (int i = 0; i < 16; ++i) {
      int l = i ^ j;
      if (l > i) ce(v[i], v[l]);
    }
}
__device__ __forceinline__ void merge_top16(float (&x)[16], const float (&y)[16]) {
#pragma unroll
  for (int i = 0; i < 16; ++i) x[i] = vmaxf(x[i], y[15 - i]);
  bmerge16(x);
}

enum { EPI_INPROJ = 0, EPI_GLU = 1, EPI_OUT = 2, EPI_Q = 3 };
#define LDT 64

template <int EPI>
__device__ void gemm_phase(const Params& P, char* smem, const u16* __restrict__ A, const u16* __restrict__ Bt,
                           int M, int N, int K) {
  constexpr int TE = 128 * LDT;
  u16* AsB = (u16*)smem;
  u16* BsB = AsB + 2 * TE;
  const int tid = threadIdx.x, lane = tid & 63, w = tid >> 6, wm = w >> 1, wn = w & 1;
  const int l15 = lane & 15, lq = lane >> 4;
  const int NT = N / 128, MT = M / 128, ntiles = MT * NT, nk = K / 64;
  int vb = blockIdx.x;
  if ((gridDim.x & 7) == 0) vb = (blockIdx.x & 7) * (gridDim.x >> 3) + (blockIdx.x >> 3);
  const int ldr = tid >> 3, ldc = (tid & 7) * 8;
  const int ldsw = ((tid & 7) ^ ((ldr >> 1) & 7)) * 8;
  const int rsw = (l15 >> 1) & 7;
  const int cnt = (vb < ntiles) ? (ntiles - vb + (int)gridDim.x - 1) / (int)gridDim.x : 0;
  const int total = cnt * nk;
  if (total == 0) return;
  f32x4 acc[4][4];
#pragma unroll
  for (int i = 0; i < 4; ++i)
#pragma unroll
    for (int j = 0; j < 4; ++j) acc[i][j] = (f32x4){0.f, 0.f, 0.f, 0.f};
  uint4 pa0, pa1, pa2, pa3, pb0, pb1, pb2, pb3, qa0, qa1, qa2, qa3, qb0, qb1, qb2, qb3;
  const u16 *Ag, *Bg;
#define STEP_ADDR(st) { int st_ = (st) < total ? (st) : total - 1; int ti_ = st_ / nk, kk_ = st_ - ti_ * nk; \
      int tl_ = vb + ti_ * (int)gridDim.x; int r0_ = (tl_ / NT) * 128, c0_ = (tl_ % NT) * 128; \
      { const int hm_ = (nk >> 1) - 1; kk_ = (kk_ & ~hm_) | ((kk_ + (tl_ % NT) + (tl_ / NT)) & hm_); } \
      Ag = A + (size_t)(r0_ + ldr) * K + ldc + kk_ * 64; Bg = Bt + (size_t)(c0_ + ldr) * K + ldc + kk_ * 64; }
#define GLD2(S, i) { S##a##i = *(const uint4*)(Ag + (size_t)(32 * i) * K); S##b##i = *(const uint4*)(Bg + (size_t)(32 * i) * K); }
#define GLDS(S, st) { STEP_ADDR(st) GLD2(S, 0) GLD2(S, 1) GLD2(S, 2) GLD2(S, 3) }
#define LST2(S, i, buf) { *(uint4*)(AsB + (buf) * TE + (ldr + 32 * i) * LDT + ldsw) = S##a##i; \
                          *(uint4*)(BsB + (buf) * TE + (ldr + 32 * i) * LDT + ldsw) = S##b##i; }
#define LSTS(S, buf) { LST2(S, 0, buf) LST2(S, 1, buf) LST2(S, 2, buf) LST2(S, 3, buf) }
#define COMPUTE(buf) { \
      const u16* As_ = AsB + (buf) * TE; const u16* Bs_ = BsB + (buf) * TE; \
      _Pragma("unroll") for (int ks = 0; ks < 2; ++ks) { \
        bf16x8 af[4], bfr[4]; \
        _Pragma("unroll") for (int mt = 0; mt < 4; ++mt) \
          af[mt] = *(const bf16x8*)(As_ + (wm * 64 + mt * 16 + l15) * LDT + (((ks * 4 + lq) ^ rsw) * 8)); \
        _Pragma("unroll") for (int nt = 0; nt < 4; ++nt) \
          bfr[nt] = *(const bf16x8*)(Bs_ + (wn * 64 + nt * 16 + l15) * LDT + (((ks * 4 + lq) ^ rsw) * 8)); \
        _Pragma("unroll") for (int mt = 0; mt < 4; ++mt) \
          _Pragma("unroll") for (int nt = 0; nt < 4; ++nt) acc[mt][nt] = MFMA16(bfr[nt], af[mt], acc[mt][nt]); \
      } }
#define RESCALE() { if (EPI == EPI_OUT) { \
      _Pragma("unroll") for (int mt = 0; mt < 4; ++mt) { \
        const int row = row0 + wm * 64 + mt * 16 + l15; \
        const float ra_ = rsqrtf(P.ssa[row] * (1.f / 512.f) + EPSF), rb_ = rsqrtf(P.ssb[row] * (1.f / 512.f) + EPSF); \
        const float ratio = ra_ / rb_; \
        _Pragma("unroll") for (int nt = 0; nt < 4; ++nt) acc[mt][nt] *= ratio; } } }
  __syncthreads();
  GLDS(p, 0)
  __builtin_amdgcn_sched_barrier(0);
  GLDS(q, 1)
  __builtin_amdgcn_sched_barrier(0);
  LSTS(p, 0)
  GLDS(p, 2)
  __builtin_amdgcn_sched_barrier(0);
  for (int st = 0; st < total; st += 2) {
    const int ti = st / nk, kt = st - ti * nk;
    const int tile = vb + ti * (int)gridDim.x;
    const int row0 = (tile / NT) * 128, col0 = (tile % NT) * 128;
    __syncthreads();
    LSTS(q, 1)
    GLDS(q, st + 3)
    __builtin_amdgcn_sched_barrier(0);
    if (kt == nk / 2) RESCALE()
    COMPUTE(0)
    __syncthreads();
    LSTS(p, 0)
    GLDS(p, st + 4)
    __builtin_amdgcn_sched_barrier(0);
    COMPUTE(1)
    if (kt + 2 < nk) continue;
    if (EPI == EPI_Q) {
      float* xch = (float*)(smem + 65536);
      float lst[4][16];
#pragma unroll
      for (int mt = 0; mt < 4; ++mt) {
        const int lr = wm * 64 + mt * 16 + l15;
        const float sc = rsqrtf(P.ss2[row0 + lr] * (1.f / 1024.f) + EPSF);
#pragma unroll
        for (int nt = 0; nt < 4; ++nt)
#pragma unroll
          for (int j = 0; j < 4; ++j) {
            const unsigned kidx = (unsigned)(wn * 64 + nt * 16 + lq * 4 + j);
            lst[mt][nt * 4 + j] = __uint_as_float((__float_as_uint(acc[mt][nt][j] * sc) & 0xffffff80u) | kidx);
          }
#pragma unroll
        for (int nt = 0; nt < 4; ++nt) acc[mt][nt] = (f32x4){0.f, 0.f, 0.f, 0.f};
        sort16(lst[mt]);
        float y[16];
#pragma unroll
        for (int i = 0; i < 16; ++i) y[i] = __shfl_xor(lst[mt][i], 16);
        merge_top16(lst[mt], y);
#pragma unroll
        for (int i = 0; i < 16; ++i) y[i] = __shfl_xor(lst[mt][i], 32);
        merge_top16(lst[mt], y);
      }
      if (wn == 1 && lq == 0) {
#pragma unroll
        for (int mt = 0; mt < 4; ++mt) {
          float4* d4 = (float4*)(xch + (wm * 64 + mt * 16 + l15) * 16);
#pragma unroll
          for (int i = 0; i < 4; ++i) d4[i] = make_float4(lst[mt][i * 4], lst[mt][i * 4 + 1], lst[mt][i * 4 + 2], lst[mt][i * 4 + 3]);
        }
      }
      __syncthreads();
      if (wn == 0) {
        const int hs = col0 >> 7;
#pragma unroll
        for (int mt = 0; mt < 4; ++mt) {
          const int lr = wm * 64 + mt * 16 + l15;
          const float4* s4 = (const float4*)(xch + lr * 16);
          float y[16];
#pragma unroll
          for (int i = 0; i < 4; ++i) { const float4 t = s4[i]; y[i * 4] = t.x; y[i * 4 + 1] = t.y; y[i * 4 + 2] = t.z; y[i * 4 + 3] = t.w; }
          merge_top16(lst[mt], y);
          if (lq == 0) {
            float4* d4 = (float4*)(P.t16 + ((size_t)(row0 + lr) * 16 + hs) * 16);
#pragma unroll
            for (int i = 0; i < 4; ++i) d4[i] = make_float4(lst[mt][i * 4], lst[mt][i * 4 + 1], lst[mt][i * 4 + 2], lst[mt][i * 4 + 3]);
          }
        }
      }
      continue;
    }
#pragma unroll
    for (int mt = 0; mt < 4; ++mt) {
      const int lr = wm * 64 + mt * 16 + l15;
      const size_t row = (size_t)(row0 + lr);
      float sc = 1.f;
      if (EPI == EPI_INPROJ) sc = P.rstd1[row];
      if (EPI == EPI_OUT) sc = rsqrtf(P.ssb[row] * (1.f / 512.f) + EPSF);
      if (EPI == EPI_Q) sc = rsqrtf(P.ss2[row] * (1.f / 1024.f) + EPSF);
      float sq = 0.f;
#pragma unroll
      for (int nt = 0; nt < 4; ++nt) {
        const int col = col0 + wn * 64 + nt * 16 + lq * 4;
        f32x4 v = acc[mt][nt];
        if (EPI == EPI_INPROJ) {
          *(uint2*)(P.p + row * 1536 + col) = make_uint2(pack2(v[0] * sc, v[1] * sc), pack2(v[2] * sc, v[3] * sc));
        } else if (EPI == EPI_GLU) {
          uint2 gg = *(const uint2*)(P.gs5 + row * 512 + col);
          float4 gb = *(const float4*)(P.glu_b + col);
          float g0 = bflo(gg.x), g1 = bfhi(gg.x), g2 = bflo(gg.y), g3 = bfhi(gg.y);
          float o0 = g0 * sigmoid_(v[0] + gb.x), o1 = g1 * sigmoid_(v[1] + gb.y);
          float o2 = g2 * sigmoid_(v[2] + gb.z), o3 = g3 * sigmoid_(v[3] + gb.w);
          sq += o0 * o0 + o1 * o1 + o2 * o2 + o3 * o3;
          *(uint2*)(P.ycat + row * 1024 + 512 + col) = make_uint2(pack2(o0, o1), pack2(o2, o3));
        } else {
          float4 xv = *(const float4*)(P.x + row * 1024 + col);
          float4 h = make_float4(xv.x + v[0] * sc, xv.y + v[1] * sc, xv.z + v[2] * sc, xv.w + v[3] * sc);
          sq += h.x * h.x + h.y * h.y + h.z * h.z + h.w * h.w;
          *(float4*)(P.out + row * 1024 + col) = h;
          *(uint2*)(P.hb + row * 1024 + col) = make_uint2(pack2(h.x, h.y), pack2(h.z, h.w));
        }
      }
      if (EPI == EPI_GLU || EPI == EPI_OUT) {
        sq += __shfl_xor(sq, 16);
        sq += __shfl_xor(sq, 32);
        if (lq == 0) atomicAdd((EPI == EPI_GLU ? P.ssb : P.ss2) + row, sq);
      }
#pragma unroll
      for (int nt = 0; nt < 4; ++nt) acc[mt][nt] = (f32x4){0.f, 0.f, 0.f, 0.f};
    }
  }
}

template <int EPI>
__device__ void gemm256_phase(const Params& P, char* smem, const u16* __restrict__ A, const u16* __restrict__ Bt,
                              int M, int N, int K) {
  u16* As = (u16*)smem;
  u16* Bs = As + 256 * 64;
  const int tid = threadIdx.x, lane = tid & 63, w = tid >> 6, wm = w >> 1, wn = w & 1;
  const int l15 = lane & 15, lq = lane >> 4;
  const int NT = N / 128, MT = M / 256, ntiles = MT * NT, nk = K / 64;
  int vb = blockIdx.x;
  if ((gridDim.x & 7) == 0) vb = (blockIdx.x & 7) * (gridDim.x >> 3) + (blockIdx.x >> 3);
  const int ldr = tid >> 3, ldc = (tid & 7) * 8;
  const int ldsw = ((tid & 7) ^ ((ldr >> 1) & 7)) * 8;
  const int rsw = (l15 >> 1) & 7;
  const int cnt = (vb < ntiles) ? (ntiles - vb + (int)gridDim.x - 1) / (int)gridDim.x : 0;
  const int total = cnt * nk;
  if (total == 0) return;
  f32x4 acc[8][4];
#pragma unroll
  for (int i = 0; i < 8; ++i)
#pragma unroll
    for (int j = 0; j < 4; ++j) acc[i][j] = (f32x4){0.f, 0.f, 0.f, 0.f};
  uint4 ga0, ga1, ga2, ga3, ga4, ga5, ga6, ga7, gb0, gb1, gb2, gb3;
  const u16 *Ag, *Bg;
#define G2_ADDR(st) { int st_ = (st) < total ? (st) : total - 1; int ti_ = st_ / nk, kk_ = st_ - ti_ * nk; \
      int tl_ = vb + ti_ * (int)gridDim.x; int r0_ = (tl_ / NT) * 256, c0_ = (tl_ % NT) * 128; \
      Ag = A + (size_t)(r0_ + ldr) * K + ldc + kk_ * 64; Bg = Bt + (size_t)(c0_ + ldr) * K + ldc + kk_ * 64; }
#define G2_LDA(i) ga##i = *(const uint4*)(Ag + (size_t)(32 * i) * K);
#define G2_LDB(i) gb##i = *(const uint4*)(Bg + (size_t)(32 * i) * K);
#define G2_GLD(st) { G2_ADDR(st) G2_LDA(0) G2_LDA(1) G2_LDA(2) G2_LDA(3) G2_LDA(4) G2_LDA(5) G2_LDA(6) G2_LDA(7) G2_LDB(0) G2_LDB(1) G2_LDB(2) G2_LDB(3) }
#define G2_STA(i) *(uint4*)(As + (ldr + 32 * i) * 64 + ldsw) = ga##i;
#define G2_STB(i) *(uint4*)(Bs + (ldr + 32 * i) * 64 + ldsw) = gb##i;
#define G2_LST() { G2_STA(0) G2_STA(1) G2_STA(2) G2_STA(3) G2_STA(4) G2_STA(5) G2_STA(6) G2_STA(7) G2_STB(0) G2_STB(1) G2_STB(2) G2_STB(3) }
  G2_GLD(0)
  for (int st = 0; st < total; ++st) {
    const int ti = st / nk, kt = st - ti * nk;
    const int tile = vb + ti * (int)gridDim.x;
    const int row0 = (tile / NT) * 256, col0 = (tile % NT) * 128;
    __syncthreads();
    G2_LST()
    G2_GLD(st + 1)
    __builtin_amdgcn_sched_barrier(0);
    __syncthreads();
    if (EPI == EPI_OUT && kt == nk / 2) {
#pragma unroll
      for (int mt = 0; mt < 8; ++mt) {
        const int row = row0 + wm * 128 + mt * 16 + l15;
        const float ra_ = rsqrtf(P.ssa[row] * (1.f / 512.f) + EPSF), rb_ = rsqrtf(P.ssb[row] * (1.f / 512.f) + EPSF);
        const float ratio = ra_ / rb_;
#pragma unroll
        for (int nt = 0; nt < 4; ++nt) acc[mt][nt] *= ratio;
      }
    }
#pragma unroll
    for (int ks = 0; ks < 2; ++ks) {
      bf16x8 bfr[4];
#pragma unroll
      for (int nt = 0; nt < 4; ++nt)
        bfr[nt] = *(const bf16x8*)(Bs + (wn * 64 + nt * 16 + l15) * 64 + (((ks * 4 + lq) ^ rsw) * 8));
#pragma unroll
      for (int hh = 0; hh < 2; ++hh) {
        bf16x8 af[4];
#pragma unroll
        for (int m = 0; m < 4; ++m)
          af[m] = *(const bf16x8*)(As + (wm * 128 + (hh * 4 + m) * 16 + l15) * 64 + (((ks * 4 + lq) ^ rsw) * 8));
#pragma unroll
        for (int m = 0; m < 4; ++m)
#pragma unroll
          for (int nt = 0; nt < 4; ++nt) acc[hh * 4 + m][nt] = MFMA16(bfr[nt], af[m], acc[hh * 4 + m][nt]);
      }
    }
    if (kt + 1 < nk) continue;
#pragma unroll
    for (int mt = 0; mt < 8; ++mt) {
      const int lr = wm * 128 + mt * 16 + l15;
      const size_t row = (size_t)(row0 + lr);
      float sc = 1.f;
      if (EPI == EPI_INPROJ) sc = P.rstd1[row];
      if (EPI == EPI_OUT) sc = rsqrtf(P.ssb[row] * (1.f / 512.f) + EPSF);
      float sq = 0.f;
#pragma unroll
      for (int nt = 0; nt < 4; ++nt) {
        const int col = col0 + wn * 64 + nt * 16 + lq * 4;
        f32x4 v = acc[mt][nt];
        if (EPI == EPI_INPROJ) {
          *(uint2*)(P.p + row * 1536 + col) = make_uint2(pack2(v[0] * sc, v[1] * sc), pack2(v[2] * sc, v[3] * sc));
        } else if (EPI == EPI_GLU) {
          uint2 gg = *(const uint2*)(P.gs5 + row * 512 + col);
          float4 gb = *(const float4*)(P.glu_b + col);
          float g0 = bflo(gg.x), g1 = bfhi(gg.x), g2 = bflo(gg.y), g3 = bfhi(gg.y);
          float o0 = g0 * sigmoid_(v[0] + gb.x), o1 = g1 * sigmoid_(v[1] + gb.y);
          float o2 = g2 * sigmoid_(v[2] + gb.z), o3 = g3 * sigmoid_(v[3] + gb.w);
          sq += o0 * o0 + o1 * o1 + o2 * o2 + o3 * o3;
          *(uint2*)(P.ycat + row * 1024 + 512 + col) = make_uint2(pack2(o0, o1), pack2(o2, o3));
        } else {
          float4 xv = *(const float4*)(P.x + row * 1024 + col);
          float4 h = make_float4(xv.x + v[0] * sc, xv.y + v[1] * sc, xv.z + v[2] * sc, xv.w + v[3] * sc);
          sq += h.x * h.x + h.y * h.y + h.z * h.z + h.w * h.w;
          *(float4*)(P.out + row * 1024 + col) = h;
          *(uint2*)(P.hb + row * 1024 + col) = make_uint2(pack2(h.x, h.y), pack2(h.z, h.w));
        }
        acc[mt][nt] = (f32x4){0.f, 0.f, 0.f, 0.f};
      }
      if (EPI == EPI_GLU || EPI == EPI_OUT) {
        sq += __shfl_xor(sq, 16);
        sq += __shfl_xor(sq, 32);
        if (lq == 0) atomicAdd((EPI == EPI_GLU ? P.ssb : P.ss2) + row, sq);
      }
    }
  }
}

__device__ __forceinline__ float one_minus_exp(float x) {
  const float ser = -x * (1.f + x * (0.5f + x * (0.16666667f + x * (0.041666668f + x * (0.0083333338f + x * 0.0013888889f)))));
  return (x > -0.5f) ? ser : (1.f - __expf(x));
}

template <bool FINAL>
__device__ void lru_phase(const Params& P, char* smem) {
  float* xcs = (float*)smem;
  float* a_s = xcs + 64 * 65;
  float* segA = a_s + 64 * 65;
  float* segH = segA + 256;
  const int tid = threadIdx.x, lane = tid & 63, w = tid >> 6;
  const int l15 = lane & 15, lq = lane >> 4;
  for (int item = blockIdx.x; item < 8192; item += gridDim.x) {
    const int head = item & 7, tile = (item >> 3) & 31, b = item >> 8;
    const int c0 = head * 64, t0 = tile * 64;
    __syncthreads();
    if (!FINAL) {
      bf16x8 af[2];
      {
        const int tl = w * 16 + l15;
        const int t = t0 + tl;
        const u16* prow = P.p + ((size_t)(b * 2048 + t)) * 1536 + c0;
#pragma unroll
        for (int ks = 0; ks < 2; ++ks) {
          const int ch = ks * 32 + lq * 8;
          float xc[8];
          {
            float4 b0 = *(const float4*)(P.conv_b + c0 + ch), b1 = *(const float4*)(P.conv_b + c0 + ch + 4);
            xc[0] = b0.x; xc[1] = b0.y; xc[2] = b0.z; xc[3] = b0.w; xc[4] = b1.x; xc[5] = b1.y; xc[6] = b1.z; xc[7] = b1.w;
          }
#pragma unroll
          for (int k = 0; k < 4; ++k) {
            if (t - 3 + k >= 0) {
              uint4 v = *(const uint4*)(prow + (k - 3) * 1536 + ch);
              float4 w0 = *(const float4*)(P.conv_w + k * 512 + c0 + ch), w1 = *(const float4*)(P.conv_w + k * 512 + c0 + ch + 4);
              xc[0] += w0.x * bflo(v.x); xc[1] += w0.y * bfhi(v.x); xc[2] += w0.z * bflo(v.y); xc[3] += w0.w * bfhi(v.y);
              xc[4] += w1.x * bflo(v.z); xc[5] += w1.y * bfhi(v.z); xc[6] += w1.z * bflo(v.w); xc[7] += w1.w * bfhi(v.w);
            }
          }
#pragma unroll
          for (int i = 0; i < 8; ++i) xcs[tl * 65 + ch + i] = xc[i];
          unsigned p0 = pack2(xc[0], xc[1]), p1 = pack2(xc[2], xc[3]), p2 = pack2(xc[4], xc[5]), p3 = pack2(xc[6], xc[7]);
          uint4 pk = make_uint4(p0, p1, p2, p3);
          af[ks] = *(bf16x8*)&pk;
        }
      }
      f32x4 accr[4], acci[4];
#pragma unroll
      for (int nt = 0; nt < 4; ++nt) {
        accr[nt] = (f32x4){0.f, 0.f, 0.f, 0.f};
        acci[nt] = (f32x4){0.f, 0.f, 0.f, 0.f};
#pragma unroll
        for (int ks = 0; ks < 2; ++ks) {
          bf16x8 ba = *(const bf16x8*)(P.WaT + head * 4096 + (nt * 16 + l15) * 64 + ks * 32 + lq * 8);
          bf16x8 bx = *(const bf16x8*)(P.WxT + head * 4096 + (nt * 16 + l15) * 64 + ks * 32 + lq * 8);
          accr[nt] = MFMA16(af[ks], ba, accr[nt]);
          acci[nt] = MFMA16(af[ks], bx, acci[nt]);
        }
      }
      __syncthreads();
#pragma unroll
      for (int nt = 0; nt < 4; ++nt) {
        const int ch = nt * 16 + l15;
        const float ba = P.lru_ba[c0 + ch], bx = P.lru_bx[c0 + ch], sp = P.spv[c0 + ch];
#pragma unroll
        for (int r = 0; r < 4; ++r) {
          const int tl = w * 16 + lq * 4 + r;
          float xf = xcs[tl * 65 + ch];
          float rr = sigmoid_(accr[nt][r] + ba), ig = sigmoid_(acci[nt][r] + bx);
          float la = -8.f * rr * sp;
          const float oma = one_minus_exp(la);
          const float om2 = one_minus_exp(2.f * la);
          float u = __builtin_amdgcn_sqrtf(om2) * ig * xf;
          a_s[tl * 65 + ch] = __uint_as_float((unsigned)f2bf(oma) | ((unsigned)f2bf(u) << 16));
        }
      }
      __syncthreads();
    }
    {
      const int ch = tid & 63, seg = tid >> 6;
      const size_t tok0 = (size_t)(b * 2048 + t0 + seg * 16);
      unsigned pk[16];
#pragma unroll
      for (int s = 0; s < 16; ++s) {
        if (!FINAL) {
          pk[s] = __float_as_uint(a_s[(seg * 16 + s) * 65 + ch]);
          P.au[(tok0 + s) * 512 + c0 + ch] = pk[s];
        } else {
          pk[s] = P.au[(tok0 + s) * 512 + c0 + ch];
        }
      }
      float Ap = 1.f, Hl = 0.f;
#pragma unroll
      for (int s = 0; s < 16; ++s) {
        const float a = 1.f - bflo(pk[s]), u = bfhi(pk[s]);
        Hl = a * Hl + u;
        Ap *= a;
      }
      segA[seg * 64 + ch] = Ap;
      segH[seg * 64 + ch] = Hl;
      __syncthreads();
      if (!FINAL) {
        if (seg == 0) {
          float Aa = 1.f, Hh = 0.f;
#pragma unroll
          for (int s = 0; s < 4; ++s) {
            Hh = segA[s * 64 + ch] * Hh + segH[s * 64 + ch];
            Aa *= segA[s * 64 + ch];
          }
          P.Acar[(b * 32 + tile) * 512 + c0 + ch] = Aa;
          P.Hcar[(b * 32 + tile) * 512 + c0 + ch] = Hh;
        }
      } else {
        float gate[16];
#pragma unroll
        for (int s = 0; s < 16; ++s) gate[s] = bf2f(P.p[(tok0 + s) * 1536 + 512 + c0 + ch]);
        float h = P.Hin[(b * 32 + tile) * 512 + c0 + ch];
#pragma unroll
        for (int s = 0; s < 3; ++s)
          if (s < seg) h = segA[s * 64 + ch] * h + segH[s * 64 + ch];
        float sqv[16];
#pragma unroll
        for (int s = 0; s < 16; ++s) {
          h = (1.f - bflo(pk[s])) * h + bfhi(pk[s]);
          const float yv = h * gelu_(gate[s]);
          sqv[s] = yv * yv;
          P.ycat[(tok0 + s) * 1024 + c0 + ch] = f2bf(yv);
        }
        {
          const bool hb = (lane & 32) != 0, b4 = (lane & 16) != 0, b3 = (lane & 8) != 0, b2 = (lane & 4) != 0;
#pragma unroll
          for (int i = 0; i < 8; ++i) { float sd = hb ? sqv[i] : sqv[i + 8], kp = hb ? sqv[i + 8] : sqv[i]; sqv[i] = kp + __shfl_xor(sd, 32); }
#pragma unroll
          for (int i = 0; i < 4; ++i) { float sd = b4 ? sqv[i] : sqv[i + 4], kp = b4 ? sqv[i + 4] : sqv[i]; sqv[i] = kp + __shfl_xor(sd, 16); }
#pragma unroll
          for (int i = 0; i < 2; ++i) { float sd = b3 ? sqv[i] : sqv[i + 2], kp = b3 ? sqv[i + 2] : sqv[i]; sqv[i] = kp + __shfl_xor(sd, 8); }
          { float sd = b2 ? sqv[0] : sqv[1], kp = b2 ? sqv[1] : sqv[0]; sqv[0] = kp + __shfl_xor(sd, 4); }
          sqv[0] += __shfl_xor(sqv[0], 2);
          sqv[0] += __shfl_xor(sqv[0], 1);
          if ((lane & 3) == 0) atomicAdd(P.ssa + tok0 + (lane >> 2), sqv[0]);
        }
      }
    }
  }
}

__device__ void carry_phase(const Params& P) {
  const int gt = blockIdx.x * 256 + threadIdx.x, nth = gridDim.x * 256;
  for (int i = gt; i < 16384 + 65536; i += nth) {
    if (i < 16384) {
      const int b = i >> 9, ch = i & 511;
      float h = 0.f;
      for (int t0 = 0; t0 < 32; t0 += 8) {
        float a[8], hh[8];
#pragma unroll
        for (int j = 0; j < 8; ++j) {
          a[j] = P.Acar[(b * 32 + t0 + j) * 512 + ch];
          hh[j] = P.Hcar[(b * 32 + t0 + j) * 512 + ch];
        }
#pragma unroll
        for (int j = 0; j < 8; ++j) {
          P.Hin[(b * 32 + t0 + j) * 512 + ch] = h;
          h = a[j] * h + hh[j];
        }
      }
    } else {
      const int k = i - 16384;
      const int pp = k & 63, g = (k >> 6) & 31, b = k >> 11;
      const float ar = P.A16[(g * 64 + pp) * 2], ai = P.A16[(g * 64 + pp) * 2 + 1];
      float hr = 0.f, hi = 0.f;
      for (int c0 = 0; c0 < 128; c0 += 8) {
        float er[8], ei[8];
#pragma unroll
        for (int j = 0; j < 8; ++j) {
          size_t base = ((size_t)(b * 128 + c0 + j) * 32 + g) * 128;
          er[j] = bf2f(((const u16*)P.E)[base + pp]);
          ei[j] = bf2f(((const u16*)P.E)[base + 64 + pp]);
        }
#pragma unroll
        for (int j = 0; j < 8; ++j) {
          size_t base = ((size_t)(b * 128 + c0 + j) * 32 + g) * 128;
          P.Hs[base + pp] = f2bf(hr);
          P.Hs[base + 64 + pp] = f2bf(hi);
          float nr = ar * hr - ai * hi + er[j], ni = ar * hi + ai * hr + ei[j];
          hr = nr; hi = ni;
        }
      }
    }
  }
}

template <bool YPH>
__device__ void s5_phase(const Params& P) {
  constexpr int MTW = YPH ? 4 : 2;
  const int tid = threadIdx.x, lane = tid & 63, w = tid >> 6;
  const int l15 = lane & 15, lq = lane >> 4;
  for (int item = blockIdx.x; item < 2048; item += gridDim.x) {
    const int g = ((item & 7) << 2) | ((item >> 3) & 3), cb = item >> 5;
    f32x4 acc[MTW][4];
#pragma unroll
    for (int i = 0; i < MTW; ++i)
#pragma unroll
      for (int j = 0; j < 4; ++j) acc[i][j] = (f32x4){0.f, 0.f, 0.f, 0.f};
    const u16* Am = YPH ? (P.MF + (size_t)g * 256 * 384) : (P.G + (size_t)g * 128 * 256);
    constexpr int LD = YPH ? 384 : 256;
    for (int ks = 0; ks < 8; ++ks) {
      bf16x8 bu[4];
#pragma unroll
      for (int nt = 0; nt < 4; ++nt) {
        const int Ncol = cb * 64 + nt * 16 + l15;
        const int b = Ncol >> 7, c = Ncol & 127;
        const int tau = ks * 2 + (lq >> 1), j0 = (lq & 1) * 8;
        bu[nt] = *(const bf16x8*)(P.p + ((size_t)(b * 2048 + c * 16 + tau)) * 1536 + 1024 + g * 16 + j0);
      }
#pragma unroll
      for (int mt = 0; mt < MTW; ++mt) {
        const int m = (w * MTW + mt) * 16 + l15;
        bf16x8 a = *(const bf16x8*)(Am + (size_t)m * LD + ks * 32 + lq * 8);
#pragma unroll
        for (int nt = 0; nt < 4; ++nt) acc[mt][nt] = MFMA16(a, bu[nt], acc[mt][nt]);
      }
    }
    if (YPH) {
      for (int ks = 0; ks < 4; ++ks) {
        bf16x8 bh[4];
#pragma unroll
        for (int nt = 0; nt < 4; ++nt) {
          const int Ncol = cb * 64 + nt * 16 + l15;
          bh[nt] = *(const bf16x8*)(P.Hs + ((size_t)Ncol * 32 + g) * 128 + ks * 32 + lq * 8);
        }
#pragma unroll
        for (int mt = 0; mt < MTW; ++mt) {
          const int m = (w * MTW + mt) * 16 + l15;
          bf16x8 a = *(const bf16x8*)(Am + (size_t)m * LD + 256 + ks * 32 + lq * 8);
#pragma unroll
          for (int nt = 0; nt < 4; ++nt) acc[mt][nt] = MFMA16(a, bh[nt], acc[mt][nt]);
        }
      }
    }
#pragma unroll
    for (int mt = 0; mt < MTW; ++mt)
#pragma unroll
      for (int nt = 0; nt < 4; ++nt) {
        const int Ncol = cb * 64 + nt * 16 + l15;
        f32x4 v = acc[mt][nt];
        if (!YPH) {
          const int m0 = (w * MTW + mt) * 16 + lq * 4;
          *(uint2*)((u16*)P.E + ((size_t)Ncol * 32 + g) * 128 + m0) = make_uint2(pack2(v[0], v[1]), pack2(v[2], v[3]));
        } else {
          const int b = Ncol >> 7, c = Ncol & 127;
          const int tloc = w * MTW + mt;
          const size_t tok = (size_t)(b * 2048 + c * 16 + tloc);
          *(uint2*)(P.gs5 + tok * 512 + g * 16 + lq * 4) =
              make_uint2(pack2(gelu_(v[0]), gelu_(v[1])), pack2(gelu_(v[2]), gelu_(v[3])));
        }
      }
  }
}

__device__ __forceinline__ void top16_of_64(f32x16 (&acc)[4], int half, float (&res)[16]) {
  float g[4][16];
#pragma unroll
  for (int mt = 0; mt < 4; ++mt) {
#pragma unroll
    for (int i = 0; i < 16; ++i) {
      unsigned idx = mt * 32 + (i >> 2) * 8 + (i & 3);
      unsigned bits = (__float_as_uint(acc[mt][i]) & 0xffffff80u) | idx | (unsigned)(half * 4);
      g[mt][i] = __uint_as_float(bits);
    }
    sort16(g[mt]);
  }
  merge_top16(g[0], g[1]);
  merge_top16(g[2], g[3]);
  merge_top16(g[0], g[2]);
  float y[16];
#pragma unroll
  for (int i = 0; i < 16; ++i) y[i] = __shfl_xor(g[0][i], 32);
  merge_top16(g[0], y);
#pragma unroll
  for (int i = 0; i < 16; ++i) res[i] = g[0][i];
}
__host__ __device__ constexpr int cand_off(int i) {
  int s = 0;
  for (int q = 0; q < i; ++q) s += 16 / (q + 1);
  return s;
}

__device__ void cand_phase(const Params& P, char* smem) {
  const int tid = threadIdx.x;
  unsigned char* lut = (unsigned char*)smem + tid * 36;
  for (int gi = blockIdx.x * 256 + tid; gi < T_TOK * 8; gi += gridDim.x * 256) {
    const size_t tok = (size_t)(gi >> 3);
    const int head = gi & 7;
    float a[16], bl[16];
    {
      const float4* src = (const float4*)(P.t16 + (size_t)gi * 32);
#pragma unroll
      for (int i = 0; i < 4; ++i) {
        const float4 t = src[i], u = src[4 + i];
        a[i * 4] = t.x; a[i * 4 + 1] = t.y; a[i * 4 + 2] = t.z; a[i * 4 + 3] = t.w;
        bl[i * 4] = u.x; bl[i * 4 + 1] = u.y; bl[i * 4 + 2] = u.z; bl[i * 4 + 3] = u.w;
      }
    }
    float va[16], vb[16];
#pragma unroll
    for (int i = 0; i < 16; ++i) {
      va[i] = __uint_as_float(__float_as_uint(a[i]) & 0xffffff80u);
      vb[i] = __uint_as_float(__float_as_uint(bl[i]) & 0xffffff80u);
    }
    float cg4[4][16];
#pragma unroll
    for (int i = 0; i < 4; ++i)
#pragma unroll
      for (int j = 0; j < 16; ++j) cg4[i][j] = __uint_as_float(0xff800000u);
#pragma unroll
    for (int i = 0; i < 16; ++i)
#pragma unroll
      for (int j = 0; j < 16; ++j)
        if ((i + 1) * (j + 1) <= 16) {
          const int pos = cand_off(i) + j;
          float sm = va[i] + vb[j];
          cg4[pos >> 4][pos & 15] = __uint_as_float((__float_as_uint(sm) & 0xffffff00u) | (unsigned)(i * 16 + j));
        }
#pragma unroll
    for (int i = 0; i < 4; ++i) sort16(cg4[i]);
    merge_top16(cg4[0], cg4[1]);
    merge_top16(cg4[2], cg4[3]);
    merge_top16(cg4[0], cg4[2]);
    {
      unsigned* lw = (unsigned*)lut;
#pragma unroll
      for (int i = 0; i < 4; ++i) {
        lw[i] = (__float_as_uint(a[i * 4]) & 127u) | ((__float_as_uint(a[i * 4 + 1]) & 127u) << 8) |
                ((__float_as_uint(a[i * 4 + 2]) & 127u) << 16) | ((__float_as_uint(a[i * 4 + 3]) & 127u) << 24);
        lw[4 + i] = (__float_as_uint(bl[i * 4]) & 127u) | ((__float_as_uint(bl[i * 4 + 1]) & 127u) << 8) |
                    ((__float_as_uint(bl[i * 4 + 2]) & 127u) << 16) | ((__float_as_uint(bl[i * 4 + 3]) & 127u) << 24);
      }
    }
    float sc[16];
    int ee[16];
    const float mx = __uint_as_float(__float_as_uint(cg4[0][0]) & 0xffffff00u);
    float ssum = 0.f;
#pragma unroll
    for (int k = 0; k < 16; ++k) {
      unsigned bits = __float_as_uint(cg4[0][k]);
      unsigned code = bits & 255u;
      float v = __uint_as_float(bits & 0xffffff00u);
      sc[k] = __expf(v - mx);
      ssum += sc[k];
      int i1 = lut[code >> 4], i2 = lut[16 + (code & 15u)];
      ee[k] = i1 * 128 + i2;
    }
    const float inv = 1.f / ssum;
    int4* de = (int4*)(P.eidx + tok * 128 + head * 16);
    float4* dg = (float4*)(P.gw + tok * 128 + head * 16);
#pragma unroll
    for (int i = 0; i < 4; ++i) {
      de[i] = make_int4(ee[i * 4], ee[i * 4 + 1], ee[i * 4 + 2], ee[i * 4 + 3]);
      dg[i] = make_float4(sc[i * 4] * inv * P.sv[ee[i * 4]], sc[i * 4 + 1] * inv * P.sv[ee[i * 4 + 1]],
                          sc[i * 4 + 2] * inv * P.sv[ee[i * 4 + 2]], sc[i * 4 + 3] * inv * P.sv[ee[i * 4 + 3]]);
    }
  }
}

typedef float f2v __attribute__((ext_vector_type(2)));
__device__ __forceinline__ float dot16_fp8(uint4 u, const f2v* x) {
  f2v acc = {0.f, 0.f};
  acc = __builtin_amdgcn_cvt_pk_f32_fp8(u.x, false) * x[0] + acc;
  acc = __builtin_amdgcn_cvt_pk_f32_fp8(u.x, true) * x[1] + acc;
  acc = __builtin_amdgcn_cvt_pk_f32_fp8(u.y, false) * x[2] + acc;
  acc = __builtin_amdgcn_cvt_pk_f32_fp8(u.y, true) * x[3] + acc;
  acc = __builtin_amdgcn_cvt_pk_f32_fp8(u.z, false) * x[4] + acc;
  acc = __builtin_amdgcn_cvt_pk_f32_fp8(u.z, true) * x[5] + acc;
  acc = __builtin_amdgcn_cvt_pk_f32_fp8(u.w, false) * x[6] + acc;
  acc = __builtin_amdgcn_cvt_pk_f32_fp8(u.w, true) * x[7] + acc;
  return acc.x + acc.y;
}
__device__ __forceinline__ void axpy16_fp8(f2v* o, float wgt, uint4 v) {
  const f2v ww = {wgt, wgt};
  o[0] = __builtin_amdgcn_cvt_pk_f32_fp8(v.x, false) * ww + o[0];
  o[1] = __builtin_amdgcn_cvt_pk_f32_fp8(v.x, true) * ww + o[1];
  o[2] = __builtin_amdgcn_cvt_pk_f32_fp8(v.y, false) * ww + o[2];
  o[3] = __builtin_amdgcn_cvt_pk_f32_fp8(v.y, true) * ww + o[3];
  o[4] = __builtin_amdgcn_cvt_pk_f32_fp8(v.z, false) * ww + o[4];
  o[5] = __builtin_amdgcn_cvt_pk_f32_fp8(v.z, true) * ww + o[5];
  o[6] = __builtin_amdgcn_cvt_pk_f32_fp8(v.w, false) * ww + o[6];
  o[7] = __builtin_amdgcn_cvt_pk_f32_fp8(v.w, true) * ww + o[7];
}

__device__ void peer_phase(const Params& P) {
  const int lane = threadIdx.x & 63;
  const int w = __builtin_amdgcn_readfirstlane(threadIdx.x >> 6);
  const int gwv = blockIdx.x * 4 + w, nw = gridDim.x * 4;
  const bool hb = (lane & 32) != 0, b4 = (lane & 16) != 0, b3 = (lane & 8) != 0;
  float4 g2v[4];
#pragma unroll
  for (int c = 0; c < 4; ++c) g2v[c] = *(const float4*)(P.norm2_g + lane * 16 + c * 4);
  float4 hn[4];
  if (gwv < T_TOK) {
#pragma unroll
    for (int c = 0; c < 4; ++c) hn[c] = *(const float4*)(P.out + (size_t)gwv * 1024 + lane * 16 + c * 4);
  }
  for (int tok = gwv; tok < T_TOK; tok += nw) {
    float4 hc[4];
#pragma unroll
    for (int c = 0; c < 4; ++c) hc[c] = hn[c];
    {
      const int ntok = (tok + nw < T_TOK) ? tok + nw : tok;
#pragma unroll
      for (int c = 0; c < 4; ++c) hn[c] = *(const float4*)(P.out + (size_t)ntok * 1024 + lane * 16 + c * 4);
    }
    const int* ep = P.eidx + (size_t)tok * 128;
    const float* gp = P.gw + (size_t)tok * 128;
    const float* sp = P.suv + (size_t)tok * 128;
    uint4 uA[8], uB[8];
    float suA, gA, suB, gB;
    int elA, elB;
#define LOADU(U, SU, G, EL, kb) { _Pragma("unroll") for (int j = 0; j < 8; ++j) { const int e = ep[(kb) + j]; \
        U[j] = *(const uint4*)(P.U8 + (size_t)e * 1024 + lane * 16); } \
      SU = sp[(kb) + (lane >> 3)]; G = gp[(kb) + (lane >> 3)]; EL = ep[(kb) + (lane >> 3)]; }
    LOADU(uA, suA, gA, elA, 0)
    __builtin_amdgcn_sched_barrier(0);
    float ss = 0.f;
#pragma unroll
    for (int c = 0; c < 4; ++c) ss += hc[c].x * hc[c].x + hc[c].y * hc[c].y + hc[c].z * hc[c].z + hc[c].w * hc[c].w;
    ss = wsum(ss);
    const float rstd2 = rsqrtf(ss * (1.f / 1024.f) + EPSF);
    f2v xn[8];
#pragma unroll
    for (int c = 0; c < 4; ++c) {
      xn[c * 2 + 0] = (f2v){hc[c].x * rstd2 * g2v[c].x, hc[c].y * rstd2 * g2v[c].y};
      xn[c * 2 + 1] = (f2v){hc[c].z * rstd2 * g2v[c].z, hc[c].w * rstd2 * g2v[c].w};
    }
#define PROCU(U, SU, G, EL, kb) { float d[8]; \
      _Pragma("unroll") for (int j = 0; j < 8; ++j) d[j] = dot16_fp8(U[j], xn); \
      _Pragma("unroll") for (int i = 0; i < 4; ++i) { float send = hb ? d[i] : d[i + 4], keep = hb ? d[i + 4] : d[i]; d[i] = keep + __shfl_xor(send, 32); } \
      _Pragma("unroll") for (int i = 0; i < 2; ++i) { float send = b4 ? d[i] : d[i + 2], keep = b4 ? d[i + 2] : d[i]; d[i] = keep + __shfl_xor(send, 16); } \
      { float send = b3 ? d[0] : d[1], keep = b3 ? d[1] : d[0]; d[0] = keep + __shfl_xor(send, 8); } \
      d[0] += __shfl_xor(d[0], 4); d[0] += __shfl_xor(d[0], 2); d[0] += __shfl_xor(d[0], 1); \
      const float act = gelu_(d[0] * SU) * G; \
      if ((lane & 7) == 0) ((unsigned*)P.wact)[(size_t)tok * 128 + (kb) + (lane >> 3)] = ((unsigned)f2bf(act) << 16) | (unsigned)EL; }
    for (int k0 = 0; k0 < 128; k0 += 16) {
      LOADU(uB, suB, gB, elB, k0 + 8)
      __builtin_amdgcn_sched_barrier(0);
      PROCU(uA, suA, gA, elA, k0)
      { const int kn = (k0 + 16 < 128) ? k0 + 16 : 112; LOADU(uA, suA, gA, elA, kn) }
      __builtin_amdgcn_sched_barrier(0);
      PROCU(uB, suB, gB, elB, k0 + 8)
    }
  }
}

__device__ void udot_phase(const Params& P) {
  const int my_xcc = (int)((unsigned)__builtin_amdgcn_s_getreg((3 << 11) | 20) & 7u), my_rank = P.rank[blockIdx.x];
  const int lane = threadIdx.x & 63, w = threadIdx.x >> 6;
  const int r = lane >> 3, c = lane & 7;
  const bool b2 = (lane & 4) != 0, b1 = (lane & 2) != 0, b0 = (lane & 1) != 0;
  int cen_ok = 1, cen_sum = 0, cen_mine = 0;
#pragma unroll
  for (int x = 0; x < 8; ++x) {
    const int cx = (int)__hip_atomic_load(P.bar + 15 * 512 + x * 32, __ATOMIC_RELAXED, __HIP_MEMORY_SCOPE_AGENT);
    cen_ok &= (cx > 0); cen_sum += cx; if (x == my_xcc) cen_mine = cx;
  }
  const bool fast = cen_ok && cen_sum == (int)gridDim.x;
  const int nwt = fast ? cen_mine * 4 : (int)gridDim.x * 4;
  const int wv = fast ? my_rank * 4 + w : (int)blockIdx.x * 4 + w;
  const int total = fast ? T_TOK : T_TOK * 8;
  const int cnt = (wv < total) ? (total - wv + nwt - 1) / nwt : 0;
  if (cnt == 0) return;
  const int slf = my_xcc;
#define UTOK(n, SL, TK) { int it_ = wv + ((n) < cnt ? (n) : cnt - 1) * nwt; SL = fast ? slf : (it_ & 7); TK = fast ? it_ : (it_ >> 3); }
#define ULOADE(E, n) { int sl_, tk_; UTOK(n, sl_, tk_) (void)sl_; const uint4* ep_ = (const uint4*)(P.eidx + (size_t)tk_ * 128 + r * 16); \
      _Pragma("unroll") for (int i = 0; i < 4; ++i) E[i] = ep_[i]; }
#define UGATHER(V, E, n) { int sl_, tk_; UTOK(n, sl_, tk_) (void)tk_; const unsigned char* ub_ = P.U8 + (size_t)sl_ * (16384 * 128) + c * 16; \
      _Pragma("unroll") for (int i = 0; i < 4; ++i) { \
        V[i * 4 + 0] = *(const uint4*)(ub_ + (size_t)E[i].x * 128); V[i * 4 + 1] = *(const uint4*)(ub_ + (size_t)E[i].y * 128); \
        V[i * 4 + 2] = *(const uint4*)(ub_ + (size_t)E[i].z * 128); V[i * 4 + 3] = *(const uint4*)(ub_ + (size_t)E[i].w * 128); } }
#define UHLOAD(H, S2, n) { int sl_, tk_; UTOK(n, sl_, tk_) const u16* hp_ = P.hb + (size_t)tk_ * 1024 + sl_ * 128 + c * 16; \
      H[0] = *(const float4*)hp_; H[1] = *(const float4*)(hp_ + 8);     (void)S2; }
#define UPROC(V, H, S2, n) { int sl_, tk_; UTOK(n, sl_, tk_) \
      f2v xn_[8]; \
      _Pragma("unroll") for (int i = 0; i < 2; ++i) { \
        const unsigned u0_ = __float_as_uint(H[i].x), u1_ = __float_as_uint(H[i].y), u2_ = __float_as_uint(H[i].z), u3_ = __float_as_uint(H[i].w); \
        xn_[i * 4] = (f2v){bflo(u0_), bfhi(u0_)}; xn_[i * 4 + 1] = (f2v){bflo(u1_), bfhi(u1_)}; \
        xn_[i * 4 + 2] = (f2v){bflo(u2_), bfhi(u2_)}; xn_[i * 4 + 3] = (f2v){bflo(u3_), bfhi(u3_)}; } \
      float d[16]; _Pragma("unroll") for (int i = 0; i < 16; ++i) d[i] = dot16_fp8(V[i], xn_); \
      _Pragma("unroll") for (int i = 0; i < 8; ++i) { float sd = b2 ? d[i] : d[i + 8], kp = b2 ? d[i + 8] : d[i]; d[i] = kp + __shfl_xor(sd, 4); } \
      _Pragma("unroll") for (int i = 0; i < 4; ++i) { float sd = b1 ? d[i] : d[i + 4], kp = b1 ? d[i + 4] : d[i]; d[i] = kp + __shfl_xor(sd, 2); } \
      _Pragma("unroll") for (int i = 0; i < 2; ++i) { float sd = b0 ? d[i] : d[i + 2], kp = b0 ? d[i + 2] : d[i]; d[i] = kp + __shfl_xor(sd, 1); } \
      __builtin_nontemporal_store(pack2(d[0], d[1]), (unsigned*)P.part + ((size_t)sl_ * T_TOK + tk_) * 64 + lane); }
  uint4 eA[4], eB[4];
  uint4 vA[16], vB[16];
  ULOADE(eA, 0)
  ULOADE(eB, 1)
  UGATHER(vA, eA, 0)
  __builtin_amdgcn_sched_barrier(0);
  for (int n = 0; n < cnt; n += 2) {
    { float4 h_[4]; float s2_ = 0.f; UHLOAD(h_, s2_, n) UGATHER(vB, eB, n + 1) ULOADE(eA, n + 2)
      __builtin_amdgcn_sched_barrier(0); UPROC(vA, h_, s2_, n) }
    if (n + 1 < cnt) {
      float4 h_[4]; float s2_ = 0.f; UHLOAD(h_, s2_, n + 1) UGATHER(vA, eA, n + 2) ULOADE(eB, n + 3)
      __builtin_amdgcn_sched_barrier(0); UPROC(vB, h_, s2_, n + 1)
    }
  }
}

__device__ void ucomb_phase(const Params& P) {
  const size_t gt = (size_t)blockIdx.x * 256 + threadIdx.x, nt = (size_t)gridDim.x * 256;
  for (size_t i = gt; i < (size_t)T_TOK * 32; i += nt) {
    float4 a = make_float4(0.f, 0.f, 0.f, 0.f);
#pragma unroll
    for (int sl = 0; sl < 8; ++sl) {
      const uint2 b = ((const uint2*)P.part)[(size_t)sl * T_TOK * 32 + i];
      a.x += bflo(b.x); a.y += bfhi(b.x); a.z += bflo(b.y); a.w += bfhi(b.y);
    }
    const float4 g = ((const float4*)P.gw)[i];
    const int4 e = ((const int4*)P.eidx)[i];
    float4 su = make_float4(P.su[e.x], P.su[e.y], P.su[e.z], P.su[e.w]);
    { const float r2 = rsqrtf(P.ss2[i >> 5] * (1.f / 1024.f) + EPSF); su.x *= r2; su.y *= r2; su.z *= r2; su.w *= r2; }
    uint4 o;
    o.x = ((unsigned)f2bf(gelu_(a.x * su.x) * g.x) << 16) | (unsigned)e.x;
    o.y = ((unsigned)f2bf(gelu_(a.y * su.y) * g.y) << 16) | (unsigned)e.y;
    o.z = ((unsigned)f2bf(gelu_(a.z * su.z) * g.z) << 16) | (unsigned)e.z;
    o.w = ((unsigned)f2bf(gelu_(a.w * su.w) * g.w) << 16) | (unsigned)e.w;
    ((uint4*)P.wact)[i] = o;
  }
}

__device__ void vacc_phase(const Params& P) {
  const int my_xcc = (int)((unsigned)__builtin_amdgcn_s_getreg((3 << 11) | 20) & 7u), my_rank = P.rank[blockIdx.x];
  const int lane = threadIdx.x & 63, w = threadIdx.x >> 6;
  const int r = lane >> 3, c = lane & 7;
  const bool hb = (lane & 32) != 0, b4 = (lane & 16) != 0, b3 = (lane & 8) != 0;
  int cen_ok = 1, cen_sum = 0, cen_mine = 0;
#pragma unroll
  for (int x = 0; x < 8; ++x) {
    const int cx = (int)__hip_atomic_load(P.bar + 15 * 512 + x * 32, __ATOMIC_RELAXED, __HIP_MEMORY_SCOPE_AGENT);
    cen_ok &= (cx > 0); cen_sum += cx; if (x == my_xcc) cen_mine = cx;
  }
  const bool fast = cen_ok && cen_sum == (int)gridDim.x;
  const int nwt = fast ? cen_mine * 4 : (int)gridDim.x * 4;
  const int wv = fast ? my_rank * 4 + w : (int)blockIdx.x * 4 + w;
  const int total = fast ? T_TOK : T_TOK * 8;
  const int cnt = (wv < total) ? (total - wv + nwt - 1) / nwt : 0;
  if (cnt == 0) return;
  const int slf = my_xcc;
#define VTOK(n, SL, TK) { int it_ = wv + ((n) < cnt ? (n) : cnt - 1) * nwt; SL = fast ? slf : (it_ & 7); TK = fast ? it_ : (it_ >> 3); }
#define VLOADEW(E, W, n) { int sl_, tk_; VTOK(n, sl_, tk_) (void)sl_; \
      const uint4* ep_ = (const uint4*)(P.wact + (size_t)tk_ * 128 + r * 16); \
      _Pragma("unroll") for (int i = 0; i < 4; ++i) { E[i] = ep_[i]; } }
#define VGATHER(V, E, n) { int sl_, tk_; VTOK(n, sl_, tk_) (void)tk_; const unsigned char* vb_ = P.V8 + (size_t)sl_ * (16384 * 128) + c * 16; \
      _Pragma("unroll") for (int i = 0; i < 4; ++i) { \
        V[i * 4 + 0] = *(const uint4*)(vb_ + (size_t)(E[i].x & 0xffffu) * 128); V[i * 4 + 1] = *(const uint4*)(vb_ + (size_t)(E[i].y & 0xffffu) * 128); \
        V[i * 4 + 2] = *(const uint4*)(vb_ + (size_t)(E[i].z & 0xffffu) * 128); V[i * 4 + 3] = *(const uint4*)(vb_ + (size_t)(E[i].w & 0xffffu) * 128); } }
#define VPROC(V, W, HV, n) { int sl_, tk_; VTOK(n, sl_, tk_) \
      f2v o[8]; _Pragma("unroll") for (int i = 0; i < 8; ++i) o[i] = (f2v){0.f, 0.f}; \
      _Pragma("unroll") for (int i = 0; i < 4; ++i) { axpy16_fp8(o, bfhi(W[i].x), V[i * 4 + 0]); axpy16_fp8(o, bfhi(W[i].y), V[i * 4 + 1]); \
        axpy16_fp8(o, bfhi(W[i].z), V[i * 4 + 2]); axpy16_fp8(o, bfhi(W[i].w), V[i * 4 + 3]); } \
      float f[16]; _Pragma("unroll") for (int i = 0; i < 8; ++i) { f[i * 2] = o[i].x; f[i * 2 + 1] = o[i].y; } \
      _Pragma("unroll") for (int i = 0; i < 8; ++i) { float sd = hb ? f[i] : f[i + 8], kp = hb ? f[i + 8] : f[i]; f[i] = kp + __shfl_xor(sd, 32); } \
      _Pragma("unroll") for (int i = 0; i < 4; ++i) { float sd = b4 ? f[i] : f[i + 4], kp = b4 ? f[i + 4] : f[i]; f[i] = kp + __shfl_xor(sd, 16); } \
      _Pragma("unroll") for (int i = 0; i < 2; ++i) { float sd = b3 ? f[i] : f[i + 2], kp = b3 ? f[i + 2] : f[i]; f[i] = kp + __shfl_xor(sd, 8); } \
      (void)HV; *(unsigned*)(P.hb + (size_t)tk_ * 1024 + sl_ * 128 + c * 16 + r * 2) = pack2(f[0], f[1]); }
#define VHLOAD(HV, n) { HV = make_float2(0.f, 0.f); }
#define IT2(VC, EC, VN, EN, n) { float2 hv0_; VHLOAD(hv0_, n) VGATHER(VN, EN, (n) + 1) VLOADEW(eC, eC, (n) + 2) \
      __builtin_amdgcn_sched_barrier(0); VPROC(VC, EC, hv0_, n) \
      _Pragma("unroll") for (int i = 0; i < 4; ++i) EC[i] = eC[i]; }
  uint4 eA[4], eB[4], eC[4];
  uint4 vA[16], vB[16];
  VLOADEW(eA, eA, 0)
  VLOADEW(eB, eB, 1)
  VGATHER(vA, eA, 0)
  __builtin_amdgcn_sched_barrier(0);
  for (int n = 0; n < cnt; n += 2) {
    IT2(vA, eA, vB, eB, n)
    if (n + 1 < cnt) IT2(vB, eB, vA, eA, n + 1)
  }
}

__device__ void final_phase(const Params& P) {
  const int lane = threadIdx.x & 63, w = threadIdx.x >> 6;
  const int gwv = blockIdx.x * 4 + w, nw = gridDim.x * 4;
  float4 g[4];
#pragma unroll
  for (int c = 0; c < 4; ++c) g[c] = *(const float4*)(P.normf_g + lane * 16 + c * 4);
  for (int tok = gwv; tok < T_TOK; tok += nw) {
    float* hrow = P.out + (size_t)tok * 1024 + lane * 16;
    const u16* orow = P.hb + (size_t)tok * 1024 + lane * 16;
    float4 v[4];
#pragma unroll
    for (int c = 0; c < 4; ++c) v[c] = *(const float4*)(hrow + c * 4);
    const uint4 o0 = *(const uint4*)orow, o1 = *(const uint4*)(orow + 8);
    v[0].x += bflo(o0.x); v[0].y += bfhi(o0.x); v[0].z += bflo(o0.y); v[0].w += bfhi(o0.y);
    v[1].x += bflo(o0.z); v[1].y += bfhi(o0.z); v[1].z += bflo(o0.w); v[1].w += bfhi(o0.w);
    v[2].x += bflo(o1.x); v[2].y += bfhi(o1.x); v[2].z += bflo(o1.y); v[2].w += bfhi(o1.y);
    v[3].x += bflo(o1.z); v[3].y += bfhi(o1.z); v[3].z += bflo(o1.w); v[3].w += bfhi(o1.w);
    float ss = 0.f;
#pragma unroll
    for (int c = 0; c < 4; ++c) ss += v[c].x * v[c].x + v[c].y * v[c].y + v[c].z * v[c].z + v[c].w * v[c].w;
    ss = wsum(ss);
    const float rf = rsqrtf(ss * (1.f / 1024.f) + EPSF);
#pragma unroll
    for (int c = 0; c < 4; ++c)
      *(float4*)(hrow + c * 4) = make_float4(v[c].x * rf * g[c].x, v[c].y * rf * g[c].y, v[c].z * rf * g[c].z, v[c].w * rf * g[c].w);
  }
}

__device__ __forceinline__ void gbar(unsigned* bar, int k) {
  asm volatile("s_waitcnt vmcnt(0)" ::: "memory");
  __syncthreads();
  if (threadIdx.x == 0) {
    unsigned* base = bar + k * 512;
    const unsigned g = blockIdx.x & 7u;
    const unsigned gsz = (gridDim.x - g + 7u) >> 3;
    const unsigned ngroups = gridDim.x < 8u ? gridDim.x : 8u;
    __builtin_amdgcn_fence(__ATOMIC_RELEASE, "agent");
    asm volatile("s_waitcnt vmcnt(0)" ::: "memory");
    const unsigned old = __hip_atomic_fetch_add(base + g * 32, 1u, __ATOMIC_RELAXED, __HIP_MEMORY_SCOPE_AGENT);
    if (old == gsz - 1u) __hip_atomic_fetch_add(base + 256, 1u, __ATOMIC_RELAXED, __HIP_MEMORY_SCOPE_AGENT);
    unsigned spins = 0;
    while (__hip_atomic_load(base + 256, __ATOMIC_RELAXED, __HIP_MEMORY_SCOPE_AGENT) < ngroups && spins < (1u << 22)) {
      __builtin_amdgcn_s_sleep(1);
      ++spins;
    }
    __builtin_amdgcn_fence(__ATOMIC_ACQUIRE, "agent");
    asm volatile("s_waitcnt vmcnt(0)" ::: "memory");
  }
  __syncthreads();
}

#define SMEM_BYTES 74752

template <int PH>
__device__ __forceinline__ void run_phase(const Params& P, char* smem) {
  if (PH == 0) phase_prep(P, smem);
  if (PH == 1) gemm256_phase<EPI_INPROJ>(P, smem, P.xb, P.WinT, T_TOK, 1536, 1024);
  if (PH == 2) { lru_phase<false>(P, smem); s5_phase<false>(P); }
  if (PH == 3) carry_phase(P);
  if (PH == 4) { lru_phase<true>(P, smem); s5_phase<true>(P); }
  if (PH == 5) gemm_phase<EPI_GLU>(P, smem, P.gs5, P.GluT, T_TOK, 512, 512);
  if (PH == 6) gemm256_phase<EPI_OUT>(P, smem, P.ycat, P.WoutT, T_TOK, 1024, 1024);
  if (PH == 7) gemm_phase<EPI_Q>(P, smem, P.hb, P.WqT, T_TOK, 2048, 1024);
  if (PH == 8) cand_phase(P, smem);
  if (PH == 9) udot_phase(P);
  if (PH == 10) ucomb_phase(P);
  if (PH == 11) vacc_phase(P);
  if (PH == 12) final_phase(P);
}

template <int LO, int HI>
__global__ void __launch_bounds__(256, 2) mk(Params P) {
  __shared__ __attribute__((aligned(16))) char smem[SMEM_BYTES];
  cg::grid_group grid = cg::this_grid();
#ifndef REPEAT_MASK
#define REPEAT_MASK 0
#endif
#define PHASE(n) if (LO <= n && n <= HI) { if ((REPEAT_MASK >> n) & 1) { run_phase<n>(P, smem); grid.sync(); } run_phase<n>(P, smem); if (n < HI) gbar(P.bar, n); }
  if (threadIdx.x == 0) {
    const unsigned xcc = (unsigned)__builtin_amdgcn_s_getreg((3 << 11) | 20) & 7u;
    const unsigned rk = __hip_atomic_fetch_add(P.bar + 15 * 512 + xcc * 32, 1u, __ATOMIC_RELAXED, __HIP_MEMORY_SCOPE_AGENT);
    P.rank[blockIdx.x] = (int)rk;
  }
  if (P.bar == nullptr) grid.sync();
  PHASE(0) PHASE(1) PHASE(2) PHASE(3) PHASE(4) PHASE(5) PHASE(6) PHASE(7) PHASE(8) PHASE(9) PHASE(10) PHASE(11) PHASE(12)
}

extern "C" void kernel_launch(void* const* d_in, const int* in_sizes, int n_in, void* d_out, int out_size,
                              void* d_ws, size_t ws_size, hipStream_t stream) {
  Params P{};
  const float** pin = (const float**)&P;
  for (int i = 0; i < 30; ++i) pin[i] = (const float*)d_in[i];
  P.out = (float*)d_out;
  char* ws = (char*)d_ws;
  size_t off = 0;
  auto take = [&](size_t bytes) { char* r = ws + off; off += (bytes + 255) & ~(size_t)255; return r; };
  const size_t MB = 1024 * 1024;
  char* RA = take(128 * MB);
  char* RB = take(256 * MB);
  char* RC = take(128 * MB);
  char* RD = take(96 * MB);
  P.xb = (u16*)RA; P.ycat = (u16*)RA;
  P.p = (u16*)RB; P.q = (u16*)RB;
  P.E = (float*)RC; P.Hs = (u16*)(RC + 64 * MB); P.hb = (u16*)RC;
  P.gs5 = (u16*)RD; P.eidx = (int*)RD; P.gw = (float*)(RD + 32 * MB); P.suv = (float*)(RD + 64 * MB);
  P.U8 = (unsigned char*)take(16 * MB); P.V8 = (unsigned char*)take(16 * MB);
  P.su = (float*)take(16384 * 4); P.sv = (float*)take(16384 * 4);
  P.WinT = (u16*)take(1536 * 1024 * 2); P.GluT = (u16*)take(512 * 512 * 2);
  P.WoutT = (u16*)take(1024 * 1024 * 2); P.WqT = (u16*)take(2048 * 1024 * 2);
  P.K1b = (u16*)take(128 * 128 * 2); P.K2b = (u16*)take(128 * 128 * 2);
  P.WaT = (u16*)take(8 * 4096 * 2); P.WxT = (u16*)take(8 * 4096 * 2);
  P.MF = (u16*)take(32 * 256 * 384 * 2); P.G = (u16*)take(32 * 128 * 256 * 2);
  P.spv = (float*)take(512 * 4);
  P.ssf = (float*)take(T_TOK * 4); P.wact = (float*)RA; P.part = (float*)RB; P.t16 = (float*)RB;
  P.ssa = (float*)take(T_TOK * 4); P.ssb = (float*)take(T_TOK * 4); P.ss2 = (float*)take(T_TOK * 4);
  P.rstd1 = (float*)take(T_TOK * 4); P.A16 = (float*)take(32 * 64 * 2 * 4);
  P.Acar = (float*)take(32 * 32 * 512 * 4); P.Hcar = (float*)take(32 * 32 * 512 * 4); P.Hin = (float*)take(32 * 32 * 512 * 4);

  P.bar = (unsigned*)take(16 * 2048);
  P.au = (unsigned*)take((size_t)T_TOK * 512 * 4);
  P.rank = (int*)take(4096 * 4);
  static int grid_blocks = 0;
#if ONE_LAUNCH
  (void)hipMemsetAsync(P.bar, 0, 16 * 2048, stream);
  if (!grid_blocks) {
    int dev = 0, cus = 0, per_cu = 0;
    (void)hipGetDevice(&dev);
    (void)hipDeviceGetAttribute(&cus, hipDeviceAttributeMultiprocessorCount, dev);
    (void)hipOccupancyMaxActiveBlocksPerMultiprocessor(&per_cu, mk<0, NPHASE - 1>, 256, 0);
    if (per_cu > 2) per_cu = 2;
    if (per_cu < 1) per_cu = 1;
    grid_blocks = cus * per_cu;
  }
  void* args[] = {&P};
  hipError_t e = hipLaunchCooperativeKernel((void*)mk<0, NPHASE - 1>, dim3(grid_blocks), dim3(256), args, 0, stream);
  if (e != hipSuccess) fprintf(stderr, "cooperative launch failed: %s (grid %d)\n", hipGetErrorString(e), grid_blocks);
#else
  if (!grid_blocks) {
    int dev = 0, cus = 0;
    (void)hipGetDevice(&dev);
    (void)hipDeviceGetAttribute(&cus, hipDeviceAttributeMultiprocessorCount, dev);
    grid_blocks = cus * 2;
  }
  mk<0, 0><<<grid_blocks, 256, 0, stream>>>(P);
  mk<1, 1><<<grid_blocks, 256, 0, stream>>>(P);
  mk<2, 2><<<grid_blocks, 256, 0, stream>>>(P);
  mk<3, 3><<<grid_blocks, 256, 0, stream>>>(P);
  mk<4, 4><<<grid_blocks, 256, 0, stream>>>(P);
  mk<5, 5><<<grid_blocks, 256, 0, stream>>>(P);
  mk<6, 6><<<grid_blocks, 256, 0, stream>>>(P);
  mk<7, 7><<<grid_blocks, 256, 0, stream>>>(P);
  mk<8, 8><<<grid_blocks, 256, 0, stream>>>(P);
  mk<9, 9><<<grid_blocks, 256, 0, stream>>>(P);
#endif
}
```
